# Optimizing an MI355X kernel written in HIP

```python
import jax, jax.numpy as jnp
from jax import lax
import numpy as np

D_MODEL = 1024
BATCH = 8
SEQ = 8192
DEPTH = 2

N_META = 16
NORM_EPS = 1e-6
RWKV_HEADS = 8
RWKV_HEAD_DIM = 64
RWKV_WIDTH = RWKV_HEADS * RWKV_HEAD_DIM
LORA_W = 64
LORA_A = 64
LORA_G = 128
RWKV_IN = 3 * RWKV_WIDTH + LORA_W + LORA_A + LORA_G
GN_EPS = 64e-5
LRU_BLOCKS = 8
LRU_BLOCK = 64
LRU_WIDTH = LRU_BLOCKS * LRU_BLOCK
CONV_WIDTH = 4
LRU_C = 8.0
EVEN_IN = RWKV_IN + 2 * LRU_WIDTH
EVEN_MIX = RWKV_WIDTH + LRU_WIDTH
GLA_HEADS = 4
GLA_DK = 128
GLA_DV = 256
GLA_KEY_WIDTH = GLA_HEADS * GLA_DK
GLA_VAL_WIDTH = GLA_HEADS * GLA_DV
GLA_LORA = 16
GLA_TAU = 16.0
GLA_CHUNK = 64
ODD_IN = 2 * GLA_KEY_WIDTH + 2 * GLA_VAL_WIDTH + GLA_LORA
N_GROUPS = 4
EXPERTS_PER_GROUP = 8
N_EXPERTS = N_GROUPS * EXPERTS_PER_GROUP
TOP_K = 2
EXPERT_FF = 256
N_EVEN = (DEPTH + 1) // 2
N_ODD = DEPTH // 2

kernel_name = 'hybrid_rwkv7_rglru_gla_hmoe'


def rms_norm(x, gain):
    xf = x.astype(jnp.float32)
    y = xf * lax.rsqrt(jnp.mean(xf * xf, axis=-1, keepdims=True) + NORM_EPS)
    return (y * gain.astype(jnp.float32)).astype(x.dtype)


def token_shift(p):
    return jnp.pad(p, ((0, 0), (1, 0), (0, 0)))[:, :-1]


def rwkv7_mix(p, mu, decay0, decay_up, iclr0, iclr_up, gate_up, k_k, k_a, r_k, ln_g, ln_b):
    B, T, _ = p.shape
    f32 = jnp.float32
    H, Dh, W = RWKV_HEADS, RWKV_HEAD_DIM, RWKV_WIDTH
    p = p + mu * (token_shift(p) - p)
    r, k, v, wd, ad, gd = jnp.split(p, [W, 2 * W, 3 * W, 3 * W + LORA_W, 3 * W + LORA_W + LORA_A], axis=-1)
    w = -jax.nn.softplus(-(decay0 + jnp.tanh(wd) @ decay_up).astype(f32)) - 0.5
    decay = jnp.exp(-jnp.exp(w))
    a = jax.nn.sigmoid((iclr0 + ad @ iclr_up).astype(f32))
    g = (jax.nn.sigmoid(gd) @ gate_up).astype(f32)
    heads = lambda t: t.reshape(B, T, H, Dh)
    kk = heads((k * k_k).astype(f32))
    kk = kk / jnp.maximum(jnp.linalg.norm(kk, axis=-1, keepdims=True), 1e-12)
    k_mod = k.astype(f32) * (1.0 + (a - 1.0) * k_a.astype(f32))
    r_h, k_h, v_h, a_h, w_h = heads(r.astype(f32)), heads(k_mod), heads(v.astype(f32)), heads(a), heads(decay)
    tm = lambda t: jnp.moveaxis(t, 1, 0)

    def step(S, inp):
        r_t, w_t, k_t, v_t, kk_t, b_t = inp
        sa = jnp.einsum('bhvk,bhk->bhv', S, kk_t)
        S = S * w_t[:, :, None, :] - sa[..., None] * b_t[:, :, None, :] + v_t[..., None] * k_t[:, :, None, :]
        return S, jnp.einsum('bhvk,bhk->bhv', S, r_t)

    S0 = jnp.zeros((B, H, Dh, Dh), f32)
    _, o = lax.scan(step, S0, (tm(r_h), tm(w_h), tm(k_h), tm(v_h), tm(kk), tm(kk * a_h)))
    o = jnp.moveaxis(o, 0, 1)
    mean = jnp.mean(o, axis=-1, keepdims=True)
    var = jnp.mean(jnp.square(o - mean), axis=-1, keepdims=True)
    o = ((o - mean) * lax.rsqrt(var + GN_EPS)).reshape(B, T, W) * ln_g.astype(f32) + ln_b.astype(f32)
    bonus = jnp.sum(r_h * k_h * r_k.astype(f32).reshape(H, Dh), axis=-1, keepdims=True) * v_h
    o = (o + bonus.reshape(B, T, W)) * g
    return o.astype(p.dtype)


def rglru_mix(xb, gb, conv_w, conv_b, wa, ba, wx, bx, lam):
    B, T, C = xb.shape
    f32 = jnp.float32
    xc = lax.conv_general_dilated(xb, conv_w[:, None, :], window_strides=(1,),
                                  padding=[(CONV_WIDTH - 1, 0)],
                                  dimension_numbers=('NWC', 'WIO', 'NWC'),
                                  feature_group_count=C) + conv_b
    blocks = xc.reshape(B, T, LRU_BLOCKS, LRU_BLOCK)
    gate_r = jax.nn.sigmoid((jnp.einsum('btni,nij->btnj', blocks, wa).reshape(B, T, C) + ba).astype(f32))
    gate_i = jax.nn.sigmoid((jnp.einsum('btni,nij->btnj', blocks, wx).reshape(B, T, C) + bx).astype(f32))
    log_a = -LRU_C * gate_r * jax.nn.softplus(-lam.astype(f32))
    a = jnp.exp(log_a)
    u = jnp.sqrt(-jnp.expm1(2.0 * log_a)) * gate_i * xc.astype(f32)

    def combine(left, right):
        al, bl = left
        ar, br = right
        return al * ar, ar * bl + br

    _, h = lax.associative_scan(combine, (a, u), axis=1)
    return (h * jax.nn.gelu(gb.astype(f32))).astype(xb.dtype)


def gla_chunk(state, q, k, v, log_a):
    L = q.shape[2]
    cum = jnp.cumsum(log_a, axis=2)
    causal = jnp.tril(jnp.ones((L, L), dtype=bool))
    diff = cum[:, :, :, None, :] - cum[:, :, None, :, :]
    decay = jnp.where(causal[:, :, None], jnp.exp(jnp.minimum(diff, 0.0)), 0.0)
    scores = jnp.einsum('bhtk,bhsk,bhtsk->bhts', q, k, decay)
    out = jnp.einsum('bhts,bhsv->bhtv', scores, v) + jnp.einsum('bhtk,bhkv->bhtv', q * jnp.exp(cum), state)
    last = cum[:, :, -1:, :]
    new_state = state * jnp.exp(last)[:, :, 0, :, None] + jnp.einsum('bhsk,bhsv->bhkv', k * jnp.exp(last - cum), v)
    return new_state, out


def gla_mix(p, g_up, g_b, head_gain):
    B, T, _ = p.shape
    f32 = jnp.float32
    kw, vw = GLA_KEY_WIDTH, GLA_VAL_WIDTH
    q, k, v, gd, r = jnp.split(p, [kw, 2 * kw, 2 * kw + vw, 2 * kw + vw + GLA_LORA], axis=-1)
    log_a = jax.nn.log_sigmoid((gd @ g_up + g_b).astype(f32)) / GLA_TAU
    heads = lambda t, d: jnp.transpose(t.astype(f32).reshape(B, T, GLA_HEADS, d), (0, 2, 1, 3))
    q = heads(q, GLA_DK) * (GLA_DK ** -0.5)
    k = heads(k, GLA_DK)
    v = heads(v, GLA_DV)
    log_a = heads(log_a, GLA_DK)
    state = jnp.zeros((B, GLA_HEADS, GLA_DK, GLA_DV), f32)
    state, out_meta = gla_chunk(state, q[:, :, :N_META], k[:, :, :N_META], v[:, :, :N_META], log_a[:, :, :N_META])
    n_chunks = (T - N_META) // GLA_CHUNK
    chunked = lambda t: jnp.moveaxis(t[:, :, N_META:].reshape(B, GLA_HEADS, n_chunks, GLA_CHUNK, t.shape[-1]), 2, 0)
    _, out_rest = lax.scan(lambda s, c: gla_chunk(s, *c), state, (chunked(q), chunked(k), chunked(v), chunked(log_a)))
    out_rest = jnp.moveaxis(out_rest, 0, 2).reshape(B, GLA_HEADS, T - N_META, GLA_DV)
    o = jnp.concatenate([out_meta, out_rest], axis=2).transpose(0, 2, 1, 3)
    o = o * lax.rsqrt(jnp.mean(o * o, axis=-1, keepdims=True) + NORM_EPS)
    o = o.reshape(B, T, vw) * head_gain.astype(f32) * jax.nn.silu(r.astype(f32))
    return o.astype(p.dtype)


def hier_moe(h, w_group, b_group, w_router, b_router, w_gate, w_up, w_down):
    B, T, D = h.shape
    hf = h.reshape(B * T, D)
    g_logits = (hf @ w_group + b_group).astype(jnp.float32)
    g_idx = jnp.argmax(g_logits, axis=-1)
    g_prob = jnp.take_along_axis(jax.nn.softmax(g_logits, axis=-1), g_idx[:, None], axis=-1)
    e_logits = (hf @ w_router + b_router).astype(jnp.float32).reshape(-1, N_GROUPS, EXPERTS_PER_GROUP)
    e_logits = jnp.take_along_axis(e_logits, g_idx[:, None, None], axis=1)[:, 0]
    top_val, top_idx = lax.top_k(e_logits, TOP_K)
    weights = jax.nn.softmax(top_val, axis=-1) * g_prob
    expert_idx = g_idx[:, None] * EXPERTS_PER_GROUP + top_idx
    combine = jnp.sum(jax.nn.one_hot(expert_idx, N_EXPERTS, dtype=jnp.float32) * weights[..., None], axis=1).astype(h.dtype)
    y = jnp.zeros_like(hf)
    for e in range(N_EXPERTS):
        hid = jax.nn.silu(hf @ w_gate[e]) * (hf @ w_up[e])
        y = y + (hid @ w_down[e]) * combine[:, e:e + 1]
    return y.reshape(B, T, D)


def setup_inputs(seed: int = 0) -> dict:
    key = jax.random.key(seed)
    ks = iter(jax.random.split(key, 48))
    nrm = lambda shape, scale: jax.random.normal(next(ks), shape, jnp.float32) * scale
    unif = lambda shape, lo, hi: jax.random.uniform(next(ks), shape, jnp.float32, lo, hi)
    E, O, Ld, D = N_EVEN, N_ODD, DEPTH, D_MODEL
    a_pow = unif((E, LRU_WIDTH), 0.9, 0.999) ** (1.0 / LRU_C)
    return {
        'x': nrm((BATCH, SEQ, D), 1.0),
        'meta': nrm((N_META, D), 1.0),
        'e_norm': 1.0 + nrm((E, D), 0.02),
        'e_w_in': nrm((E, D, EVEN_IN), D ** -0.5),
        'e_mu': unif((E, RWKV_IN), 0.0, 1.0),
        'e_decay0': unif((E, RWKV_WIDTH), -6.0, -1.0),
        'e_decay_up': nrm((E, LORA_W, RWKV_WIDTH), 0.1 * LORA_W ** -0.5),
        'e_iclr0': nrm((E, RWKV_WIDTH), 0.5),
        'e_iclr_up': nrm((E, LORA_A, RWKV_WIDTH), 0.1 * LORA_A ** -0.5),
        'e_gate_up': nrm((E, LORA_G, RWKV_WIDTH), LORA_G ** -0.5),
        'e_k_k': 0.85 + nrm((E, RWKV_WIDTH), 0.02),
        'e_k_a': 1.0 + nrm((E, RWKV_WIDTH), 0.02),
        'e_r_k': nrm((E, RWKV_WIDTH), 0.1),
        'e_ln_g': 1.0 + nrm((E, RWKV_WIDTH), 0.02),
        'e_ln_b': nrm((E, RWKV_WIDTH), 0.01),
        'e_conv_w': nrm((E, CONV_WIDTH, LRU_WIDTH), CONV_WIDTH ** -0.5),
        'e_conv_b': nrm((E, LRU_WIDTH), 0.01),
        'e_lru_wa': nrm((E, LRU_BLOCKS, LRU_BLOCK, LRU_BLOCK), LRU_BLOCK ** -0.5),
        'e_lru_ba': nrm((E, LRU_WIDTH), 0.01),
        'e_lru_wx': nrm((E, LRU_BLOCKS, LRU_BLOCK, LRU_BLOCK), LRU_BLOCK ** -0.5),
        'e_lru_bx': nrm((E, LRU_WIDTH), 0.01),
        'e_lru_lambda': jnp.log(a_pow) - jnp.log1p(-a_pow),
        'e_w_out': nrm((E, EVEN_MIX, D), EVEN_MIX ** -0.5),
        'o_norm': 1.0 + nrm((O, D), 0.02),
        'o_w_in': nrm((O, D, ODD_IN), D ** -0.5),
        'o_g_up': nrm((O, GLA_LORA, GLA_KEY_WIDTH), GLA_LORA ** -0.5),
        'o_g_b': nrm((O, GLA_KEY_WIDTH), 0.1),
        'o_head_gain': 1.0 + nrm((O, GLA_VAL_WIDTH), 0.02),
        'o_w_out': nrm((O, GLA_VAL_WIDTH, D), GLA_VAL_WIDTH ** -0.5),
        'm_norm': 1.0 + nrm((Ld, D), 0.02),
        'm_w_group': nrm((Ld, D, N_GROUPS), D ** -0.5),
        'm_b_group': nrm((Ld, N_GROUPS), 0.01),
        'm_w_router': nrm((Ld, D, N_EXPERTS), D ** -0.5),
        'm_b_router': nrm((Ld, N_EXPERTS), 0.01),
        'm_w_gate': nrm((Ld, N_EXPERTS, D, EXPERT_FF), D ** -0.5),
        'm_w_up': nrm((Ld, N_EXPERTS, D, EXPERT_FF), D ** -0.5),
        'm_w_down': nrm((Ld, N_EXPERTS, EXPERT_FF, D), EXPERT_FF ** -0.5),
        'final_norm': 1.0 + nrm((D,), 0.02),
    }


def reference(x, meta, e_norm, e_w_in, e_mu, e_decay0, e_decay_up, e_iclr0, e_iclr_up, e_gate_up,
              e_k_k, e_k_a, e_r_k, e_ln_g, e_ln_b, e_conv_w, e_conv_b, e_lru_wa, e_lru_ba, e_lru_wx,
              e_lru_bx, e_lru_lambda, e_w_out, o_norm, o_w_in, o_g_up, o_g_b, o_head_gain, o_w_out,
              m_norm, m_w_group, m_b_group, m_w_router, m_b_router, m_w_gate, m_w_up, m_w_down,
              final_norm):
    B = x.shape[0]
    h = jnp.concatenate([jnp.broadcast_to(meta[None].astype(x.dtype), (B, N_META, x.shape[-1])), x], axis=1)
    for layer in range(DEPTH):
        i = layer // 2
        if layer % 2 == 0:
            p = rms_norm(h, e_norm[i]) @ e_w_in[i]
            y_a = rwkv7_mix(p[..., :RWKV_IN], e_mu[i], e_decay0[i], e_decay_up[i], e_iclr0[i], e_iclr_up[i],
                            e_gate_up[i], e_k_k[i], e_k_a[i], e_r_k[i], e_ln_g[i], e_ln_b[i])
            y_b = rglru_mix(p[..., RWKV_IN:RWKV_IN + LRU_WIDTH], p[..., RWKV_IN + LRU_WIDTH:],
                            e_conv_w[i], e_conv_b[i], e_lru_wa[i], e_lru_ba[i], e_lru_wx[i], e_lru_bx[i],
                            e_lru_lambda[i])
            h = h + jnp.concatenate([y_a, y_b], axis=-1) @ e_w_out[i]
        else:
            p = rms_norm(h, o_norm[i]) @ o_w_in[i]
            h = h + gla_mix(p, o_g_up[i], o_g_b[i], o_head_gain[i]) @ o_w_out[i]
        h = h + hier_moe(rms_norm(h, m_norm[layer]), m_w_group[layer], m_b_group[layer], m_w_router[layer],
                         m_b_router[layer], m_w_gate[layer], m_w_up[layer], m_w_down[layer])
    return rms_norm(h[:, N_META:], final_norm)
```

```cpp
#include <hip/hip_runtime.h>
#include <stdint.h>
#include <stdio.h>

typedef unsigned short bf16_t;
typedef short bf16x8 __attribute__((ext_vector_type(8)));
typedef float f32x4 __attribute__((ext_vector_type(4)));
typedef unsigned u32x4 __attribute__((ext_vector_type(4)));
typedef unsigned u32x2 __attribute__((ext_vector_type(2)));
#define LAS __attribute__((address_space(3)))
typedef LAS float lfloat;
typedef LAS int lint;

#ifndef ONE_LAUNCH
#define ONE_LAUNCH 0
#endif

constexpr int BATCH = 8, SEQ = 8192, DM = 1024, NMETA = 16, TT = SEQ + NMETA  , TP = 8256  , NP = BATCH * TP  , NTOK = BATCH * TT;
constexpr int NCH = TP / 64;
constexpr int EVEN_IN = 2816, ODD_IN = 3088, ODD_IN_PAD = 3328;
constexpr int MCAP = 65792;
constexpr int NTHREADS = 512;
constexpr int LDS_BYTES = 155648;
constexpr int LDS_PH = 64;
constexpr int LDS_MISC = 64 + 131072;

constexpr size_t WS_CTL = 0;
constexpr size_t WS_H = 32768;
constexpr size_t WS_P = WS_H + (size_t)NP * 1024 * 4;
constexpr size_t WS_Y = WS_P + (size_t)NP * ODD_IN * 2;
constexpr size_t WS_HN = WS_Y + (size_t)NP * 1024 * 2;
constexpr size_t WS_WINE = WS_HN + (size_t)NP * 1024 * 2;
constexpr size_t WS_WOUTE = WS_WINE + (size_t)EVEN_IN * 1024 * 2;
constexpr size_t WS_WINO = WS_WOUTE + (size_t)1024 * 1024 * 2;
constexpr size_t WS_WOUTO = WS_WINO + (size_t)ODD_IN_PAD * 1024 * 2;
constexpr size_t WS_W1 = WS_WOUTO + (size_t)1024 * 1024 * 2;
constexpr size_t WS_W2 = WS_W1 + (size_t)2 * 32 * 512 * 1024 * 2;
constexpr size_t WS_WRT = WS_W2 + (size_t)2 * 32 * 1024 * 256 * 2;
constexpr size_t WS_END = WS_WRT + (size_t)2 * 36 * 1024 * 4;
constexpr size_t PO_YM = 0;
constexpr size_t PO_HID = (size_t)2 * NP * 1024 * 2;
constexpr size_t PO_LIST = PO_HID + (size_t)(2 * NTOK + 32 * 256) * 256 * 2;
constexpr size_t PO_LW = PO_LIST + (size_t)32 * MCAP * 4;
constexpr size_t PO_END = PO_LW + (size_t)32 * MCAP * 4;
static_assert(PO_END <= (size_t)NP * EVEN_IN * 2, "MoE scratch must fit the P region");
constexpr size_t DO_LRUA = 0;
constexpr size_t DO_LRUH = DO_LRUA + (size_t)BATCH * NCH * 512 * 4;
constexpr size_t DO_LRUC = DO_LRUH + (size_t)BATCH * NCH * 512 * 4;
constexpr size_t DO_GLAG = DO_LRUC + (size_t)BATCH * NCH * 512 * 4;
constexpr size_t DO_END = DO_GLAG + (size_t)BATCH * 4 * NCH * 128 * 4;
static_assert(DO_END <= (size_t)BATCH * SEQ * DM * 4, "d_out scratch");

#define XB_TMO      128
#define XB_XCNT(j)  (256  + 64 * (j))
#define XB_XSUB(j)  (1280 + 64 * (j))
#define XB_XGEN(j)  (2304 + 64 * (j))
#define XB_TOP      3328
#define XB_TOPGEN   3392
#define XCD_BAR_WORDS 3456
#define XB_SPIN_CAP (1u << 22)

__device__ __forceinline__ unsigned xb_ld(unsigned* p)              { return __hip_atomic_load(p, __ATOMIC_RELAXED, __HIP_MEMORY_SCOPE_AGENT); }
__device__ __forceinline__ unsigned xb_add(unsigned* p, unsigned v) { return __hip_atomic_fetch_add(p, v, __ATOMIC_RELAXED, __HIP_MEMORY_SCOPE_AGENT); }
__device__ __forceinline__ unsigned xb_xcc_id() { return (unsigned)__builtin_amdgcn_s_getreg((3 << 11) | 20) & 0xFu; }
#define XB_SPIN(cond, bar) do { unsigned _sp = 0; while (cond) { __builtin_amdgcn_s_sleep(1); \
    if ((++_sp & 255u) == 0u) { if (xb_ld(&(bar)[XB_TMO])) break; if (_sp > XB_SPIN_CAP) { atomicAdd(&(bar)[XB_TMO], 1u); break; } } } } while (0)

struct XcdBarrier { unsigned* bar; unsigned x; volatile LAS unsigned* st; };

__device__ __forceinline__ XcdBarrier xcd_barrier_post(unsigned* bar, volatile LAS unsigned* st) {
    XcdBarrier b; b.bar = bar; b.x = xb_xcc_id(); b.st = st;
    if (threadIdx.x == 0) (void)xb_add(&bar[XB_XCNT(b.x)], 1u);
    return b;
}
__device__ __forceinline__ void xcd_barrier_complete(unsigned* bar, unsigned x, unsigned& nloc, unsigned& nx) {
    const unsigned G = gridDim.x * gridDim.y * gridDim.z;
    unsigned sum, cnt, mine, sp = 0u;
    for (;;) {
        sum = 0u; cnt = 0u; mine = 0u;
#pragma unroll
        for (unsigned j = 0; j < 16; ++j) { const unsigned c = xb_ld(&bar[XB_XCNT(j)]); sum += c; cnt += (c > 0u) ? 1u : 0u; mine = (j == x) ? c : mine; }
        if (sum == G) break;
        __builtin_amdgcn_s_sleep(1);
        if ((++sp & 255u) == 0u) { if (xb_ld(&bar[XB_TMO])) break; if (sp > XB_SPIN_CAP) { atomicAdd(&bar[XB_TMO], 1u); break; } }
    }
    nloc = mine > 0u ? mine : 1u; nx = cnt > 0u ? cnt : 1u;
}
__device__ __forceinline__ void xcd_barrier(const XcdBarrier& b) {
    asm volatile("s_waitcnt vmcnt(0)" ::: "memory");
    __syncthreads();
    if (threadIdx.x == 0) {
        unsigned* bar = b.bar;
        __builtin_amdgcn_s_waitcnt(0);
        unsigned nloc = b.st[0], nx = b.st[1];
        if (nloc == 0u) { xcd_barrier_complete(bar, b.x, nloc, nx); b.st[0] = nloc; b.st[1] = nx; }
        const unsigned old = xb_add(&bar[XB_XSUB(b.x)], 1u);
        const unsigned gen = old / nloc;
        if (old + 1u == (gen + 1u) * nloc) {
            __builtin_amdgcn_fence(__ATOMIC_RELEASE, "agent");
            asm volatile("s_waitcnt vmcnt(0)" ::: "memory");
            const unsigned og = xb_add(&bar[XB_TOP], 1u);
            const unsigned tg = og / nx;
            if (og + 1u == (tg + 1u) * nx) xb_add(&bar[XB_TOPGEN], 1u);
            else XB_SPIN(xb_ld(&bar[XB_TOPGEN]) == tg, bar);
            __builtin_amdgcn_fence(__ATOMIC_ACQUIRE, "agent");
            xb_add(&bar[XB_XGEN(b.x)], 1u);
            asm volatile("s_waitcnt vmcnt(0)" ::: "memory");
        } else {
            XB_SPIN(xb_ld(&bar[XB_XGEN(b.x)]) == gen, bar);
            __builtin_amdgcn_fence(__ATOMIC_ACQUIRE, "agent");
            asm volatile("s_waitcnt vmcnt(0)" ::: "memory");
        }
    }
    __syncthreads();
}

struct Params {
    const float* in[38];
    float* out;
    unsigned char* ws;
};
enum { I_X = 0, I_META, I_ENORM, I_EWIN, I_EMU, I_EDECAY0, I_EDECAYUP, I_EICLR0, I_EICLRUP, I_EGATEUP, I_EKK, I_EKA, I_ERK, I_ELNG, I_ELNB,
       I_ECONVW, I_ECONVB, I_ELRUWA, I_ELRUBA, I_ELRUWX, I_ELRUBX, I_ELAMBDA, I_EWOUT, I_ONORM, I_OWIN, I_OGUP, I_OGB, I_OHEADGAIN, I_OWOUT,
       I_MNORM, I_MWGROUP, I_MBGROUP, I_MWROUTER, I_MBROUTER, I_MWGATE, I_MWUP, I_MWDOWN, I_FINALNORM };

__device__ __forceinline__ bf16_t f2bf(float f) { unsigned u = __float_as_uint(f); u += 0x7FFFu + ((u >> 16) & 1u); return (bf16_t)(u >> 16); }
__device__ __forceinline__ float bf2f(unsigned b) { return __uint_as_float(b << 16); }
__device__ __forceinline__ unsigned pack2(float lo, float hi) { return (unsigned)f2bf(lo) | ((unsigned)f2bf(hi) << 16); }
__device__ __forceinline__ void unpack8(const u32x4 v, float* o) {
    o[0] = bf2f(v.x & 0xffffu); o[1] = bf2f(v.x >> 16); o[2] = bf2f(v.y & 0xffffu); o[3] = bf2f(v.y >> 16);
    o[4] = bf2f(v.z & 0xffffu); o[5] = bf2f(v.z >> 16); o[6] = bf2f(v.w & 0xffffu); o[7] = bf2f(v.w >> 16);
}
__device__ __forceinline__ u32x4 pack8(const float* o) { u32x4 w; w.x = pack2(o[0], o[1]); w.y = pack2(o[2], o[3]); w.z = pack2(o[4], o[5]); w.w = pack2(o[6], o[7]); return w; }
__device__ __forceinline__ float wave_sum(float v) {
#pragma unroll
    for (int o = 32; o > 0; o >>= 1) v += __shfl_xor(v, o);
    return v;
}
__device__ __forceinline__ float sum8(float v) { v += __shfl_xor(v, 1); v += __shfl_xor(v, 2); v += __shfl_xor(v, 4); return v; }
__device__ __forceinline__ float sigmoidf_(float x) { return 1.0f / (1.0f + __expf(-x)); }
__device__ __forceinline__ float softplusf_(float x) { return fmaxf(x, 0.f) + log1pf(__expf(-fabsf(x))); }

namespace pg8 {
constexpr int BM = 256, BK = 64, HALF = 128, HTB = HALF * BK * 2, STAGE_BYTES = 8 * HTB;
__device__ __forceinline__ int lds_byte(int r, int c) { const int st = (r >> 4) * 2 + (c >> 5), rr = r & 15, cc = c & 31, ob = rr * 64 + cc * 2; return st * 1024 + (ob ^ (((ob >> 9) & 1) << 5)); }
__device__ __forceinline__ void stage_rc(int b, int& R, int& C) { const int st = b / 1024, sb = b % 1024, swz = sb ^ (((sb >> 9) & 1) << 5); R = (st >> 1) * 16 + swz / 64; C = (st & 1) * 32 + (swz % 64) / 2; }
__device__ __forceinline__ int perm32(int rho) { const int n = rho >> 4, i = rho & 15; return 8 * (i >> 2) + 4 * n + (i & 3); }
__device__ __forceinline__ unsigned cvt_pk_bf16(float lo, float hi) { unsigned r; asm volatile("v_cvt_pk_bf16_f32 %0, %1, %2" : "=v"(r) : "v"(lo), "v"(hi)); return r; }

struct Unit { const char* b; int row0, col0, cnt, lrow; };

struct DenseOrder {
    int nM, nN, nwg, G, c, K; const char* Bt;
    __device__ void init(int M, int N, int K_, const void* Bt_, int G_, int c_) { nM = M / BM; nN = N / BM; nwg = nM * nN; G = G_; c = c_; K = K_; Bt = (const char*)Bt_; }
    __device__ __forceinline__ bool next(int i, Unit& u) const {
        const long L = (long)i * G + c; if (L >= nwg) return false;
        int wgid = (int)L; { const int q = nwg / 8, r = nwg % 8, xcd = wgid % 8, off = wgid / 8; wgid = (xcd < r ? xcd * (q + 1) : r * (q + 1) + (xcd - r) * q) + off; }
        const int nig = 8 * nN, gid = wgid / nig, fm = gid * 8, gsz = (nM - fm) < 8 ? (nM - fm) : 8;
        const int pm = fm + ((wgid % nig) % gsz), pn = (wgid % nig) / gsz;
        u.row0 = pm * BM; u.col0 = pn * BM; u.b = Bt + (size_t)pn * BM * K * 2; u.cnt = BM; u.lrow = 0; return true;
    }
    __device__ __forceinline__ unsigned arow(const Unit& u, int r) const { return (unsigned)(u.row0 + r); }
};
struct MoeOrder {
    const LAS int* tstart; const int* cnt; const int* list; const char* W; size_t wstride; int npn, G, c, K, gather;
    __device__ __forceinline__ bool next(int i, Unit& u) const {
        const int L = i * G + c; const int total = tstart[32] * npn; if (L >= total) return false;
        const int tile = L / npn, pn = L - tile * npn;
        int e = 0;
#pragma unroll 1
        for (int k = 1; k < 32; ++k) e = (tstart[k] <= tile) ? k : e;
        const int j = tile - tstart[e];
        int c2 = cnt[e] - 256 * j; u.cnt = c2 > 256 ? 256 : c2; u.lrow = e * MCAP + 256 * j; u.row0 = tile * 256; u.col0 = pn * 256;
        u.b = W + (size_t)e * wstride + (size_t)pn * 256 * K * 2; return true;
    }
    __device__ __forceinline__ unsigned arow(const Unit& u, int r) const {
        if (gather) return (r < u.cnt) ? (unsigned)(list[u.lrow + r] >> 1) : 0u;
        return (unsigned)(u.row0 + r);
    }
};

struct EpiStoreBf16 {
    static constexpr bool PERM = true;
    bf16_t* O; int ldc; int ncols;
    __device__ __forceinline__ void operator()(const f32x4 (&acc)[2][2][4][2], const Unit& u, int wr, int wc, int fr, int fq) const {
        const int row0 = u.row0 + wr * 64 + fr, col0 = u.col0 + wc * 32 + 8 * fq;
#pragma unroll
        for (int ai = 0; ai < 2; ++ai)
#pragma unroll
            for (int m = 0; m < 4; ++m) { bf16_t* rowp = O + (size_t)(row0 + ai * HALF + m * 16) * ldc + col0;
#pragma unroll
                for (int bj = 0; bj < 2; ++bj) { const f32x4 v0 = acc[ai][bj][m][0], v1 = acc[ai][bj][m][1];
                    u32x4 w; w.x = cvt_pk_bf16(v0[0], v0[1]); w.y = cvt_pk_bf16(v0[2], v0[3]); w.z = cvt_pk_bf16(v1[0], v1[1]); w.w = cvt_pk_bf16(v1[2], v1[3]);
                    if (col0 + bj * HALF < ncols) *(u32x4*)(rowp + bj * HALF) = w; } }
    }
};
struct EpiResid {
    static constexpr bool PERM = false;
    float* H;
    __device__ __forceinline__ void operator()(const f32x4 (&acc)[2][2][4][2], const Unit& u, int wr, int wc, int fr, int fq) const {
        const int row0 = u.row0 + wr * 64 + fr, col0 = u.col0 + wc * 32 + 4 * fq;
#pragma unroll
        for (int ai = 0; ai < 2; ++ai)
#pragma unroll
            for (int m = 0; m < 4; ++m) { float* rowp = H + (size_t)(row0 + ai * HALF + m * 16) * 1024 + col0;
#pragma unroll
                for (int bj = 0; bj < 2; ++bj)
#pragma unroll
                    for (int n = 0; n < 2; ++n) { f32x4* q = (f32x4*)(rowp + bj * HALF + n * 16); *q = *q + acc[ai][bj][m][n]; } }
    }
};
struct EpiSwiglu {
    static constexpr bool PERM = false;
    bf16_t* HID;
    __device__ __forceinline__ void operator()(const f32x4 (&acc)[2][2][4][2], const Unit& u, int wr, int wc, int fr, int fq) const {
        const int row0 = u.row0 + wr * 64 + fr, hc0 = (u.col0 >> 1) + wc * 32 + 4 * fq;
#pragma unroll
        for (int ai = 0; ai < 2; ++ai)
#pragma unroll
            for (int m = 0; m < 4; ++m) { bf16_t* rowp = HID + (size_t)(row0 + ai * HALF + m * 16) * 256 + hc0;
#pragma unroll
                for (int n = 0; n < 2; ++n) { const f32x4 g = acc[ai][0][m][n], up = acc[ai][1][m][n]; float h[4];
#pragma unroll
                    for (int q = 0; q < 4; ++q) h[q] = g[q] / (1.0f + __expf(-g[q])) * up[q];
                    u32x2 w; w.x = cvt_pk_bf16(h[0], h[1]); w.y = cvt_pk_bf16(h[2], h[3]); *(u32x2*)(rowp + n * 16) = w; } }
    }
};
struct EpiScatter {
    static constexpr bool PERM = true;
    bf16_t* YM; const int* list; const float* lw;
    __device__ __forceinline__ void operator()(const f32x4 (&acc)[2][2][4][2], const Unit& u, int wr, int wc, int fr, int fq) const {
        const int r0 = wr * 64 + fr, col0 = u.col0 + wc * 32 + 8 * fq;
#pragma unroll
        for (int ai = 0; ai < 2; ++ai)
#pragma unroll
            for (int m = 0; m < 4; ++m) { const int r = r0 + ai * HALF + m * 16;
                if (r < u.cnt) { const int ent = list[u.lrow + r]; const float wgt = lw[u.lrow + r]; bf16_t* rowp = YM + (size_t)ent * 1024 + col0;
#pragma unroll
                    for (int bj = 0; bj < 2; ++bj) { const f32x4 v0 = acc[ai][bj][m][0] * wgt, v1 = acc[ai][bj][m][1] * wgt;
                        u32x4 w; w.x = cvt_pk_bf16(v0[0], v0[1]); w.y = cvt_pk_bf16(v0[2], v0[3]); w.z = cvt_pk_bf16(v1[0], v1[1]); w.w = cvt_pk_bf16(v1[2], v1[3]);
                        *(u32x4*)(rowp + bj * HALF) = w; } } }
    }
};

template <class Epi, class Sched>
__device__ __forceinline__ void gemm_phase(LAS unsigned char* lds, const char* Abase, const int K, const Sched& S, const Epi& E) {
    const int tid = threadIdx.x, wid = __builtin_amdgcn_readfirstlane(tid >> 6), lane = tid & 63, wr = wid >> 2, wc = wid & 3, fr = lane & 15, fq = lane >> 4;
    const int nt = K / BK;
    int RA[2]; unsigned CA[2], voffB[2];
#pragma unroll
    for (int i = 0; i < 2; ++i) { int R, C; stage_rc(tid * 16 + i * 8192, R, C); const int Rb = Epi::PERM ? ((R & ~31) + perm32(R & 31)) : R;
        RA[i] = R; CA[i] = (unsigned)C * 2u; voffB[i] = (unsigned)(Rb * K + C) * 2u; }
    const size_t kstep = (size_t)(BK * 2);
    const size_t hstep = (size_t)HALF * K * 2;
    const unsigned rowb = (unsigned)K * 2u;
    const unsigned ldsw = (unsigned)wid * 1024u;
    const int aoff = lds_byte(wr * 64 + fr, fq * 8), boff = lds_byte(wc * 32 + fr, fq * 8);
#define PG8_SA(b, h) (((b) * 2 + (h)) * HTB)
#define PG8_SB(b, h) ((4 + (b) * 2 + (h)) * HTB)
#define PG8_STAGE_B(bufoff, gbase) do { _Pragma("unroll") for (int _i = 0; _i < 2; ++_i) \
        __builtin_amdgcn_global_load_lds((const unsigned*)((const char*)(gbase) + voffB[_i]), (LAS unsigned*)(lds + (bufoff) + ldsw + _i * 8192), 16, 0, 0); } while (0)
#define PG8_STAGE_A(bufoff, OFF, h, kb) do { _Pragma("unroll") for (int _i = 0; _i < 2; ++_i) \
        __builtin_amdgcn_global_load_lds((const unsigned*)(Abase + (size_t)(kb) + (OFF)[h][_i]), (LAS unsigned*)(lds + (bufoff) + ldsw + _i * 8192), 16, 0, 0); } while (0)
#define PG8_LDA(dst, b, h) do { _Pragma("unroll") for (int m = 0; m < 4; ++m) _Pragma("unroll") for (int k = 0; k < 2; ++k) dst[m][k] = *(const LAS bf16x8*)(lds + PG8_SA(b, h) + aoff + m * 2048 + k * 1024); } while (0)
#define PG8_LDB(dst, b, h) do { _Pragma("unroll") for (int n = 0; n < 2; ++n) _Pragma("unroll") for (int k = 0; k < 2; ++k) dst[n][k] = *(const LAS bf16x8*)(lds + PG8_SB(b, h) + boff + n * 2048 + k * 1024); } while (0)
#define PG8_MMA(ai, bj, At, Bt) do { __builtin_amdgcn_s_setprio(1); _Pragma("unroll") for (int m = 0; m < 4; ++m) _Pragma("unroll") for (int n = 0; n < 2; ++n) _Pragma("unroll") for (int k = 0; k < 2; ++k) \
        acc[ai][bj][m][n] = __builtin_amdgcn_mfma_f32_16x16x32_bf16(Bt[n][k], At[m][k], acc[ai][bj][m][n], 0, 0, 0); __builtin_amdgcn_s_setprio(0); } while (0)
#define PG8_WAIT_V(n) asm volatile("s_waitcnt vmcnt(" #n ")" ::: "memory")
#define PG8_WAIT_L(n) asm volatile("s_waitcnt lgkmcnt(" #n ")" ::: "memory")
#define PG8_BAR __builtin_amdgcn_s_barrier()
#define PG8_SCHED __builtin_amdgcn_sched_barrier(0)
    Unit cur, nxt; int ui = 0;
    if (!S.next(0, cur)) return;
    unsigned oc[2][2], on[2][2];
#pragma unroll
    for (int h = 0; h < 2; ++h)
#pragma unroll
        for (int i = 0; i < 2; ++i) oc[h][i] = S.arow(cur, h * HALF + RA[i]) * rowb + CA[i];
    f32x4 acc[2][2][4][2];
#pragma unroll
    for (int a = 0; a < 2; ++a)
#pragma unroll
        for (int b = 0; b < 2; ++b)
#pragma unroll
            for (int m = 0; m < 4; ++m)
#pragma unroll
                for (int n = 0; n < 2; ++n) acc[a][b][m][n] = (f32x4){0.f, 0.f, 0.f, 0.f};
    bf16x8 At[4][2], B0[2][2], B1[2][2];
    const char* cB = cur.b;
    PG8_STAGE_B(PG8_SB(0, 0), cB); PG8_STAGE_A(PG8_SA(0, 0), oc, 0, 0); PG8_STAGE_B(PG8_SB(0, 1), cB + hstep); PG8_STAGE_A(PG8_SA(0, 1), oc, 1, 0);
    if (wr == 1) PG8_BAR;
    PG8_WAIT_V(4); PG8_BAR;
    PG8_STAGE_B(PG8_SB(1, 0), cB + kstep); PG8_STAGE_A(PG8_SA(1, 0), oc, 0, kstep); PG8_STAGE_B(PG8_SB(1, 1), cB + hstep + kstep);
    PG8_WAIT_V(6); PG8_BAR;
    for (;;) {
        const bool has_next = S.next(ui + 1, nxt);
        const char* nB = has_next ? nxt.b : cB;
#pragma unroll
        for (int h = 0; h < 2; ++h)
#pragma unroll
            for (int i = 0; i < 2; ++i) on[h][i] = has_next ? (S.arow(nxt, h * HALF + RA[i]) * rowb + CA[i]) : oc[h][i];
        for (int t = 0; t < nt; t += 2) {
            const bool last = (t == nt - 2);
            const size_t k1 = (size_t)(t + 1) * kstep;
            const size_t k2 = last ? (size_t)0 : (size_t)(t + 2) * kstep, k3 = k2 + kstep;
            const char* b2 = last ? nB : cB + (size_t)(t + 2) * kstep; const char* b3 = b2 + kstep;
            unsigned o2[2][2];
#pragma unroll
            for (int h = 0; h < 2; ++h)
#pragma unroll
                for (int i = 0; i < 2; ++i) o2[h][i] = last ? on[h][i] : oc[h][i];
            PG8_LDB(B0, 0, 0); PG8_SCHED; PG8_LDA(At, 0, 0); PG8_STAGE_A(PG8_SA(1, 1), oc, 1, k1);
            PG8_WAIT_L(8); PG8_BAR; PG8_WAIT_L(0); PG8_MMA(0, 0, At, B0); PG8_BAR; PG8_SCHED;
            PG8_LDB(B1, 0, 1); PG8_STAGE_B(PG8_SB(0, 0), b2);
            PG8_BAR; PG8_WAIT_L(0); PG8_MMA(0, 1, At, B1); PG8_BAR;
            PG8_LDA(At, 0, 1); PG8_STAGE_A(PG8_SA(0, 0), o2, 0, k2);
            PG8_BAR; PG8_WAIT_L(0); PG8_MMA(1, 0, At, B0); PG8_BAR; PG8_SCHED;
            PG8_STAGE_B(PG8_SB(0, 1), b2 + hstep);
            PG8_WAIT_V(6); PG8_BAR; PG8_MMA(1, 1, At, B1); PG8_BAR;
            PG8_LDB(B0, 1, 0); PG8_SCHED; PG8_LDA(At, 1, 0); PG8_STAGE_A(PG8_SA(0, 1), o2, 1, k2);
            PG8_WAIT_L(8); PG8_BAR; PG8_WAIT_L(0); PG8_MMA(0, 0, At, B0); PG8_BAR; PG8_SCHED;
            PG8_LDB(B1, 1, 1); PG8_STAGE_B(PG8_SB(1, 0), b3);
            PG8_BAR; PG8_WAIT_L(0); PG8_MMA(0, 1, At, B1); PG8_BAR;
            PG8_LDA(At, 1, 1); PG8_STAGE_A(PG8_SA(1, 0), o2, 0, k3);
            PG8_BAR; PG8_WAIT_L(0); PG8_MMA(1, 0, At, B0); PG8_BAR; PG8_SCHED;
            PG8_STAGE_B(PG8_SB(1, 1), b3 + hstep);
            PG8_WAIT_V(6); PG8_BAR; PG8_MMA(1, 1, At, B1); PG8_BAR;
        }
        E(acc, cur, wr, wc, fr, fq);
        if (!has_next) break;
#pragma unroll
        for (int a = 0; a < 2; ++a)
#pragma unroll
            for (int b = 0; b < 2; ++b)
#pragma unroll
                for (int m = 0; m < 4; ++m)
#pragma unroll
                    for (int n = 0; n < 2; ++n) acc[a][b][m][n] = (f32x4){0.f, 0.f, 0.f, 0.f};
        cur = nxt; cB = nB; ++ui;
#pragma unroll
        for (int h = 0; h < 2; ++h)
#pragma unroll
            for (int i = 0; i < 2; ++i) oc[h][i] = on[h][i];
    }
    PG8_WAIT_V(0);
    if (wr == 0) PG8_BAR;
    PG8_BAR;
#undef PG8_SA
#undef PG8_SB
#undef PG8_STAGE_A
#undef PG8_STAGE_B
#undef PG8_LDA
#undef PG8_LDB
#undef PG8_MMA
#undef PG8_WAIT_V
#undef PG8_WAIT_L
#undef PG8_BAR
#undef PG8_SCHED
}
}

struct Ctx {
    const Params* p; LAS unsigned char* lds; int tid, lane, wave, G, bid;
    float* H; bf16_t* P; bf16_t* Y; bf16_t* HN; bf16_t *WinE, *WoutE, *WinO, *WoutO, *W1, *W2; float* WrT; int* mcnt;
    bf16_t* YM; bf16_t* HID; int* mlist; float* mlw;
    float *lruA, *lruH, *lruC, *glaG;
};

__device__ __forceinline__ void ph_prologue(const Ctx& c) {
    const Params& p = *c.p; const int tid = c.tid;
    lfloat* tile = (lfloat*)(c.lds + LDS_PH);
    constexpr int NJ_WINE = 16 * 44, NJ_WOUT = 256, NJ_WINO = 16 * 49, NJ_W1 = 64 * 128, NJ_W2 = 64 * 64;
    constexpr int J1 = NJ_WINE, J2 = J1 + NJ_WOUT, J3 = J2 + NJ_WINO, J4 = J3 + NJ_WOUT, J5 = J4 + NJ_W1, J6 = J5 + NJ_W2;
    for (int job = c.bid; job < J6; job += c.G) {
        const float* src; int lds_src, nvalid = 64; bf16_t* dst; int ldd;
        int j = job;
        if (j < J1) { const int kt = j / 44, nt = j % 44; src = p.in[I_EWIN] + (size_t)kt * 64 * EVEN_IN + nt * 64; lds_src = EVEN_IN; dst = c.WinE + (size_t)nt * 64 * 1024 + kt * 64; ldd = 1024; }
        else if (j < J2) { j -= J1; const int kt = j / 16, nt = j % 16; src = p.in[I_EWOUT] + (size_t)kt * 64 * 1024 + nt * 64; lds_src = 1024; dst = c.WoutE + (size_t)nt * 64 * 1024 + kt * 64; ldd = 1024; }
        else if (j < J3) { j -= J2; const int kt = j / 49, nt = j % 49; src = p.in[I_OWIN] + (size_t)kt * 64 * ODD_IN + nt * 64; lds_src = ODD_IN; nvalid = (ODD_IN - nt * 64) < 64 ? (ODD_IN - nt * 64) : 64;
            dst = c.WinO + (size_t)nt * 64 * 1024 + kt * 64; ldd = 1024; }
        else if (j < J4) { j -= J3; const int kt = j / 16, nt = j % 16; src = p.in[I_OWOUT] + (size_t)kt * 64 * 1024 + nt * 64; lds_src = 1024; dst = c.WoutO + (size_t)nt * 64 * 1024 + kt * 64; ldd = 1024; }
        else if (j < J5) { j -= J4; const int le = j / 128, r = j % 128, which = r / 64, r2 = r % 64, kt = r2 / 4, nt = r2 % 4;
            src = p.in[which ? I_MWUP : I_MWGATE] + (size_t)le * 1024 * 256 + (size_t)kt * 64 * 256 + nt * 64; lds_src = 256;
            const int row0 = (nt >> 1) * 256 + (nt & 1) * 64 + which * 128;
            dst = c.W1 + (size_t)le * 512 * 1024 + (size_t)row0 * 1024 + kt * 64; ldd = 1024; }
        else { j -= J5; const int le = j / 64, r = j % 64, kt = r / 16, nt = r % 16;
            src = p.in[I_MWDOWN] + (size_t)le * 256 * 1024 + (size_t)kt * 64 * 1024 + nt * 64; lds_src = 1024;
            dst = c.W2 + (size_t)le * 1024 * 256 + (size_t)nt * 64 * 256 + kt * 64; ldd = 256; }
#pragma unroll
        for (int i = 0; i < 2; ++i) { const int k = (tid >> 4) + 32 * i, n4 = (tid & 15) * 4;
            f32x4 v = (f32x4){0.f, 0.f, 0.f, 0.f};
            if (n4 < nvalid) v = *(const f32x4*)(src + (size_t)k * lds_src + n4);
            tile[k * 65 + n4 + 0] = v[0]; tile[k * 65 + n4 + 1] = v[1]; tile[k * 65 + n4 + 2] = v[2]; tile[k * 65 + n4 + 3] = v[3]; }
        __syncthreads();
        { const int n = tid >> 3, k8 = (tid & 7) * 8;
            if (n < nvalid) { float o[8];
#pragma unroll
                for (int q = 0; q < 8; ++q) o[q] = tile[(k8 + q) * 65 + n];
                *(u32x4*)(dst + (size_t)n * ldd + k8) = pack8(o); } }
        __syncthreads();
    }
    for (int idx = c.bid * NTHREADS + tid; idx < 2 * 36 * 1024; idx += c.G * NTHREADS) {
        const int l = idx / (36 * 1024), r = idx % (36 * 1024), e = r / 1024, k = r % 1024;
        c.WrT[idx] = e < 4 ? p.in[I_MWGROUP][((size_t)l * 1024 + k) * 4 + e] : p.in[I_MWROUTER][((size_t)l * 1024 + k) * 32 + (e - 4)];
    }
    for (int idx = c.bid * NTHREADS + tid; idx < (ODD_IN_PAD - ODD_IN) * 1024 / 8; idx += c.G * NTHREADS)
        *(u32x4*)(c.WinO + (size_t)ODD_IN * 1024 + (size_t)idx * 8) = (u32x4){0u, 0u, 0u, 0u};
    const float* gain = p.in[I_ENORM];
    for (int row = c.bid * 8 + c.wave; row < NP; row += c.G * 8) {
        const int b = row / TP, t = row % TP;
        float* hrow = c.H + (size_t)row * 1024; bf16_t* nrow = c.HN + (size_t)row * 1024;
        if (t >= TT) {
#pragma unroll
            for (int i = 0; i < 4; ++i) { *(f32x4*)(hrow + 4 * c.lane + 256 * i) = (f32x4){0.f, 0.f, 0.f, 0.f}; *(u32x2*)(nrow + 4 * c.lane + 256 * i) = (u32x2){0u, 0u}; }
            continue;
        }
        const float* src = t < NMETA ? p.in[I_META] + (size_t)t * 1024 : p.in[I_X] + ((size_t)b * SEQ + (t - NMETA)) * 1024;
        f32x4 v[4]; float ss = 0.f;
#pragma unroll
        for (int i = 0; i < 4; ++i) { v[i] = *(const f32x4*)(src + 4 * c.lane + 256 * i); ss += v[i][0] * v[i][0] + v[i][1] * v[i][1] + v[i][2] * v[i][2] + v[i][3] * v[i][3]; }
        ss = wave_sum(ss);
        const float s = rsqrtf(ss * (1.0f / 1024.0f) + 1e-6f);
#pragma unroll
        for (int i = 0; i < 4; ++i) { const f32x4 g = *(const f32x4*)(gain + 4 * c.lane + 256 * i);
            *(f32x4*)(hrow + 4 * c.lane + 256 * i) = v[i];
            u32x2 w; w.x = pack2(v[i][0] * s * g[0], v[i][1] * s * g[1]); w.y = pack2(v[i][2] * s * g[2], v[i][3] * s * g[3]);
            *(u32x2*)(nrow + 4 * c.lane + 256 * i) = w; }
    }
}

__device__ __forceinline__ float gelu_tanh(float x) { const float u = 0.7978845608028654f * (x + 0.044715f * x * x * x); return 0.5f * x * (1.0f + tanhf(u)); }
__device__ __forceinline__ void ph_lru(const Ctx& c, const bool final) {
    const Params& p = *c.p; const int tid = c.tid;
    lfloat* xin = (lfloat*)(c.lds + LDS_PH);
    lfloat* xc = xin + 67 * 64;
    lfloat* aa = xc + 64 * 64;
    lfloat* uu = aa + 64 * 64;
    const float* conv_w = p.in[I_ECONVW]; const float* conv_b = p.in[I_ECONVB];
    for (int u = c.bid; u < BATCH * NCH * 8; u += c.G) {
        const int b = u / (NCH * 8), rem = u % (NCH * 8), ch = rem / 8, n = rem % 8;
        const int t0 = ch * 64;
        for (int idx = tid; idx < 67 * 8; idx += NTHREADS) { const int i = idx >> 3, c8 = idx & 7, t = t0 - 3 + i;
            float o[8] = {0.f, 0.f, 0.f, 0.f, 0.f, 0.f, 0.f, 0.f};
            if (t >= 0 && t < TT) { const u32x4 v = *(const u32x4*)(c.P + ((size_t)b * TP + t) * EVEN_IN + 1792 + 64 * n + 8 * c8); unpack8(v, o); }
#pragma unroll
            for (int q = 0; q < 8; ++q) xin[i * 64 + 8 * c8 + q] = o[q]; }
        __syncthreads();
        const int i = tid >> 3, j8 = (tid & 7) * 8;
        {
#pragma unroll
            for (int q = 0; q < 8; ++q) { const int cg = 64 * n + j8 + q; float a = conv_b[cg];
#pragma unroll
                for (int j = 0; j < 4; ++j) a += conv_w[j * 512 + cg] * xin[(i + j) * 64 + j8 + q];
                xc[i * 64 + j8 + q] = a; } }
        __syncthreads();
        {
            float gr[8], gi[8];
#pragma unroll
            for (int q = 0; q < 8; ++q) { gr[q] = 0.f; gi[q] = 0.f; }
            const float* wa = p.in[I_ELRUWA] + (size_t)n * 4096 + j8; const float* wx = p.in[I_ELRUWX] + (size_t)n * 4096 + j8;
            for (int k = 0; k < 64; ++k) { const float x = xc[i * 64 + k];
                const f32x4 a0 = *(const f32x4*)(wa + k * 64), a1 = *(const f32x4*)(wa + k * 64 + 4), x0 = *(const f32x4*)(wx + k * 64), x1 = *(const f32x4*)(wx + k * 64 + 4);
#pragma unroll
                for (int q = 0; q < 4; ++q) { gr[q] += x * a0[q]; gr[4 + q] += x * a1[q]; gi[q] += x * x0[q]; gi[4 + q] += x * x1[q]; } }
#pragma unroll
            for (int q = 0; q < 8; ++q) { const int cg = 64 * n + j8 + q;
                const float g_r = sigmoidf_(gr[q] + p.in[I_ELRUBA][cg]), g_i = sigmoidf_(gi[q] + p.in[I_ELRUBX][cg]);
                const float log_a = -8.0f * g_r * softplusf_(-p.in[I_ELAMBDA][cg]);
                aa[i * 64 + j8 + q] = __expf(log_a);
                uu[i * 64 + j8 + q] = sqrtf(-expm1f(2.0f * log_a)) * g_i * xc[i * 64 + j8 + q]; }
        }
        __syncthreads();
        if (tid < 64) { const size_t si = ((size_t)b * NCH + ch) * 512 + 64 * n + tid;
            float h = final ? c.lruC[si] : 0.f, ap = 1.f;
            for (int k = 0; k < 64; ++k) { const float a = aa[k * 64 + tid]; h = a * h + uu[k * 64 + tid]; ap *= a; if (final) uu[k * 64 + tid] = h; }
            if (!final) { c.lruA[si] = ap; c.lruH[si] = h; } }
        __syncthreads();
        if (final) { const size_t row = (size_t)b * TP + t0 + i;
            const u32x4 gv = *(const u32x4*)(c.P + row * EVEN_IN + 2304 + 64 * n + j8); float g[8], o[8]; unpack8(gv, g);
#pragma unroll
            for (int q = 0; q < 8; ++q) o[q] = uu[i * 64 + j8 + q] * gelu_tanh(g[q]);
            *(u32x4*)(c.Y + row * 1024 + 512 + 64 * n + j8) = pack8(o);
            __syncthreads(); }
    }
}

__device__ __forceinline__ void ph_rwkv_naive(const Ctx& c) {
    const Params& p = *c.p; const int tid = c.tid;
    lfloat* L = (lfloat*)(c.lds + LDS_PH);
    lfloat* S_R = L, *S_K = L + 4096, *S_V = L + 2 * 4096, *S_W3 = L + 3 * 4096, *S_A4 = L + 4 * 4096, *S_G5 = L + 5 * 4096  , *S_LW = L + 7 * 4096, *S_A8 = L + 8 * 4096, *S_BON = L + 9 * 4096;
    for (int u = c.bid; u < 72; u += c.G) {
        if (u >= 64) {
            const int b = u - 64; float carry = 0.f;
            for (int ch = 0; ch < NCH; ++ch) { const size_t si = ((size_t)b * NCH + ch) * 512 + tid; c.lruC[si] = carry; carry = c.lruA[si] * carry + c.lruH[si]; }
            continue;
        }
        const int b = u >> 3, h = u & 7;
        float St[8];
#pragma unroll
        for (int q = 0; q < 8; ++q) St[q] = 0.f;
        const float* mu = p.in[I_EMU];
        for (int ch = 0; ch < NCH; ++ch) {
            const int t0 = ch * 64;
            for (int idx = tid; idx < 64 * 56; idx += NTHREADS) { const int i = idx / 56, q = idx % 56, t = t0 + i;
                int col; lfloat* dst; int mode = 0;
                if (q < 8) { col = h * 64 + 8 * q; dst = S_R + i * 64 + 8 * q; }
                else if (q < 16) { col = 512 + h * 64 + 8 * (q - 8); dst = S_K + i * 64 + 8 * (q - 8); }
                else if (q < 24) { col = 1024 + h * 64 + 8 * (q - 16); dst = S_V + i * 64 + 8 * (q - 16); }
                else if (q < 32) { col = 1536 + 8 * (q - 24); dst = S_W3 + i * 64 + 8 * (q - 24); mode = 1; }
                else if (q < 40) { col = 1600 + 8 * (q - 32); dst = S_A4 + i * 64 + 8 * (q - 32); }
                else { col = 1664 + 8 * (q - 40); dst = S_G5 + i * 128 + 8 * (q - 40); mode = 2; }
                float x[8] = {0.f, 0.f, 0.f, 0.f, 0.f, 0.f, 0.f, 0.f};
                if (t < TT) { float pv[8] = {0.f, 0.f, 0.f, 0.f, 0.f, 0.f, 0.f, 0.f};
                    const bf16_t* rp = c.P + ((size_t)b * TP + t) * EVEN_IN + col;
                    unpack8(*(const u32x4*)rp, x);
                    if (t > 0) unpack8(*(const u32x4*)(rp - EVEN_IN), pv);
#pragma unroll
                    for (int k = 0; k < 8; ++k) { x[k] = x[k] + mu[col + k] * (pv[k] - x[k]);
                        if (mode == 1) x[k] = tanhf(x[k]); else if (mode == 2) x[k] = sigmoidf_(x[k]); } }
#pragma unroll
                for (int k = 0; k < 8; ++k) dst[k] = x[k]; }
            __syncthreads();
            const int i = tid >> 3, j8 = (tid & 7) * 8, hj = h * 64 + j8;
            {
                float aw[8], aa[8];
#pragma unroll
                for (int q = 0; q < 8; ++q) { aw[q] = 0.f; aa[q] = 0.f; }
                const float* du = p.in[I_EDECAYUP] + hj; const float* iu = p.in[I_EICLRUP] + hj;
                for (int k = 0; k < 64; ++k) { const float x1 = S_W3[i * 64 + k], x2 = S_A4[i * 64 + k];
                    const f32x4 d0 = *(const f32x4*)(du + k * 512), d1 = *(const f32x4*)(du + k * 512 + 4), i0 = *(const f32x4*)(iu + k * 512), i1 = *(const f32x4*)(iu + k * 512 + 4);
#pragma unroll
                    for (int q = 0; q < 4; ++q) { aw[q] += x1 * d0[q]; aw[4 + q] += x1 * d1[q]; aa[q] += x2 * i0[q]; aa[4 + q] += x2 * i1[q]; } }
#pragma unroll
                for (int q = 0; q < 8; ++q) { const float wl = p.in[I_EDECAY0][hj + q] + aw[q]; const float w = -softplusf_(-wl) - 0.5f;
                    S_LW[i * 64 + j8 + q] = __expf(-__expf(w));
                    S_A8[i * 64 + j8 + q] = sigmoidf_(p.in[I_EICLR0][hj + q] + aa[q]); }
            }
            __syncthreads();
            {
                float ag[8];
#pragma unroll
                for (int q = 0; q < 8; ++q) ag[q] = 0.f;
                const float* gu = p.in[I_EGATEUP] + hj;
                for (int k = 0; k < 128; ++k) { const float x = S_G5[i * 128 + k]; const f32x4 g0 = *(const f32x4*)(gu + k * 512), g1 = *(const f32x4*)(gu + k * 512 + 4);
#pragma unroll
                    for (int q = 0; q < 4; ++q) { ag[q] += x * g0[q]; ag[4 + q] += x * g1[q]; } }
                float kx[8], ss = 0.f, bon = 0.f;
#pragma unroll
                for (int q = 0; q < 8; ++q) { kx[q] = S_K[i * 64 + j8 + q] * p.in[I_EKK][hj + q]; ss += kx[q] * kx[q]; }
                ss = sum8(ss);
                const float inv = 1.0f / fmaxf(sqrtf(ss), 1e-12f);
#pragma unroll
                for (int q = 0; q < 8; ++q) { const float kk = kx[q] * inv, a = S_A8[i * 64 + j8 + q], k0 = S_K[i * 64 + j8 + q];
                    const float km = k0 * (1.0f + (a - 1.0f) * p.in[I_EKA][hj + q]);
                    bon += S_R[i * 64 + j8 + q] * km * p.in[I_ERK][hj + q];
                    S_W3[i * 64 + j8 + q] = kk; S_K[i * 64 + j8 + q] = km; S_A8[i * 64 + j8 + q] = kk * a; S_A4[i * 64 + j8 + q] = ag[q]; }
                bon = sum8(bon);
                if ((tid & 7) == 0) S_BON[i] = bon;
            }
            __syncthreads();
            {
                const int v = tid >> 3, k8 = (tid & 7) * 8;
                for (int s = 0; s < 64; ++s) {
                    float kk[8], bb[8], dec[8], km[8], rr[8];
                    *(f32x4*)kk = *(const LAS f32x4*)(S_W3 + s * 64 + k8); *(f32x4*)(kk + 4) = *(const LAS f32x4*)(S_W3 + s * 64 + k8 + 4);
                    *(f32x4*)bb = *(const LAS f32x4*)(S_A8 + s * 64 + k8); *(f32x4*)(bb + 4) = *(const LAS f32x4*)(S_A8 + s * 64 + k8 + 4);
                    *(f32x4*)dec = *(const LAS f32x4*)(S_LW + s * 64 + k8); *(f32x4*)(dec + 4) = *(const LAS f32x4*)(S_LW + s * 64 + k8 + 4);
                    *(f32x4*)km = *(const LAS f32x4*)(S_K + s * 64 + k8); *(f32x4*)(km + 4) = *(const LAS f32x4*)(S_K + s * 64 + k8 + 4);
                    *(f32x4*)rr = *(const LAS f32x4*)(S_R + s * 64 + k8); *(f32x4*)(rr + 4) = *(const LAS f32x4*)(S_R + s * 64 + k8 + 4);
                    const float vv = S_V[s * 64 + v];
                    float sa = 0.f;
#pragma unroll
                    for (int q = 0; q < 8; ++q) sa += St[q] * kk[q];
                    sa = sum8(sa);
                    float o = 0.f;
#pragma unroll
                    for (int q = 0; q < 8; ++q) { St[q] = St[q] * dec[q] - sa * bb[q] + vv * km[q]; o += St[q] * rr[q]; }
                    o = sum8(o);
                    if ((tid & 7) == 0) S_G5[s * 64 + v] = o;
                }
            }
            __syncthreads();
            {
                float o[8], s1 = 0.f;
#pragma unroll
                for (int q = 0; q < 8; ++q) { o[q] = S_G5[i * 64 + j8 + q]; s1 += o[q]; }
                s1 = sum8(s1); const float mean = s1 * (1.0f / 64.0f);
                float s2 = 0.f;
#pragma unroll
                for (int q = 0; q < 8; ++q) { const float d = o[q] - mean; s2 += d * d; }
                s2 = sum8(s2); const float rstd = rsqrtf(s2 * (1.0f / 64.0f) + 64e-5f);
                const float bon = S_BON[i]; float y[8];
#pragma unroll
                for (int q = 0; q < 8; ++q) y[q] = ((o[q] - mean) * rstd * p.in[I_ELNG][hj + q] + p.in[I_ELNB][hj + q] + bon * S_V[i * 64 + j8 + q]) * S_A4[i * 64 + j8 + q];
                *(u32x4*)(c.Y + ((size_t)b * TP + t0 + i) * 1024 + hj) = pack8(y);
            }
            __syncthreads();
        }
    }
}

__device__ __forceinline__ void ph_router(const Ctx& c, const int l) {
    const Params& p = *c.p;
    lint* sel_e = (lint*)(c.lds + LDS_PH);
    lfloat* sel_w = (lfloat*)(sel_e + 2 * 288);
    lint* sel_row = (lint*)(sel_w + 2 * 288);
    lint* sel_pos = sel_row + 288;
    lint* lcnt = sel_pos + 2 * 288;
    lint* gbase = lcnt + 32;
    if (c.tid < 32) lcnt[c.tid] = 0;
    const float* gain = p.in[I_MNORM] + (size_t)l * 1024;
    const float* W = c.WrT + (size_t)l * 36 * 1024;
    int nloc = 0;
    for (int it = 0;; ++it) {
        const int idx0 = (it * c.G + c.bid) * 8; if (idx0 >= NTOK) break;
        const int idx = idx0 + c.wave; const int slot = it * 8 + c.wave; nloc = it * 8 + 8;
        if (idx < NTOK) {
            const int b = idx / TT, t = idx % TT; const int row = b * TP + t;
            const float* hrow = c.H + (size_t)row * 1024; bf16_t* nrow = c.HN + (size_t)row * 1024;
            f32x4 v[4]; float ss = 0.f;
#pragma unroll
            for (int i = 0; i < 4; ++i) { v[i] = *(const f32x4*)(hrow + 4 * c.lane + 256 * i); ss += v[i][0] * v[i][0] + v[i][1] * v[i][1] + v[i][2] * v[i][2] + v[i][3] * v[i][3]; }
            ss = wave_sum(ss);
            const float s = rsqrtf(ss * (1.0f / 1024.0f) + 1e-6f);
#pragma unroll
            for (int i = 0; i < 4; ++i) { const f32x4 g = *(const f32x4*)(gain + 4 * c.lane + 256 * i);
                v[i][0] *= s * g[0]; v[i][1] *= s * g[1]; v[i][2] *= s * g[2]; v[i][3] *= s * g[3];
                u32x2 w; w.x = pack2(v[i][0], v[i][1]); w.y = pack2(v[i][2], v[i][3]); *(u32x2*)(nrow + 4 * c.lane + 256 * i) = w; }
            float mylg = 0.f;
#pragma unroll 2
            for (int e = 0; e < 36; ++e) { float a = 0.f;
#pragma unroll
                for (int i = 0; i < 4; ++i) { const f32x4 w = *(const f32x4*)(W + (size_t)e * 1024 + 4 * c.lane + 256 * i); a += v[i][0] * w[0] + v[i][1] * w[1] + v[i][2] * w[2] + v[i][3] * w[3]; }
                a = wave_sum(a); mylg = (c.lane == e) ? a : mylg; }
            const float* bg = p.in[I_MBGROUP] + l * 4; const float* br = p.in[I_MBROUTER] + l * 32;
            float g0 = __shfl(mylg, 0) + bg[0], g1 = __shfl(mylg, 1) + bg[1], g2 = __shfl(mylg, 2) + bg[2], g3 = __shfl(mylg, 3) + bg[3];
            int gi = 0; float gm = g0; if (g1 > gm) { gm = g1; gi = 1; } if (g2 > gm) { gm = g2; gi = 2; } if (g3 > gm) { gm = g3; gi = 3; }
            const float gprob = 1.0f / (__expf(g0 - gm) + __expf(g1 - gm) + __expf(g2 - gm) + __expf(g3 - gm));
            float el[8];
#pragma unroll
            for (int j = 0; j < 8; ++j) el[j] = __shfl(mylg, 4 + gi * 8 + j) + br[gi * 8 + j];
            int i1 = 0; float v1 = el[0];
#pragma unroll
            for (int j = 1; j < 8; ++j) if (el[j] > v1) { v1 = el[j]; i1 = j; }
            int i2 = -1; float v2 = -3.0e38f;
#pragma unroll
            for (int j = 0; j < 8; ++j) if (j != i1 && el[j] > v2) { v2 = el[j]; i2 = j; }
            const float e2 = __expf(v2 - v1), w1 = gprob / (1.0f + e2), w2 = gprob * e2 / (1.0f + e2);
            if (c.lane == 0) { sel_e[slot] = gi * 8 + i1; sel_e[288 + slot] = gi * 8 + i2; sel_w[slot] = w1; sel_w[288 + slot] = w2; sel_row[slot] = row; }
        } else if (c.lane == 0) sel_row[slot] = -1;
    }
    __syncthreads();
    if (c.tid < nloc && sel_row[c.tid] >= 0) { sel_pos[c.tid] = __hip_atomic_fetch_add(&lcnt[sel_e[c.tid]], 1, __ATOMIC_RELAXED, __HIP_MEMORY_SCOPE_WORKGROUP); sel_pos[288 + c.tid] = __hip_atomic_fetch_add(&lcnt[sel_e[288 + c.tid]], 1, __ATOMIC_RELAXED, __HIP_MEMORY_SCOPE_WORKGROUP); }
    __syncthreads();
    if (c.tid < 32) gbase[c.tid] = lcnt[c.tid] > 0 ? atomicAdd(&c.mcnt[l * 32 + c.tid], lcnt[c.tid]) : 0;
    __syncthreads();
    if (c.tid < nloc && sel_row[c.tid] >= 0) {
#pragma unroll
        for (int sl = 0; sl < 2; ++sl) { const int e = sel_e[sl * 288 + c.tid]; const size_t pos = (size_t)e * MCAP + gbase[e] + sel_pos[sl * 288 + c.tid];
            c.mlist[pos] = sel_row[c.tid] * 2 + sl; c.mlw[pos] = sel_w[sl * 288 + c.tid]; } }
    __syncthreads();
}

__device__ __forceinline__ void ph_combine_norm(const Ctx& c, const float* gain, const int mode) {
    for (int row = c.bid * 8 + c.wave; row < NP; row += c.G * 8) {
        const int b = row / TP, t = row % TP;
        bf16_t* nrow = c.HN + (size_t)row * 1024;
        if (t >= TT) { if (mode == 0) {
#pragma unroll
                for (int i = 0; i < 4; ++i) *(u32x2*)(nrow + 4 * c.lane + 256 * i) = (u32x2){0u, 0u}; }
            continue; }
        if (mode == 1 && t < NMETA) continue;
        float* hrow = c.H + (size_t)row * 1024; const bf16_t* y0 = c.YM + (size_t)row * 2048; const bf16_t* y1 = y0 + 1024;
        f32x4 v[4]; float ss = 0.f;
#pragma unroll
        for (int i = 0; i < 4; ++i) { v[i] = *(const f32x4*)(hrow + 4 * c.lane + 256 * i);
            const u32x2 a = *(const u32x2*)(y0 + 4 * c.lane + 256 * i), d = *(const u32x2*)(y1 + 4 * c.lane + 256 * i);
            v[i][0] += bf2f(a.x & 0xffffu) + bf2f(d.x & 0xffffu); v[i][1] += bf2f(a.x >> 16) + bf2f(d.x >> 16);
            v[i][2] += bf2f(a.y & 0xffffu) + bf2f(d.y & 0xffffu); v[i][3] += bf2f(a.y >> 16) + bf2f(d.y >> 16);
            ss += v[i][0] * v[i][0] + v[i][1] * v[i][1] + v[i][2] * v[i][2] + v[i][3] * v[i][3]; }
        ss = wave_sum(ss);
        const float s = rsqrtf(ss * (1.0f / 1024.0f) + 1e-6f);
        float* orow = c.p->out + ((size_t)b * SEQ + (t - NMETA)) * 1024;
#pragma unroll
        for (int i = 0; i < 4; ++i) { const f32x4 g = *(const f32x4*)(gain + 4 * c.lane + 256 * i);
            if (mode == 0) { *(f32x4*)(hrow + 4 * c.lane + 256 * i) = v[i];
                u32x2 w; w.x = pack2(v[i][0] * s * g[0], v[i][1] * s * g[1]); w.y = pack2(v[i][2] * s * g[2], v[i][3] * s * g[3]); *(u32x2*)(nrow + 4 * c.lane + 256 * i) = w; }
            else { f32x4 o; o[0] = v[i][0] * s * g[0]; o[1] = v[i][1] * s * g[1]; o[2] = v[i][2] * s * g[2]; o[3] = v[i][3] * s * g[3]; *(f32x4*)(orow + 4 * c.lane + 256 * i) = o; } }
    }
}

__device__ __forceinline__ void moe_table(const Ctx& c, const int l) {
    lint* ts = (lint*)(c.lds + LDS_MISC);
    if (c.tid == 0) { int a = 0; for (int e = 0; e < 32; ++e) { ts[e] = a; a += (c.mcnt[l * 32 + e] + 255) >> 8; } ts[32] = a; }
    __syncthreads();
}

constexpr int GL_LD = 132;
__device__ __forceinline__ float logsigmoidf_(float x) { return fminf(x, 0.f) - log1pf(__expf(-fabsf(x))); }
__device__ __forceinline__ void ph_gla_prep(const Ctx& c) {
    const Params& p = *c.p; const int tid = c.tid;
    lfloat* GD = (lfloat*)(c.lds + LDS_PH);
    lfloat* CUM = GD + 1024;
    lfloat* QT = CUM + 8192;
    lfloat* KT = QT + 64 * GL_LD;
    lfloat* SC = KT + 64 * GL_LD;
    const float* g_up = p.in[I_OGUP]; const float* g_b = p.in[I_OGB];
    for (int u = c.bid; u < BATCH * 4 * NCH; u += c.G) {
        const int b = u / (4 * NCH), rem = u % (4 * NCH), ch = rem / 4, hd = rem % 4;
        const size_t row0 = (size_t)b * TP + ch * 64;
        for (int idx = tid; idx < 64 * 34; idx += NTHREADS) { const int i = idx / 34, q = idx % 34; float x[8];
            const bf16_t* rp = c.P + (row0 + i) * ODD_IN;
            if (q < 16) { unpack8(*(const u32x4*)(rp + hd * 128 + 8 * q), x);
#pragma unroll
                for (int k = 0; k < 8; ++k) QT[i * GL_LD + 8 * q + k] = x[k]; }
            else if (q < 32) { unpack8(*(const u32x4*)(rp + 512 + hd * 128 + 8 * (q - 16)), x);
#pragma unroll
                for (int k = 0; k < 8; ++k) KT[i * GL_LD + 8 * (q - 16) + k] = x[k]; }
            else { unpack8(*(const u32x4*)(rp + 2048 + 8 * (q - 32)), x);
#pragma unroll
                for (int k = 0; k < 8; ++k) GD[i * 16 + 8 * (q - 32) + k] = x[k]; } }
        __syncthreads();
        { const int i = tid >> 3, j16 = (tid & 7) * 16; float a[16];
#pragma unroll
            for (int q = 0; q < 16; ++q) a[q] = g_b[hd * 128 + j16 + q];
            for (int k = 0; k < 16; ++k) { const float x = GD[i * 16 + k];
#pragma unroll
                for (int q4 = 0; q4 < 4; ++q4) { const f32x4 w = *(const f32x4*)(g_up + k * 512 + hd * 128 + j16 + 4 * q4);
                    a[4 * q4] += x * w[0]; a[4 * q4 + 1] += x * w[1]; a[4 * q4 + 2] += x * w[2]; a[4 * q4 + 3] += x * w[3]; } }
#pragma unroll
            for (int q = 0; q < 16; ++q) CUM[i * 128 + j16 + q] = logsigmoidf_(a[q]) * (1.0f / 16.0f); }
        __syncthreads();
        if (tid < 128) { float run = 0.f; for (int i = 0; i < 64; ++i) { run += CUM[i * 128 + tid]; CUM[i * 128 + tid] = run; }
            c.glaG[(((size_t)b * 4 + hd) * NCH + ch) * 128 + tid] = __expf(run); }
        __syncthreads();
        { const int i = tid >> 3, j16 = (tid & 7) * 16; float qo[16], ko[16];
#pragma unroll
            for (int q = 0; q < 16; ++q) { const float cu = CUM[i * 128 + j16 + q], last = CUM[63 * 128 + j16 + q];
                const float qv = QT[i * GL_LD + j16 + q] * 0.08838834764831845f * __expf(cu), kv = KT[i * GL_LD + j16 + q];
                QT[i * GL_LD + j16 + q] = qv; KT[i * GL_LD + j16 + q] = kv * __expf(-cu); qo[q] = qv; ko[q] = kv * __expf(last - cu); }
            bf16_t* rp = c.P + (row0 + i) * ODD_IN;
            *(u32x4*)(rp + hd * 128 + j16) = pack8(qo); *(u32x4*)(rp + hd * 128 + j16 + 8) = pack8(qo + 8);
            *(u32x4*)(rp + 512 + hd * 128 + j16) = pack8(ko); *(u32x4*)(rp + 512 + hd * 128 + j16 + 8) = pack8(ko + 8); }
        __syncthreads();
        { const int s = tid & 63, tq = (tid >> 6) * 8; float a[8];
#pragma unroll
            for (int q = 0; q < 8; ++q) a[q] = 0.f;
            for (int j = 0; j < 128; j += 4) { const f32x4 kv = *(const LAS f32x4*)(KT + s * GL_LD + j);
#pragma unroll
                for (int q = 0; q < 8; ++q) { const f32x4 qv = *(const LAS f32x4*)(QT + (tq + q) * GL_LD + j); a[q] += qv[0] * kv[0] + qv[1] * kv[1] + qv[2] * kv[2] + qv[3] * kv[3]; } }
#pragma unroll
            for (int q = 0; q < 8; ++q) SC[(tq + q) * 64 + s] = (s <= tq + q) ? a[q] : 0.f; }
        __syncthreads();
        { const int d4 = (tid & 63) * 4, tq = (tid >> 6) * 8; float a[8][4];
#pragma unroll
            for (int q = 0; q < 8; ++q) { a[q][0] = 0.f; a[q][1] = 0.f; a[q][2] = 0.f; a[q][3] = 0.f; }
            for (int s = 0; s < 64; ++s) { const u32x2 vv = *(const u32x2*)(c.P + (row0 + s) * ODD_IN + 1024 + hd * 256 + d4);
                const float v0 = bf2f(vv.x & 0xffffu), v1 = bf2f(vv.x >> 16), v2 = bf2f(vv.y & 0xffffu), v3 = bf2f(vv.y >> 16);
#pragma unroll
                for (int q = 0; q < 8; ++q) { const float sc = SC[(tq + q) * 64 + s]; a[q][0] += sc * v0; a[q][1] += sc * v1; a[q][2] += sc * v2; a[q][3] += sc * v3; } }
#pragma unroll
            for (int q = 0; q < 8; ++q) { u32x2 w; w.x = pack2(a[q][0], a[q][1]); w.y = pack2(a[q][2], a[q][3]); *(u32x2*)(c.HN + (row0 + tq + q) * 1024 + hd * 256 + d4) = w; } }
        __syncthreads();
    }
}
__device__ __forceinline__ void ph_gla_seq(const Ctx& c) {
    const int tid = c.tid;
    lfloat* QS = (lfloat*)(c.lds + LDS_PH);
    lfloat* KS = QS + 64 * GL_LD;
    lfloat* VS = KS + 64 * GL_LD;
    lfloat* ZS = VS + 64 * 68;
    lfloat* GS = ZS + 128 * 68;
    for (int u = c.bid; u < BATCH * 4 * 4; u += c.G) {
        const int b = u >> 4, hd = (u >> 2) & 3, dq = u & 3;
        const int kq4 = (tid >> 4) * 4, d4 = (tid & 15) * 4;
        float Z[4][4];
#pragma unroll
        for (int a = 0; a < 4; ++a)
#pragma unroll
            for (int q = 0; q < 4; ++q) Z[a][q] = 0.f;
        for (int ch = 0; ch < NCH; ++ch) {
            const size_t row0 = (size_t)b * TP + ch * 64;
            for (int idx = tid; idx < 64 * 40; idx += NTHREADS) { const int i = idx / 40, q = idx % 40; float x[8];
                const bf16_t* rp = c.P + (row0 + i) * ODD_IN;
                if (q < 16) { unpack8(*(const u32x4*)(rp + hd * 128 + 8 * q), x);
#pragma unroll
                    for (int k = 0; k < 8; ++k) QS[i * GL_LD + 8 * q + k] = x[k]; }
                else if (q < 32) { unpack8(*(const u32x4*)(rp + 512 + hd * 128 + 8 * (q - 16)), x);
#pragma unroll
                    for (int k = 0; k < 8; ++k) KS[i * GL_LD + 8 * (q - 16) + k] = x[k]; }
                else { unpack8(*(const u32x4*)(rp + 1024 + hd * 256 + dq * 64 + 8 * (q - 32)), x);
#pragma unroll
                    for (int k = 0; k < 8; ++k) VS[i * 68 + 8 * (q - 32) + k] = x[k]; } }
            if (tid < 128) GS[tid] = c.glaG[(((size_t)b * 4 + hd) * NCH + ch) * 128 + tid];
#pragma unroll
            for (int a = 0; a < 4; ++a) *(LAS f32x4*)(ZS + (kq4 + a) * 68 + d4) = (f32x4){Z[a][0], Z[a][1], Z[a][2], Z[a][3]};
            __syncthreads();
            { const int t2 = (tid >> 4) * 2; float o0[4] = {0.f, 0.f, 0.f, 0.f}, o1[4] = {0.f, 0.f, 0.f, 0.f};
                for (int k = 0; k < 128; k += 4) { const f32x4 q0 = *(const LAS f32x4*)(QS + t2 * GL_LD + k), q1 = *(const LAS f32x4*)(QS + (t2 + 1) * GL_LD + k);
#pragma unroll
                    for (int kk = 0; kk < 4; ++kk) { const f32x4 z = *(const LAS f32x4*)(ZS + (k + kk) * 68 + d4);
#pragma unroll
                        for (int q = 0; q < 4; ++q) { o0[q] += q0[kk] * z[q]; o1[q] += q1[kk] * z[q]; } } }
                bf16_t* op0 = c.HN + (row0 + t2) * 1024 + hd * 256 + dq * 64 + d4; bf16_t* op1 = op0 + 1024;
                const u32x2 a0 = *(const u32x2*)op0, a1 = *(const u32x2*)op1;
                u32x2 w0, w1;
                w0.x = pack2(o0[0] + bf2f(a0.x & 0xffffu), o0[1] + bf2f(a0.x >> 16)); w0.y = pack2(o0[2] + bf2f(a0.y & 0xffffu), o0[3] + bf2f(a0.y >> 16));
                w1.x = pack2(o1[0] + bf2f(a1.x & 0xffffu), o1[1] + bf2f(a1.x >> 16)); w1.y = pack2(o1[2] + bf2f(a1.y & 0xffffu), o1[3] + bf2f(a1.y >> 16));
                *(u32x2*)op0 = w0; *(u32x2*)op1 = w1; }
            {
#pragma unroll
                for (int a = 0; a < 4; ++a) { const float g = GS[kq4 + a];
#pragma unroll
                    for (int q = 0; q < 4; ++q) Z[a][q] *= g; }
                for (int s = 0; s < 64; ++s) { const f32x4 kv = *(const LAS f32x4*)(KS + s * GL_LD + kq4), vv = *(const LAS f32x4*)(VS + s * 68 + d4);
#pragma unroll
                    for (int a = 0; a < 4; ++a)
#pragma unroll
                        for (int q = 0; q < 4; ++q) Z[a][q] += kv[a] * vv[q]; } }
            __syncthreads();
        }
    }
}
__device__ __forceinline__ void ph_gla_finish(const Ctx& c) {
    const Params& p = *c.p; const float* hg = p.in[I_OHEADGAIN];
    for (int row = c.bid * 8 + c.wave; row < NP; row += c.G * 8) {
        const bf16_t* op = c.HN + (size_t)row * 1024 + 16 * c.lane; const bf16_t* rp = c.P + (size_t)row * ODD_IN + 2064 + 16 * c.lane;
        float o[16], r[16];
        unpack8(*(const u32x4*)op, o); unpack8(*(const u32x4*)(op + 8), o + 8); unpack8(*(const u32x4*)rp, r); unpack8(*(const u32x4*)(rp + 8), r + 8);
        float ss = 0.f;
#pragma unroll
        for (int q = 0; q < 16; ++q) ss += o[q] * o[q];
        ss += __shfl_xor(ss, 1); ss += __shfl_xor(ss, 2); ss += __shfl_xor(ss, 4); ss += __shfl_xor(ss, 8);
        const float inv = rsqrtf(ss * (1.0f / 256.0f) + 1e-6f); float y[16];
#pragma unroll
        for (int q = 0; q < 16; ++q) y[q] = o[q] * inv * hg[16 * c.lane + q] * (r[q] / (1.0f + __expf(-r[q])));
        bf16_t* yp = c.Y + (size_t)row * 1024 + 16 * c.lane;
        *(u32x4*)yp = pack8(y); *(u32x4*)(yp + 8) = pack8(y + 8);
    }
}

constexpr int N_PHASES = 19;
__global__ void __launch_bounds__(NTHREADS, 2) fwd(const Params p, const int lo, const int hi) {
    extern __shared__ __attribute__((aligned(16))) unsigned char smem[];
    Ctx c; c.p = &p; c.lds = (LAS unsigned char*)smem; c.tid = threadIdx.x; c.lane = c.tid & 63; c.wave = __builtin_amdgcn_readfirstlane(c.tid >> 6); c.G = gridDim.x; c.bid = blockIdx.x;
    unsigned char* ws = p.ws;
    c.H = (float*)(ws + WS_H); c.P = (bf16_t*)(ws + WS_P); c.Y = (bf16_t*)(ws + WS_Y); c.HN = (bf16_t*)(ws + WS_HN);
    c.WinE = (bf16_t*)(ws + WS_WINE); c.WoutE = (bf16_t*)(ws + WS_WOUTE); c.WinO = (bf16_t*)(ws + WS_WINO); c.WoutO = (bf16_t*)(ws + WS_WOUTO);
    c.W1 = (bf16_t*)(ws + WS_W1); c.W2 = (bf16_t*)(ws + WS_W2); c.WrT = (float*)(ws + WS_WRT); c.mcnt = (int*)(ws + WS_CTL + 16384);
    c.YM = (bf16_t*)(ws + WS_P + PO_YM); c.HID = (bf16_t*)(ws + WS_P + PO_HID); c.mlist = (int*)(ws + WS_P + PO_LIST); c.mlw = (float*)(ws + WS_P + PO_LW);
    unsigned char* dsc = (unsigned char*)p.out;
    c.lruA = (float*)(dsc + DO_LRUA); c.lruH = (float*)(dsc + DO_LRUH); c.lruC = (float*)(dsc + DO_LRUC); c.glaG = (float*)(dsc + DO_GLAG);
    LAS unsigned char* glds = c.lds + LDS_PH;

    if (c.tid < 4) ((volatile LAS unsigned*)smem)[c.tid] = 0u;
    __syncthreads();
    XcdBarrier bar; bar.bar = (unsigned*)(ws + WS_CTL); bar.x = 0; bar.st = (volatile LAS unsigned*)smem;
    if (hi - lo > 1) bar = xcd_barrier_post((unsigned*)(ws + WS_CTL), (volatile LAS unsigned*)smem);
#ifndef PHMASK
#define PHMASK 0x7FFFF
#endif
#define IN(k) (((PHMASK >> (k)) & 1) && lo <= (k) && (k) < hi)
#define SEAM(k) do { if (IN(k) && IN((k) + 1)) xcd_barrier(bar); } while (0)

    if (IN(0)) ph_prologue(c);
    SEAM(0);
    if (IN(1)) { pg8::DenseOrder S; S.init(NP, EVEN_IN, 1024, c.WinE, c.G, c.bid); pg8::EpiStoreBf16 E{c.P, EVEN_IN, EVEN_IN};
        pg8::gemm_phase(glds, (const char*)c.HN, 1024, S, E); }
    SEAM(1);
    if (IN(2)) ph_lru(c, false);
    SEAM(2);
    if (IN(3)) ph_rwkv_naive(c);
    SEAM(3);
    if (IN(4)) ph_lru(c, true);
    SEAM(4);
    if (IN(5)) { pg8::DenseOrder S; S.init(NP, 1024, 1024, c.WoutE, c.G, c.bid); pg8::EpiResid E{c.H};
        pg8::gemm_phase(glds, (const char*)c.Y, 1024, S, E); }
    SEAM(5);
    if (IN(6)) ph_router(c, 0);
    SEAM(6);
    if (IN(7)) { moe_table(c, 0);
        pg8::MoeOrder S{(const LAS int*)(glds + 131072), c.mcnt, c.mlist, (const char*)c.W1, (size_t)512 * 1024 * 2, 2, c.G, c.bid, 1024, 1}; pg8::EpiSwiglu E{c.HID};
        pg8::gemm_phase(glds, (const char*)c.HN, 1024, S, E); }
    SEAM(7);
    if (IN(8)) { moe_table(c, 0);
        pg8::MoeOrder S{(const LAS int*)(glds + 131072), c.mcnt, c.mlist, (const char*)c.W2, (size_t)1024 * 256 * 2, 4, c.G, c.bid, 256, 0}; pg8::EpiScatter E{c.YM, c.mlist, c.mlw};
        pg8::gemm_phase(glds, (const char*)c.HID, 256, S, E); }
    SEAM(8);
    if (IN(9)) ph_combine_norm(c, p.in[I_ONORM], 0);
    SEAM(9);
    if (IN(10)) { pg8::DenseOrder S; S.init(NP, ODD_IN_PAD, 1024, c.WinO, c.G, c.bid); pg8::EpiStoreBf16 E{c.P, ODD_IN, ODD_IN};
        pg8::gemm_phase(glds, (const char*)c.HN, 1024, S, E); }
    SEAM(10);
    if (IN(11)) ph_gla_prep(c);
    SEAM(11);
    if (IN(12)) ph_gla_seq(c);
    SEAM(12);
    if (IN(13)) ph_gla_finish(c);
    SEAM(13);
    if (IN(14)) { pg8::DenseOrder S; S.init(NP, 1024, 1024, c.WoutO, c.G, c.bid); pg8::EpiResid E{c.H};
        pg8::gemm_phase(glds, (const char*)c.Y, 1024, S, E); }
    SEAM(14);
    if (IN(15)) ph_router(c, 1);
    SEAM(15);
    if (IN(16)) { moe_table(c, 1);
        pg8::MoeOrder S{(const LAS int*)(glds + 131072), c.mcnt + 32, c.mlist, (const char*)(c.W1 + (size_t)32 * 512 * 1024), (size_t)512 * 1024 * 2, 2, c.G, c.bid, 1024, 1}; pg8::EpiSwiglu E{c.HID};
        pg8::gemm_phase(glds, (const char*)c.HN, 1024, S, E); }
    SEAM(16);
    if (IN(17)) { moe_table(c, 1);
        pg8::MoeOrder S{(const LAS int*)(glds + 131072), c.mcnt + 32, c.mlist, (const char*)(c.W2 + (size_t)32 * 1024 * 256), (size_t)1024 * 256 * 2, 4, c.G, c.bid, 256, 0}; pg8::EpiScatter E{c.YM, c.mlist, c.mlw};
        pg8::gemm_phase(glds, (const char*)c.HID, 256, S, E); }
    SEAM(17);
    if (IN(18)) ph_combine_norm(c, p.in[I_FINALNORM], 1);
#undef IN
#undef SEAM
}

extern "C" void kernel_launch(void* const* d_in, const int* in_sizes, int n_in, void* d_out, int out_size, void* d_ws, size_t ws_size, hipStream_t stream) {
    static int grid = 0;
    if (grid == 0) {
        if (n_in != 38 || ws_size < WS_END) { fprintf(stderr, "kernel_launch: unexpected n_in %d or ws_size %zu (< %zu)\n", n_in, ws_size, (size_t)WS_END); grid = -1; return; }
        int dev = 0, cus = 0, per_cu = 0;
        if (hipGetDevice(&dev) != hipSuccess || hipDeviceGetAttribute(&cus, hipDeviceAttributeMultiprocessorCount, dev) != hipSuccess) { grid = -1; return; }
        if (hipFuncSetAttribute((const void*)fwd, hipFuncAttributeMaxDynamicSharedMemorySize, LDS_BYTES) != hipSuccess) { fprintf(stderr, "kernel_launch: hipFuncSetAttribute failed\n"); grid = -1; return; }
        if (hipOccupancyMaxActiveBlocksPerMultiprocessor(&per_cu, (const void*)fwd, NTHREADS, LDS_BYTES) != hipSuccess || per_cu < 1) fprintf(stderr, "kernel_launch: occupancy query says %d\n", per_cu);
        (void)hipGetLastError();
        grid = cus;
    }
    if (grid < 0) return;
    (void)hipMemsetAsync((char*)d_ws + WS_CTL, 0, 32768, stream);
    Params p{};
    for (int i = 0; i < 38; ++i) p.in[i] = (const float*)d_in[i];
    p.out = (float*)d_out; p.ws = (unsigned char*)d_ws;
#if ONE_LAUNCH
    hipLaunchKernelGGL(fwd, dim3(grid), dim3(NTHREADS), LDS_BYTES, stream, p, 0, N_PHASES);
#else
    for (int k = 0; k < N_PHASES; ++k) hipLaunchKernelGGL(fwd, dim3(grid), dim3(NTHREADS), LDS_BYTES, stream, p, k, k + 1);
#endif
}
```

```cpp
#include <hip/hip_runtime.h>
#include <stdint.h>
#include <stdio.h>

typedef unsigned short bf16_t;
typedef short bf16x8 __attribute__((ext_vector_type(8)));
typedef float f32x4 __attribute__((ext_vector_type(4)));
typedef unsigned u32x4 __attribute__((ext_vector_type(4)));
typedef unsigned u32x2 __attribute__((ext_vector_type(2)));
#define LAS __attribute__((address_space(3)))
typedef LAS float lfloat;
typedef LAS int lint;

#ifndef PROBE_MASK
#define PROBE_MASK 0
#endif
#ifndef ONE_LAUNCH
#define ONE_LAUNCH 1
#endif

constexpr int BATCH = 8, SEQ = 8192, DM = 1024, NMETA = 16, TT = SEQ + NMETA  , TP = 8256  , NP = BATCH * TP  , NTOK = BATCH * TT;
constexpr int NCH = TP / 64;
constexpr int EVEN_IN = 2816, ODD_IN = 3088, ODD_IN_PAD = 3328;
constexpr int MCAP = 65792;
constexpr int NTHREADS = 512;
constexpr int LDS_BYTES = 161792;
constexpr int LDS_PH = 64;
constexpr int LDS_MISC = 64 + 131072;

constexpr size_t WS_CTL = 0;
constexpr size_t WS_H = 32768;
constexpr size_t WS_P = WS_H + (size_t)NP * 1024 * 4;
constexpr size_t WS_Y = WS_P + (size_t)NP * ODD_IN * 2;
constexpr size_t WS_HN = WS_Y + (size_t)NP * 1024 * 2;
constexpr size_t WS_WINE = WS_HN + (size_t)NP * 1024 * 2;
constexpr size_t WS_WOUTE = WS_WINE + (size_t)EVEN_IN * 1024 * 2;
constexpr size_t WS_WINO = WS_WOUTE + (size_t)1024 * 1024 * 2;
constexpr size_t WS_WOUTO = WS_WINO + (size_t)ODD_IN_PAD * 1024 * 2;
constexpr size_t WS_W1 = WS_WOUTO + (size_t)1024 * 1024 * 2;
constexpr size_t WS_W2 = WS_W1 + (size_t)2 * 32 * 512 * 1024 * 2;
constexpr size_t WS_WRT = WS_W2 + (size_t)2 * 32 * 1024 * 256 * 2;
constexpr size_t WS_DUT = WS_WRT + (size_t)2 * 36 * 1024 * 4;
constexpr size_t WS_IUT = WS_DUT + 512 * 64 * 2;
constexpr size_t WS_GUT = WS_IUT + 512 * 64 * 2;
constexpr size_t WS_WAT = WS_GUT + 512 * 128 * 2;
constexpr size_t WS_WXT = WS_WAT + 8 * 4096 * 2;
constexpr size_t WS_LAMC = WS_WXT + 8 * 4096 * 2;
constexpr size_t WS_WRH = WS_LAMC + 512 * 4;
constexpr size_t WS_WRL = WS_WRH + (size_t)2 * 48 * 1024 * 2;
constexpr size_t WS_GLU = WS_WRL + (size_t)2 * 48 * 1024 * 2;
constexpr size_t WS_SROW = WS_GLU + 512 * 32 * 2;
constexpr size_t WS_END = WS_SROW + (size_t)NP * 4;
constexpr size_t PO_YM = 0;
constexpr size_t PO_HID = (size_t)2 * NP * 1024 * 2;
constexpr size_t PO_LIST = PO_HID + (size_t)(2 * NTOK + 32 * 256) * 256 * 2;
constexpr size_t PO_LW = PO_LIST + (size_t)32 * MCAP * 4;
constexpr size_t PO_LS = PO_LW + (size_t)32 * MCAP * 4;
constexpr size_t PO_END = PO_LS + (size_t)32 * MCAP * 4;
static_assert(PO_END <= (size_t)NP * EVEN_IN * 2, "MoE scratch must fit the P region");
constexpr size_t DO_LRUA = 0;
constexpr size_t DO_LRUH = DO_LRUA + (size_t)BATCH * NCH * 512 * 4;
constexpr size_t DO_LRUC = DO_LRUH + (size_t)BATCH * NCH * 512 * 4;
constexpr size_t DO_GLAG = DO_LRUC + (size_t)BATCH * NCH * 512 * 4;
constexpr int NRU = BATCH * 8 * NCH;
constexpr size_t DO_RWHC = DO_GLAG + (size_t)BATCH * 4 * NCH * 128 * 4;
constexpr size_t DO_RWOO = DO_RWHC + (size_t)NRU * 4096 * 2;
constexpr size_t DO_RWE2 = DO_RWOO + (size_t)NRU * 4096 * 2;
constexpr size_t DO_RWGL = DO_RWE2 + (size_t)NRU * 4096 * 2;
constexpr size_t DO_END = DO_RWGL + (size_t)NRU * 64 * 4;
constexpr size_t LRU_LA_HALF = (size_t)4 * TP * 512 * 2;
static_assert(DO_END + LRU_LA_HALF <= (size_t)BATCH * SEQ * DM * 4, "d_out scratch");
static_assert((size_t)NP * EVEN_IN * 2 + LRU_LA_HALF <= (size_t)NP * ODD_IN * 2, "log a of batches 0-3 sits in the tail of the P region during the even layer");

#define XB_TMO      128
#define XB_XCNT(j)  (256  + 64 * (j))
#define XB_XSUB(j)  (1280 + 64 * (j))
#define XB_XGEN(j)  (2304 + 64 * (j))
#define XB_TOP      3328
#define XB_TOPGEN   3392
#define XCD_BAR_WORDS 3456
#define XB_SPIN_CAP (1u << 22)

__device__ __forceinline__ unsigned xb_ld(unsigned* p)              { return __hip_atomic_load(p, __ATOMIC_RELAXED, __HIP_MEMORY_SCOPE_AGENT); }
__device__ __forceinline__ unsigned xb_add(unsigned* p, unsigned v) { return __hip_atomic_fetch_add(p, v, __ATOMIC_RELAXED, __HIP_MEMORY_SCOPE_AGENT); }
__device__ __forceinline__ unsigned xb_xcc_id() { return (unsigned)__builtin_amdgcn_s_getreg((3 << 11) | 20) & 0xFu; }
#define XB_SPIN(cond, bar) do { unsigned _sp = 0; while (cond) { __builtin_amdgcn_s_sleep(1); \
    if ((++_sp & 255u) == 0u) { if (xb_ld(&(bar)[XB_TMO])) break; if (_sp > XB_SPIN_CAP) { atomicAdd(&(bar)[XB_TMO], 1u); break; } } } } while (0)

struct XcdBarrier { unsigned* bar; unsigned x; volatile LAS unsigned* st; };

__device__ __forceinline__ XcdBarrier xcd_barrier_post(unsigned* bar, volatile LAS unsigned* st) {
    XcdBarrier b; b.bar = bar; b.x = xb_xcc_id(); b.st = st;
    if (threadIdx.x == 0) (void)xb_add(&bar[XB_XCNT(b.x)], 1u);
    return b;
}
__device__ __forceinline__ void xcd_barrier_complete(unsigned* bar, unsigned x, unsigned& nloc, unsigned& nx) {
    const unsigned G = gridDim.x * gridDim.y * gridDim.z;
    unsigned sum, cnt, mine, sp = 0u;
    for (;;) {
        sum = 0u; cnt = 0u; mine = 0u;
#pragma unroll
        for (unsigned j = 0; j < 16; ++j) { const unsigned c = xb_ld(&bar[XB_XCNT(j)]); sum += c; cnt += (c > 0u) ? 1u : 0u; mine = (j == x) ? c : mine; }
        if (sum == G) break;
        __builtin_amdgcn_s_sleep(1);
        if ((++sp & 255u) == 0u) { if (xb_ld(&bar[XB_TMO])) break; if (sp > XB_SPIN_CAP) { atomicAdd(&bar[XB_TMO], 1u); break; } }
    }
    nloc = mine > 0u ? mine : 1u; nx = cnt > 0u ? cnt : 1u;
}
__device__ __forceinline__ void xcd_barrier(const XcdBarrier& b) {
    asm volatile("s_waitcnt vmcnt(0)" ::: "memory");
    __syncthreads();
    if (threadIdx.x == 0) {
        unsigned* bar = b.bar;
        __builtin_amdgcn_s_waitcnt(0);
        unsigned nloc = b.st[0], nx = b.st[1];
        if (nloc == 0u) { xcd_barrier_complete(bar, b.x, nloc, nx); b.st[0] = nloc; b.st[1] = nx; }
        const unsigned old = xb_add(&bar[XB_XSUB(b.x)], 1u);
        const unsigned gen = old / nloc;
        if (old + 1u == (gen + 1u) * nloc) {
            __builtin_amdgcn_fence(__ATOMIC_RELEASE, "agent");
            asm volatile("s_waitcnt vmcnt(0)" ::: "memory");
            const unsigned og = xb_add(&bar[XB_TOP], 1u);
            const unsigned tg = og / nx;
            if (og + 1u == (tg + 1u) * nx) xb_add(&bar[XB_TOPGEN], 1u);
            else XB_SPIN(xb_ld(&bar[XB_TOPGEN]) == tg, bar);
            __builtin_amdgcn_fence(__ATOMIC_ACQUIRE, "agent");
            xb_add(&bar[XB_XGEN(b.x)], 1u);
            asm volatile("s_waitcnt vmcnt(0)" ::: "memory");
        } else {
            XB_SPIN(xb_ld(&bar[XB_XGEN(b.x)]) == gen, bar);
            __builtin_amdgcn_fence(__ATOMIC_ACQUIRE, "agent");
            asm volatile("s_waitcnt vmcnt(0)" ::: "memory");
        }
    }
    __syncthreads();
}

struct Params {
    const float* in[38];
    float* out;
    unsigned char* ws;
};
enum { I_X = 0, I_META, I_ENORM, I_EWIN, I_EMU, I_EDECAY0, I_EDECAYUP, I_EICLR0, I_EICLRUP, I_EGATEUP, I_EKK, I_EKA, I_ERK, I_ELNG, I_ELNB,
       I_ECONVW, I_ECONVB, I_ELRUWA, I_ELRUBA, I_ELRUWX, I_ELRUBX, I_ELAMBDA, I_EWOUT, I_ONORM, I_OWIN, I_OGUP, I_OGB, I_OHEADGAIN, I_OWOUT,
       I_MNORM, I_MWGROUP, I_MBGROUP, I_MWROUTER, I_MBROUTER, I_MWGATE, I_MWUP, I_MWDOWN, I_FINALNORM };

__device__ __forceinline__ bf16_t f2bf(float f) { unsigned u = __float_as_uint(f); u += 0x7FFFu + ((u >> 16) & 1u); return (bf16_t)(u >> 16); }
__device__ __forceinline__ float bf2f(unsigned b) { return __uint_as_float(b << 16); }
typedef __bf16 bf16v2 __attribute__((ext_vector_type(2)));
__device__ __forceinline__ unsigned pack2(float lo, float hi) { bf16v2 v; v.x = (__bf16)lo; v.y = (__bf16)hi; return __builtin_bit_cast(unsigned, v); }
__device__ __forceinline__ void unpack8(const u32x4 v, float* o) {
    o[0] = bf2f(v.x & 0xffffu); o[1] = bf2f(v.x >> 16); o[2] = bf2f(v.y & 0xffffu); o[3] = bf2f(v.y >> 16);
    o[4] = bf2f(v.z & 0xffffu); o[5] = bf2f(v.z >> 16); o[6] = bf2f(v.w & 0xffffu); o[7] = bf2f(v.w >> 16);
}
__device__ __forceinline__ u32x4 pack8(const float* o) { u32x4 w; w.x = pack2(o[0], o[1]); w.y = pack2(o[2], o[3]); w.z = pack2(o[4], o[5]); w.w = pack2(o[6], o[7]); return w; }
__device__ __forceinline__ float wave_sum(float v) {
#pragma unroll
    for (int o = 32; o > 0; o >>= 1) v += __shfl_xor(v, o);
    return v;
}
__device__ __forceinline__ float sum8(float v) { v += __shfl_xor(v, 1); v += __shfl_xor(v, 2); v += __shfl_xor(v, 4); return v; }
__device__ __forceinline__ float sigmoidf_(float x) { return 1.0f / (1.0f + __expf(-x)); }
__device__ __forceinline__ float softplusf_(float x) { return fmaxf(x, 0.f) + log1pf(__expf(-fabsf(x))); }

__device__ __forceinline__ void lds_barrier() { asm volatile("s_waitcnt lgkmcnt(0)" ::: "memory"); __builtin_amdgcn_s_barrier(); asm volatile("" ::: "memory"); }
namespace pg8 {
__device__ __forceinline__ float bf2f_(unsigned v) { return __builtin_bit_cast(float, v << 16); }
constexpr int BM = 256, BK = 64, HALF = 128, HTB = HALF * BK * 2, STAGE_BYTES = 8 * HTB;
__device__ __forceinline__ int lds_byte(int r, int c) { const int st = (r >> 4) * 2 + (c >> 5), rr = r & 15, cc = c & 31, ob = rr * 64 + cc * 2; return st * 1024 + (ob ^ (((ob >> 9) & 1) << 5)); }
__device__ __forceinline__ void stage_rc(int b, int& R, int& C) { const int st = b / 1024, sb = b % 1024, swz = sb ^ (((sb >> 9) & 1) << 5); R = (st >> 1) * 16 + swz / 64; C = (st & 1) * 32 + (swz % 64) / 2; }
__device__ __forceinline__ int perm32(int rho) { const int n = rho >> 4, i = rho & 15; return 8 * (i >> 2) + 4 * n + (i & 3); }
__device__ __forceinline__ unsigned cvt_pk_bf16(float lo, float hi) { return pack2(lo, hi); }

struct Unit { const char* b; int row0, col0, cnt, lrow; };

struct DenseOrder {
    int nM, nN, nwg, G, c, K; const char* Bt;
    __device__ void init(int M, int N, int K_, const void* Bt_, int G_, int c_) { nM = M / BM; nN = N / BM; nwg = nM * nN; G = G_; c = c_; K = K_; Bt = (const char*)Bt_; }
    __device__ __forceinline__ bool next(int i, Unit& u) const {
        const long L = (long)i * G + c; if (L >= nwg) return false;
        int wgid = (int)L; { const int q = nwg / 8, r = nwg % 8, xcd = wgid % 8, off = wgid / 8; wgid = (xcd < r ? xcd * (q + 1) : r * (q + 1) + (xcd - r) * q) + off; }
        const int nig = 8 * nN, gid = wgid / nig, fm = gid * 8, gsz = (nM - fm) < 8 ? (nM - fm) : 8;
        const int pm = fm + ((wgid % nig) % gsz), pn = (wgid % nig) / gsz;
        u.row0 = pm * BM; u.col0 = pn * BM; u.b = Bt + (size_t)pn * BM * K * 2; u.cnt = BM; u.lrow = 0; return true;
    }
    __device__ __forceinline__ unsigned arow(const Unit& u, int r) const { return (unsigned)(u.row0 + r); }
};
struct MoeOrder {
    const LAS int* tstart; const int* cnt; const int* list; const char* W; size_t wstride; int npn, G, c, K, gather;
    __device__ __forceinline__ bool next(int i, Unit& u) const {
        const int L = i * G + c; const int total = tstart[32] * npn; if (L >= total) return false;
        const int grp = 8 * npn, g0 = L / grp, gr = L - g0 * grp; int tile = 8 * g0 + (gr & 7), pn = gr >> 3;
        const int ntile = tstart[32]; if (8 * g0 + 8 > ntile) { const int Lr = L - g0 * grp; tile = 8 * g0 + Lr / npn; pn = Lr - (Lr / npn) * npn; }
        int e = 0;
#pragma unroll 1
        for (int k = 1; k < 32; ++k) e = (tstart[k] <= tile) ? k : e;
        const int j = tile - tstart[e];
        int c2 = cnt[e] - 256 * j; u.cnt = c2 > 256 ? 256 : c2; u.lrow = e * MCAP + 256 * j; u.row0 = tile * 256; u.col0 = pn * 256;
        u.b = W + (size_t)e * wstride + (size_t)pn * 256 * K * 2; return true;
    }
    __device__ __forceinline__ unsigned arow(const Unit& u, int r) const {
        if (gather) return (r < u.cnt) ? (unsigned)(list[u.lrow + r] >> 1) : 0u;
        return (unsigned)(u.row0 + r);
    }
};

template <bool RS, bool RES> struct EpiStoreBf16T {
    static constexpr bool PERM = true;
    bf16_t* O; int ldc; int ncols; int dry; const float* rs; const bf16_t* res;
    __device__ __forceinline__ void operator()(const f32x4 (&acc)[2][2][4][2], const Unit& u, int wr, int wc, int fr, int fq) const {
        const int row0 = u.row0 + wr * 64 + fr, col0 = u.col0 + wc * 32 + 8 * fq;
#pragma unroll
        for (int ai = 0; ai < 2; ++ai)
#pragma unroll
            for (int m = 0; m < 4; ++m) { bf16_t* rowp = O + (size_t)(row0 + ai * HALF + m * 16) * ldc + col0; const float sc = RS ? rs[row0 + ai * HALF + m * 16] : 1.0f;
#pragma unroll
                for (int bj = 0; bj < 2; ++bj) { f32x4 v0 = acc[ai][bj][m][0] * sc, v1 = acc[ai][bj][m][1] * sc;
                    if (RES) { const u32x4 rr = *(const u32x4*)(res + (size_t)(row0 + ai * HALF + m * 16) * ldc + col0 + bj * HALF);
                        v0[0] += bf2f_(rr.x & 0xffffu); v0[1] += bf2f_(rr.x >> 16); v0[2] += bf2f_(rr.y & 0xffffu); v0[3] += bf2f_(rr.y >> 16);
                        v1[0] += bf2f_(rr.z & 0xffffu); v1[1] += bf2f_(rr.z >> 16); v1[2] += bf2f_(rr.w & 0xffffu); v1[3] += bf2f_(rr.w >> 16); }
                    u32x4 w; w.x = cvt_pk_bf16(v0[0], v0[1]); w.y = cvt_pk_bf16(v0[2], v0[3]); w.z = cvt_pk_bf16(v1[0], v1[1]); w.w = cvt_pk_bf16(v1[2], v1[3]);
                    if (col0 + bj * HALF < ncols && !dry) *(u32x4*)(rowp + bj * HALF) = w; } }
    }
};
struct EpiSwiglu {
    static constexpr bool PERM = false;
    bf16_t* HID; int dry; const float* ls;
    __device__ __forceinline__ void operator()(const f32x4 (&acc)[2][2][4][2], const Unit& u, int wr, int wc, int fr, int fq) const {
        const int row0 = u.row0 + wr * 64 + fr, hc0 = (u.col0 >> 1) + wc * 32 + 4 * fq;
        float scv[2][4];
#pragma unroll
        for (int ai = 0; ai < 2; ++ai)
#pragma unroll
            for (int m = 0; m < 4; ++m) { const int r = wr * 64 + fr + ai * HALF + m * 16; const float v = ls[u.lrow + (r < u.cnt ? r : 0)]; scv[ai][m] = r < u.cnt ? v : 0.f; }
#pragma unroll
        for (int ai = 0; ai < 2; ++ai)
#pragma unroll
            for (int m = 0; m < 4; ++m) { bf16_t* rowp = HID + (size_t)(row0 + ai * HALF + m * 16) * 256 + hc0; const float sc = scv[ai][m];
#pragma unroll
                for (int n = 0; n < 2; ++n) { const f32x4 g = acc[ai][0][m][n] * sc, up = acc[ai][1][m][n] * sc; float h[4];
#pragma unroll
                    for (int q = 0; q < 4; ++q) h[q] = g[q] / (1.0f + __expf(-g[q])) * up[q];
                    u32x2 w; w.x = cvt_pk_bf16(h[0], h[1]); w.y = cvt_pk_bf16(h[2], h[3]); if (!dry) *(u32x2*)(rowp + n * 16) = w; else asm volatile("" :: "v"(w)); } }
    }
};
struct EpiScatter {
    static constexpr bool PERM = true;
    bf16_t* YM; const int* list; const float* lw; int dry;
    __device__ __forceinline__ void operator()(const f32x4 (&acc)[2][2][4][2], const Unit& u, int wr, int wc, int fr, int fq) const {
        const int r0 = wr * 64 + fr, col0 = u.col0 + wc * 32 + 8 * fq;
        int entv[2][4]; float wgtv[2][4];
#pragma unroll
        for (int ai = 0; ai < 2; ++ai)
#pragma unroll
            for (int m = 0; m < 4; ++m) { const int r = r0 + ai * HALF + m * 16, rc = u.lrow + (r < u.cnt ? r : 0); entv[ai][m] = list[rc]; wgtv[ai][m] = lw[rc]; }
#pragma unroll
        for (int ai = 0; ai < 2; ++ai)
#pragma unroll
            for (int m = 0; m < 4; ++m) { const int r = r0 + ai * HALF + m * 16;
                if (r < u.cnt) { const int ent = entv[ai][m]; const float wgt = wgtv[ai][m]; bf16_t* rowp = YM + (size_t)ent * 1024 + col0;
#pragma unroll
                    for (int bj = 0; bj < 2; ++bj) { const f32x4 v0 = acc[ai][bj][m][0] * wgt, v1 = acc[ai][bj][m][1] * wgt;
                        u32x4 w; w.x = cvt_pk_bf16(v0[0], v0[1]); w.y = cvt_pk_bf16(v0[2], v0[3]); w.z = cvt_pk_bf16(v1[0], v1[1]); w.w = cvt_pk_bf16(v1[2], v1[3]);
                        if (!dry) *(u32x4*)(rowp + bj * HALF) = w; else asm volatile("" :: "v"(w)); } } }
    }
};

template <class Epi, class Sched, bool ALIGN_EPI = true, bool SP2 = true>
__device__ __forceinline__ void gemm_phase(LAS unsigned char* lds, const char* Abase, const int K, const Sched& S, const Epi& E) {
    const int tid = threadIdx.x, wid = __builtin_amdgcn_readfirstlane(tid >> 6), lane = tid & 63, wr = wid >> 2, wc = wid & 3, fr = lane & 15, fq = lane >> 4;
    const int nt = K / BK;
    int RA[2]; unsigned CA[2], voffB[2];
#pragma unroll
    for (int i = 0; i < 2; ++i) { int R, C; stage_rc(tid * 16 + i * 8192, R, C); const int Rb = Epi::PERM ? ((R & ~31) + perm32(R & 31)) : R;
        RA[i] = R; CA[i] = (unsigned)C * 2u; voffB[i] = (unsigned)(Rb * K + C) * 2u; }
    const size_t kstep = (size_t)(BK * 2);
    const size_t hstep = (size_t)HALF * K * 2;
    const unsigned rowb = (unsigned)K * 2u;
    const unsigned ldsw = (unsigned)wid * 1024u;
    const int aoff = lds_byte(wr * 64 + fr, fq * 8), boff = lds_byte(wc * 32 + fr, fq * 8);
#define PG8_SA(b, h) (((b) * 2 + (h)) * HTB)
#define PG8_SB(b, h) ((4 + (b) * 2 + (h)) * HTB)
#define PG8_STAGE_B(bufoff, gbase) do { _Pragma("unroll") for (int _i = 0; _i < 2; ++_i) \
        __builtin_amdgcn_global_load_lds((const unsigned*)((const char*)(gbase) + voffB[_i]), (LAS unsigned*)(lds + (bufoff) + ldsw + _i * 8192), 16, 0, 0); } while (0)
#define PG8_STAGE_A(bufoff, OFF, h, kb) do { _Pragma("unroll") for (int _i = 0; _i < 2; ++_i) \
        __builtin_amdgcn_global_load_lds((const unsigned*)(Abase + (size_t)(kb) + (OFF)[h][_i]), (LAS unsigned*)(lds + (bufoff) + ldsw + _i * 8192), 16, 0, 0); } while (0)
#define PG8_LDA(dst, b, h) do { _Pragma("unroll") for (int m = 0; m < 4; ++m) _Pragma("unroll") for (int k = 0; k < 2; ++k) dst[m][k] = *(const LAS bf16x8*)(lds + PG8_SA(b, h) + aoff + m * 2048 + k * 1024); } while (0)
#define PG8_LDB(dst, b, h) do { _Pragma("unroll") for (int n = 0; n < 2; ++n) _Pragma("unroll") for (int k = 0; k < 2; ++k) dst[n][k] = *(const LAS bf16x8*)(lds + PG8_SB(b, h) + boff + n * 2048 + k * 1024); } while (0)
#define PG8_MMA(ai, bj, At, Bt) do { __builtin_amdgcn_s_setprio(1); _Pragma("unroll") for (int m = 0; m < 4; ++m) _Pragma("unroll") for (int n = 0; n < 2; ++n) _Pragma("unroll") for (int k = 0; k < 2; ++k) \
        acc[ai][bj][m][n] = __builtin_amdgcn_mfma_f32_16x16x32_bf16(Bt[n][k], At[m][k], acc[ai][bj][m][n], 0, 0, 0); __builtin_amdgcn_s_setprio(0); } while (0)
#define PG8_WAIT_V(n) asm volatile("s_waitcnt vmcnt(" #n ")" ::: "memory")
#define PG8_WAIT_L(n) asm volatile("s_waitcnt lgkmcnt(" #n ")" ::: "memory")
#define PG8_BAR __builtin_amdgcn_s_barrier()
#define PG8_SCHED __builtin_amdgcn_sched_barrier(0)
    Unit cur, nxt; int ui = 0;
    if (!S.next(0, cur)) return;
    unsigned oc[2][2], on[2][2];
#pragma unroll
    for (int h = 0; h < 2; ++h)
#pragma unroll
        for (int i = 0; i < 2; ++i) oc[h][i] = S.arow(cur, h * HALF + RA[i]) * rowb + CA[i];
    f32x4 acc[2][2][4][2];
#pragma unroll
    for (int a = 0; a < 2; ++a)
#pragma unroll
        for (int b = 0; b < 2; ++b)
#pragma unroll
            for (int m = 0; m < 4; ++m)
#pragma unroll
                for (int n = 0; n < 2; ++n) acc[a][b][m][n] = (f32x4){0.f, 0.f, 0.f, 0.f};
    bf16x8 At[4][2], B0[2][2], B1[2][2];
    const char* cB = cur.b;
    if constexpr (SP2) {
        PG8_STAGE_B(PG8_SB(0, 0), cB); PG8_STAGE_B(PG8_SB(0, 1), cB + hstep); PG8_STAGE_A(PG8_SA(0, 0), oc, 0, 0); PG8_STAGE_A(PG8_SA(0, 1), oc, 1, 0);
        if (wr == 1) PG8_BAR;
        PG8_WAIT_V(2); PG8_BAR;
        PG8_STAGE_B(PG8_SB(1, 0), cB + kstep); PG8_STAGE_A(PG8_SA(1, 0), oc, 0, kstep); PG8_STAGE_B(PG8_SB(1, 1), cB + hstep + kstep);
        PG8_WAIT_V(6); PG8_BAR;
    } else {
    PG8_STAGE_B(PG8_SB(0, 0), cB); PG8_STAGE_A(PG8_SA(0, 0), oc, 0, 0); PG8_STAGE_B(PG8_SB(0, 1), cB + hstep); PG8_STAGE_A(PG8_SA(0, 1), oc, 1, 0);
    if (wr == 1) PG8_BAR;
    PG8_WAIT_V(4); PG8_BAR;
    PG8_STAGE_B(PG8_SB(1, 0), cB + kstep); PG8_STAGE_A(PG8_SA(1, 0), oc, 0, kstep); PG8_STAGE_B(PG8_SB(1, 1), cB + hstep + kstep);
    PG8_WAIT_V(6); PG8_BAR;
    }
    for (;;) {
        const bool has_next = S.next(ui + 1, nxt);
        const char* nB = has_next ? nxt.b : cB;
#pragma unroll
        for (int h = 0; h < 2; ++h)
#pragma unroll
            for (int i = 0; i < 2; ++i) on[h][i] = has_next ? (S.arow(nxt, h * HALF + RA[i]) * rowb + CA[i]) : oc[h][i];
        for (int t = 0; t < nt; t += 2) {
            const bool last = (t == nt - 2);
            const size_t k1 = (size_t)(t + 1) * kstep;
            const size_t k2 = last ? (size_t)0 : (size_t)(t + 2) * kstep, k3 = k2 + kstep;
            const char* b2 = last ? nB : cB + (size_t)(t + 2) * kstep; const char* b3 = b2 + kstep;
            unsigned o2[2][2];
#pragma unroll
            for (int h = 0; h < 2; ++h)
#pragma unroll
                for (int i = 0; i < 2; ++i) o2[h][i] = last ? on[h][i] : oc[h][i];
            if constexpr (SP2) {
            PG8_LDB(B0, 0, 0); PG8_LDB(B1, 0, 1); PG8_SCHED; PG8_LDA(At, 0, 0); PG8_STAGE_A(PG8_SA(1, 1), oc, 1, k1);
            PG8_WAIT_V(8); PG8_WAIT_L(0); PG8_BAR; PG8_MMA(0, 0, At, B0); PG8_MMA(0, 1, At, B1); PG8_BAR; PG8_SCHED;
            PG8_LDA(At, 0, 1); PG8_STAGE_B(PG8_SB(0, 0), b2); PG8_STAGE_B(PG8_SB(0, 1), b2 + hstep); PG8_STAGE_A(PG8_SA(0, 0), o2, 0, k2);
            PG8_WAIT_V(8); PG8_WAIT_L(0); PG8_BAR; PG8_MMA(1, 0, At, B0); PG8_MMA(1, 1, At, B1); PG8_BAR; PG8_SCHED;
            PG8_LDB(B0, 1, 0); PG8_LDB(B1, 1, 1); PG8_SCHED; PG8_LDA(At, 1, 0); PG8_STAGE_A(PG8_SA(0, 1), o2, 1, k2);
            PG8_WAIT_V(8); PG8_WAIT_L(0); PG8_BAR; PG8_MMA(0, 0, At, B0); PG8_MMA(0, 1, At, B1); PG8_BAR; PG8_SCHED;
            PG8_LDA(At, 1, 1); PG8_STAGE_B(PG8_SB(1, 0), b3); PG8_STAGE_B(PG8_SB(1, 1), b3 + hstep); PG8_STAGE_A(PG8_SA(1, 0), o2, 0, k3);
            PG8_WAIT_V(8); PG8_WAIT_L(0); PG8_BAR; PG8_MMA(1, 0, At, B0); PG8_MMA(1, 1, At, B1); PG8_BAR; PG8_SCHED;
            } else {
            PG8_LDB(B0, 0, 0); PG8_SCHED; PG8_LDA(At, 0, 0); PG8_STAGE_A(PG8_SA(1, 1), oc, 1, k1);
            PG8_WAIT_L(8); PG8_BAR; PG8_WAIT_L(0); PG8_MMA(0, 0, At, B0); PG8_BAR; PG8_SCHED;
            PG8_LDB(B1, 0, 1); PG8_STAGE_B(PG8_SB(0, 0), b2);
            PG8_BAR; PG8_WAIT_L(0); PG8_MMA(0, 1, At, B1); PG8_BAR;
            PG8_LDA(At, 0, 1); PG8_STAGE_A(PG8_SA(0, 0), o2, 0, k2);
            PG8_BAR; PG8_WAIT_L(0); PG8_MMA(1, 0, At, B0); PG8_BAR; PG8_SCHED;
            PG8_STAGE_B(PG8_SB(0, 1), b2 + hstep);
            PG8_WAIT_V(6); PG8_BAR; PG8_MMA(1, 1, At, B1); PG8_BAR;
            PG8_LDB(B0, 1, 0); PG8_SCHED; PG8_LDA(At, 1, 0); PG8_STAGE_A(PG8_SA(0, 1), o2, 1, k2);
            PG8_WAIT_L(8); PG8_BAR; PG8_WAIT_L(0); PG8_MMA(0, 0, At, B0); PG8_BAR; PG8_SCHED;
            PG8_LDB(B1, 1, 1); PG8_STAGE_B(PG8_SB(1, 0), b3);
            PG8_BAR; PG8_WAIT_L(0); PG8_MMA(0, 1, At, B1); PG8_BAR;
            PG8_LDA(At, 1, 1); PG8_STAGE_A(PG8_SA(1, 0), o2, 0, k3);
            PG8_BAR; PG8_WAIT_L(0); PG8_MMA(1, 0, At, B0); PG8_BAR; PG8_SCHED;
            PG8_STAGE_B(PG8_SB(1, 1), b3 + hstep);
            PG8_WAIT_V(6); PG8_BAR; PG8_MMA(1, 1, At, B1); PG8_BAR;
            }
        }
        if constexpr (ALIGN_EPI) { if (wr == 0) PG8_BAR; }
        E(acc, cur, wr, wc, fr, fq);
        if (!has_next) break;
#pragma unroll
        for (int a = 0; a < 2; ++a)
#pragma unroll
            for (int b = 0; b < 2; ++b)
#pragma unroll
                for (int m = 0; m < 4; ++m)
#pragma unroll
                    for (int n = 0; n < 2; ++n) acc[a][b][m][n] = (f32x4){0.f, 0.f, 0.f, 0.f};
        cur = nxt; cB = nB; ++ui;
#pragma unroll
        for (int h = 0; h < 2; ++h)
#pragma unroll
            for (int i = 0; i < 2; ++i) oc[h][i] = on[h][i];
        if constexpr (ALIGN_EPI) { if (wr == 1) PG8_BAR; }
    }
    PG8_WAIT_V(0);
    if constexpr (!ALIGN_EPI) { if (wr == 0) PG8_BAR; }
    PG8_BAR;
#undef PG8_SA
#undef PG8_SB
#undef PG8_STAGE_A
#undef PG8_STAGE_B
#undef PG8_LDA
#undef PG8_LDB
#undef PG8_MMA
#undef PG8_WAIT_V
#undef PG8_WAIT_L
#undef PG8_BAR
#undef PG8_SCHED
}
}

struct Ctx {
    const Params* p; LAS unsigned char* lds; int tid, lane, wave, G, bid, dry;
    unsigned char* ws; unsigned char* dsc;
#define WSP(T, name, off) __device__ __forceinline__ T* name() const { return (T*)(ws + (off)); }
#define DSP(T, name, off) __device__ __forceinline__ T* name() const { return (T*)(dsc + (off)); }
    WSP(bf16_t, H, WS_H) WSP(bf16_t, P, WS_P) WSP(bf16_t, Y, WS_Y) WSP(bf16_t, HN, WS_HN)
    WSP(bf16_t, WinE, WS_WINE) WSP(bf16_t, WoutE, WS_WOUTE) WSP(bf16_t, WinO, WS_WINO) WSP(bf16_t, WoutO, WS_WOUTO) WSP(bf16_t, W1, WS_W1) WSP(bf16_t, W2, WS_W2)
    WSP(int, mcnt, WS_CTL + 16384)
    WSP(bf16_t, YM, WS_P + PO_YM) WSP(bf16_t, HID, WS_P + PO_HID) WSP(int, mlist, WS_P + PO_LIST) WSP(float, mlw, WS_P + PO_LW) WSP(float, mls, WS_P + PO_LS) WSP(float, srow, WS_SROW) WSP(bf16_t, XB, WS_H + (size_t)NP * 1024 * 2)
    DSP(float, lruA, DO_LRUA) DSP(float, lruH, DO_LRUH) DSP(float, lruC, DO_LRUC) DSP(float, glaG, DO_GLAG)
    WSP(bf16_t, DUt, WS_DUT) WSP(bf16_t, IUt, WS_IUT) WSP(bf16_t, GUt, WS_GUT) WSP(bf16_t, WAt, WS_WAT) WSP(bf16_t, WXt, WS_WXT) WSP(bf16_t, WrH, WS_WRH) WSP(bf16_t, WrL, WS_WRL) WSP(float, LAMC, WS_LAMC)
    WSP(bf16_t, GLUt, WS_GLU)
    WSP(bf16_t, rwGP, WS_HN) WSP(bf16_t, rwQE, WS_HN + (size_t)NRU * 4096 * 2)
    DSP(bf16_t, rwHC, DO_RWHC) DSP(bf16_t, rwOO, DO_RWOO) DSP(bf16_t, rwE2, DO_RWE2) DSP(float, rwGL, DO_RWGL)
    __device__ __forceinline__ bf16_t* lruLA(const int b) const { return b < 4 ? (bf16_t*)(ws + WS_P + (size_t)NP * EVEN_IN * 2) + (size_t)b * TP * 512 : (bf16_t*)(dsc + DO_END) + (size_t)(b - 4) * TP * 512; }
    DSP(bf16_t, gKH, DO_RWHC) DSP(bf16_t, gVC, DO_RWHC + (size_t)BATCH * 4 * NCH * 8192 * 2)
#undef WSP
#undef DSP
};

constexpr int NJ_WINE = 16 * 44, NJ_WOUT = 256, NJ_WINO = 16 * 49, NJ_W1 = 64 * 128, NJ_W2 = 64 * 64;
constexpr int J1 = NJ_WINE, J2 = J1 + NJ_WOUT, J3 = J2 + NJ_WINO, J4 = J3 + NJ_WOUT, J5 = J4 + NJ_W1, J6 = J5 + NJ_W2, J7 = J6 + 48;
struct ConvJob { const float* src; bf16_t* dst; const float* ksc; int lds_src, ldd, nvalid; };
__device__ __forceinline__ ConvJob conv_decode(const Ctx& c, const int job) {
    const Params& p = *c.p; ConvJob J; J.nvalid = 64; J.ksc = nullptr;
    int j = job;
    if (j < J1) { const int kt = j / 44, nt = j % 44; J.src = p.in[I_EWIN] + (size_t)kt * 64 * EVEN_IN + nt * 64; J.lds_src = EVEN_IN; J.ksc = p.in[I_ENORM] + kt * 64; J.dst = c.WinE() + (size_t)nt * 64 * 1024 + kt * 64; J.ldd = 1024; }
    else if (j < J2) { j -= J1; const int kt = j / 16, nt = j % 16; J.src = p.in[I_EWOUT] + (size_t)kt * 64 * 1024 + nt * 64; J.lds_src = 1024; J.dst = c.WoutE() + (size_t)nt * 64 * 1024 + kt * 64; J.ldd = 1024; }
    else if (j < J3) { j -= J2; const int kt = j / 49, nt = j % 49; J.src = p.in[I_OWIN] + (size_t)kt * 64 * ODD_IN + nt * 64; J.lds_src = ODD_IN; J.ksc = p.in[I_ONORM] + kt * 64; J.nvalid = (ODD_IN - nt * 64) < 64 ? (ODD_IN - nt * 64) : 64;
        J.dst = c.WinO() + (size_t)nt * 64 * 1024 + kt * 64; J.ldd = 1024; }
    else if (j < J4) { j -= J3; const int kt = j / 16, nt = j % 16; J.src = p.in[I_OWOUT] + (size_t)kt * 64 * 1024 + nt * 64; J.lds_src = 1024; J.dst = c.WoutO() + (size_t)nt * 64 * 1024 + kt * 64; J.ldd = 1024; }
    else if (j < J5) { j -= J4; const int le = j / 128, r = j % 128, which = r / 64, r2 = r % 64, kt = r2 / 4, nt = r2 % 4;
        J.src = p.in[which ? I_MWUP : I_MWGATE] + (size_t)le * 1024 * 256 + (size_t)kt * 64 * 256 + nt * 64; J.lds_src = 256; J.ksc = p.in[I_MNORM] + (le >> 5) * 1024 + kt * 64;
        const int row0 = (nt >> 1) * 256 + (nt & 1) * 64 + which * 128;
        J.dst = c.W1() + (size_t)le * 512 * 1024 + (size_t)row0 * 1024 + kt * 64; J.ldd = 1024; }
    else if (j >= J6) { j -= J6;
        if (j < 8) { J.src = p.in[I_EDECAYUP] + j * 64; J.lds_src = 512; J.dst = c.DUt() + (size_t)j * 64 * 64; J.ldd = 64; }
        else if (j < 16) { j -= 8; J.src = p.in[I_EICLRUP] + j * 64; J.lds_src = 512; J.dst = c.IUt() + (size_t)j * 64 * 64; J.ldd = 64; }
        else if (j < 32) { j -= 16; const int kt = j / 8, nt = j % 8; J.src = p.in[I_EGATEUP] + (size_t)kt * 64 * 512 + nt * 64; J.lds_src = 512; J.dst = c.GUt() + (size_t)nt * 64 * 128 + kt * 64; J.ldd = 128; }
        else if (j < 40) { j -= 32; J.src = p.in[I_ELRUWA] + (size_t)j * 4096; J.lds_src = 64; J.dst = c.WAt() + (size_t)j * 4096; J.ldd = 64; }
        else { j -= 40; J.src = p.in[I_ELRUWX] + (size_t)j * 4096; J.lds_src = 64; J.dst = c.WXt() + (size_t)j * 4096; J.ldd = 64; } }
    else { j -= J5; const int le = j / 64, r = j % 64, kt = r / 16, nt = r % 16;
        J.src = p.in[I_MWDOWN] + (size_t)le * 256 * 1024 + (size_t)kt * 64 * 1024 + nt * 64; J.lds_src = 1024;
        J.dst = c.W2() + (size_t)le * 1024 * 256 + (size_t)nt * 64 * 256 + kt * 64; J.ldd = 256; }
    return J;
}
constexpr int CONV_T = 2;
template <bool FAST> __device__ __forceinline__ void conv_range(const Ctx& c, const int lo, const int hi, const int vb, const int nvb) {
    const int tid = c.tid;
    lfloat* tile = (lfloat*)(c.lds + LDS_PH);
    for (int j0 = lo + CONV_T * vb; j0 < hi; j0 += CONV_T * nvb) {
        f32x4 v[CONV_T][2]; const float* ksc[CONV_T];
#pragma unroll
        for (int q = 0; q < CONV_T; ++q) { const int job = (j0 + q) < hi ? (j0 + q) : (hi - 1); const ConvJob J = conv_decode(c, job); ksc[q] = J.ksc;
#pragma unroll
            for (int i = 0; i < 2; ++i) { const int k = (tid >> 4) + 32 * i, n4 = (tid & 15) * 4;
                if (FAST) v[q][i] = *(const f32x4*)(J.src + (size_t)k * J.lds_src + (n4 < J.nvalid ? n4 : 0));
                else { v[q][i] = (f32x4){0.f, 0.f, 0.f, 0.f}; if (n4 < J.nvalid) v[q][i] = *(const f32x4*)(J.src + (size_t)k * J.lds_src + n4); } } }
#pragma unroll
        for (int q = 0; q < CONV_T; ++q)
#pragma unroll
            for (int i = 0; i < 2; ++i) { const int k = (tid >> 4) + 32 * i, n4 = (tid & 15) * 4; lfloat* tp = tile + q * 4160 + k * 65 + n4; const float g = ksc[q] ? ksc[q][k] : 1.0f;
                tp[0] = v[q][i][0] * g; tp[1] = v[q][i][1] * g; tp[2] = v[q][i][2] * g; tp[3] = v[q][i][3] * g; }
        __syncthreads();
#pragma unroll
        for (int q = 0; q < CONV_T; ++q) { const int job = j0 + q;
            if (job < hi) { const ConvJob J = conv_decode(c, job); const int n = tid >> 3, k8 = (tid & 7) * 8;
                if (n < J.nvalid) { float o[8];
#pragma unroll
                    for (int e = 0; e < 8; ++e) o[e] = tile[q * 4160 + (k8 + e) * 65 + n];
                    if (!c.dry) *(u32x4*)(J.dst + (size_t)n * J.ldd + k8) = pack8(o); } } }
        __syncthreads();
    }
}

__device__ __forceinline__ void ph_prologue(const Ctx& c) {
    const Params& p = *c.p; const int tid = c.tid;
    conv_range<true>(c, 0, J1, c.bid, c.G); conv_range<true>(c, J6, J7, c.bid, c.G);
    if (c.bid == 0 && !c.dry) c.LAMC()[tid] = -8.0f * softplusf_(-p.in[I_ELAMBDA][tid]);
    for (int row = c.bid * 8 + c.wave; row < NP; row += c.G * 8) {
        const int b = row / TP, t = row % TP;
        bf16_t* nrow = c.XB() + (size_t)row * 1024;
        if (t >= TT) {
#pragma unroll
            for (int i = 0; i < 4; ++i) { if (!c.dry) *(u32x2*)(nrow + 4 * c.lane + 256 * i) = (u32x2){0u, 0u}; }
            if (c.lane == 0 && !c.dry) c.srow()[row] = 0.f;
            continue;
        }
        const float* src = t < NMETA ? p.in[I_META] + (size_t)t * 1024 : p.in[I_X] + ((size_t)b * SEQ + (t - NMETA)) * 1024;
        f32x4 v[4]; float ss = 0.f;
#pragma unroll
        for (int i = 0; i < 4; ++i) { v[i] = *(const f32x4*)(src + 4 * c.lane + 256 * i); ss += v[i][0] * v[i][0] + v[i][1] * v[i][1] + v[i][2] * v[i][2] + v[i][3] * v[i][3]; }
        ss = wave_sum(ss);
        if (c.lane == 0 && !c.dry) c.srow()[row] = rsqrtf(ss * (1.0f / 1024.0f) + 1e-6f);
#pragma unroll
        for (int i = 0; i < 4; ++i) { u32x2 w; w.x = pack2(v[i][0], v[i][1]); w.y = pack2(v[i][2], v[i][3]); if (!c.dry) *(u32x2*)(nrow + 4 * c.lane + 256 * i) = w; }
    }
}
__device__ __forceinline__ void filler_A(const Ctx& c, const int vb, const int nvb) {
    const Params& p = *c.p; const int tid = c.tid;
    conv_range<true>(c, J1, J4 + 4096, vb, nvb); conv_range<true>(c, J5, J5 + 2048, vb, nvb);
    for (int idx = vb * NTHREADS + tid; idx < 2 * 48 * 1024; idx += nvb * NTHREADS) {
        const int l = idx / (48 * 1024), r = idx % (48 * 1024), e = r / 1024, k = r % 1024;
        const float val = (e < 4 ? p.in[I_MWGROUP][((size_t)l * 1024 + k) * 4 + e] : e < 36 ? p.in[I_MWROUTER][((size_t)l * 1024 + k) * 32 + (e - 4)] : 0.f) * p.in[I_MNORM][(size_t)l * 1024 + k];
        const bf16_t hi = f2bf(val); const bf16_t lo = f2bf(val - bf2f(hi));
        if (!c.dry) { c.WrH()[idx] = hi; c.WrL()[idx] = lo; } }
    for (int idx = vb * NTHREADS + tid; idx < 512 * 32; idx += nvb * NTHREADS) { const int n = idx >> 5, k = idx & 31; if (!c.dry) c.GLUt()[idx] = k < 16 ? f2bf(p.in[I_OGUP][k * 512 + n]) : (bf16_t)0; }
    for (int idx = vb * NTHREADS + tid; idx < (ODD_IN_PAD - ODD_IN) * 1024 / 8; idx += nvb * NTHREADS)
        if (!c.dry) *(u32x4*)(c.WinO() + (size_t)ODD_IN * 1024 + (size_t)idx * 8) = (u32x4){0u, 0u, 0u, 0u};
}
__device__ __forceinline__ void filler_B(const Ctx& c, const int vb, const int nvb) { conv_range<true>(c, J4 + 4096, J5, vb, nvb); conv_range<true>(c, J5 + 2048, J6, vb, nvb); }

typedef LAS bf16_t lbf;
#define MFMA16(a, b, c) __builtin_amdgcn_mfma_f32_16x16x32_bf16(a, b, c, 0, 0, 0)
__device__ __forceinline__ bf16x8 ldfrag(const lbf* base, int ld, int row0, int k0, int lane) { return *(const LAS bf16x8*)(base + (row0 + (lane & 15)) * ld + k0 + (lane >> 4) * 8); }
__device__ __forceinline__ bf16x8 gfrag(const bf16_t* base, int ld, int row0, int k0, int lane) { return *(const bf16x8*)(base + (size_t)(row0 + (lane & 15)) * ld + k0 + (lane >> 4) * 8); }
__device__ __forceinline__ u32x2 pk4(const f32x4 a) { u32x2 w; w.x = pg8::cvt_pk_bf16(a[0], a[1]); w.y = pg8::cvt_pk_bf16(a[2], a[3]); return w; }
__device__ __forceinline__ f32x4 up4(const u32x2 w) { return (f32x4){bf2f(w.x & 0xffffu), bf2f(w.x >> 16), bf2f(w.y & 0xffffu), bf2f(w.y >> 16)}; }
__device__ __forceinline__ void st4(lbf* base, int ld, int i0, int j0, const f32x4 a, int lane) { *(LAS u32x2*)(base + (j0 + (lane & 15)) * ld + i0 + 4 * (lane >> 4)) = pk4(a); }


__device__ __forceinline__ float fast_sigmoid(float x) { return __builtin_amdgcn_rcpf(1.0f + __expf(-x)); }
struct LruRows { u32x4 xv[4]; u32x4 gb; };
__device__ __forceinline__ LruRows lru_load_rows(const Ctx& c, const int u, const bool final) {
    const int b = u / (NCH * 8), rem = u % (NCH * 8), ch = rem / 8, n = rem % 8;
    const int i = c.tid >> 3, cg0 = 64 * n + (c.tid & 7) * 8, t = ch * 64 + i;
    LruRows R; R.gb = (u32x4){0u, 0u, 0u, 0u};
#pragma unroll
    for (int j = 0; j < 4; ++j) { const int tj = t - 3 + j; const bool ok = tj >= 0 && tj < TT;
        const u32x4 x = *(const u32x4*)(c.P() + ((size_t)b * TP + (ok ? tj : 0)) * EVEN_IN + 1792 + cg0);
        R.xv[j] = ok ? x : (u32x4){0u, 0u, 0u, 0u}; }
    if (final) R.gb = *(const u32x4*)(c.P() + ((size_t)b * TP + t) * EVEN_IN + 2304 + cg0);
    return R;
}
__device__ __forceinline__ void lru_run(const Ctx& c, const bool final, const int vb, const int nvb) {
    const Params& p = *c.p; const int tid = c.tid, lane = c.lane, w = c.wave, fr = lane & 15, fq = lane >> 4;
    const int NU = BATCH * NCH * 8;
    if (vb >= NU) return;
    lbf* XA = (lbf*)(c.lds + LDS_PH);
    lfloat* XC = (lfloat*)(XA + 64 * 72);
    lfloat* AA = XC + 4096;
    lfloat* UU = AA + 4096;
    lfloat* SEGA = UU + 4096;
    lfloat* SEGH = SEGA + 512;
    lfloat* CARA = SEGH + 512;
    lfloat* CARH = CARA + 512;
    const int i = tid >> 3, j8 = (tid & 7) * 8, mi = w >> 1;
    const bool fixed_n = (nvb % 8) == 0;
    bf16x8 fwa[2][2], fwx[2][2];
    if (fixed_n) { const int n = vb % 8;
#pragma unroll
        for (int n2 = 0; n2 < 2; ++n2)
#pragma unroll
            for (int k = 0; k < 2; ++k) { fwa[n2][k] = gfrag(c.WAt() + n * 4096, 64, 16 * (2 * (w & 1) + n2), 32 * k, lane); fwx[n2][k] = gfrag(c.WXt() + n * 4096, 64, 16 * (2 * (w & 1) + n2), 32 * k, lane); } }
    LruRows R = lru_load_rows(c, vb, final);
    for (int u = vb; u < NU; u += nvb) {
        const int b = u / (NCH * 8), rem = u % (NCH * 8), ch = rem / 8, n = rem % 8, t0 = ch * 64, cg0 = 64 * n + j8, t = t0 + i;
        if (!fixed_n) {
#pragma unroll
            for (int n2 = 0; n2 < 2; ++n2)
#pragma unroll
                for (int k = 0; k < 2; ++k) { fwa[n2][k] = gfrag(c.WAt() + n * 4096, 64, 16 * (2 * (w & 1) + n2), 32 * k, lane); fwx[n2][k] = gfrag(c.WXt() + n * 4096, 64, 16 * (2 * (w & 1) + n2), 32 * k, lane); } }
        float ca = 1.f, chh = 0.f;
        float cra[17], crh[17];
        if (final) { const int chn = tid & 63, sg = tid >> 6;
#pragma unroll
            for (int j = 0; j < 17; ++j) { const int c2 = 17 * sg + j, c3 = c2 < NCH ? c2 : NCH - 1; const size_t s2i = ((size_t)b * NCH + c3) * 512 + 64 * n + chn; cra[j] = c.lruA()[s2i]; crh[j] = c.lruH()[s2i]; } }
        const u32x4 gbv = R.gb;
        { float xc[8];
            const f32x4 cb0 = *(const f32x4*)(p.in[I_ECONVB] + cg0), cb1 = *(const f32x4*)(p.in[I_ECONVB] + cg0 + 4);
            xc[0] = cb0[0]; xc[1] = cb0[1]; xc[2] = cb0[2]; xc[3] = cb0[3]; xc[4] = cb1[0]; xc[5] = cb1[1]; xc[6] = cb1[2]; xc[7] = cb1[3];
#pragma unroll
            for (int j = 0; j < 4; ++j) { float x[8]; unpack8(R.xv[j], x);
                const f32x4 w0 = *(const f32x4*)(p.in[I_ECONVW] + j * 512 + cg0), w1 = *(const f32x4*)(p.in[I_ECONVW] + j * 512 + cg0 + 4);
                xc[0] += w0[0] * x[0]; xc[1] += w0[1] * x[1]; xc[2] += w0[2] * x[2]; xc[3] += w0[3] * x[3];
                xc[4] += w1[0] * x[4]; xc[5] += w1[1] * x[5]; xc[6] += w1[2] * x[6]; xc[7] += w1[3] * x[7]; }
            *(LAS u32x4*)(XA + i * 72 + j8) = pack8(xc);
            *(LAS f32x4*)(XC + i * 64 + j8) = (f32x4){xc[0], xc[1], xc[2], xc[3]}; *(LAS f32x4*)(XC + i * 64 + j8 + 4) = (f32x4){xc[4], xc[5], xc[6], xc[7]}; }
        if (u + nvb < NU) R = lru_load_rows(c, u + nvb, final);
        lds_barrier();
#pragma unroll
        for (int n2 = 0; n2 < 2; ++n2) { const int ni = 2 * (w & 1) + n2; f32x4 gr = (f32x4){0.f, 0.f, 0.f, 0.f}, gi = gr;
#pragma unroll
            for (int k = 0; k < 2; ++k) { const bf16x8 xa = ldfrag(XA, 72, 16 * mi, 32 * k, lane); gr = MFMA16(fwa[n2][k], xa, gr); gi = MFMA16(fwx[n2][k], xa, gi); }
            const int tt = 16 * mi + fr, j = 16 * ni + 4 * fq, cg = 64 * n + j;
            const f32x4 xc4 = *(const LAS f32x4*)(XC + tt * 64 + j), ba = *(const f32x4*)(p.in[I_ELRUBA] + cg), bx = *(const f32x4*)(p.in[I_ELRUBX] + cg), lc = *(const f32x4*)(c.LAMC() + cg);
            f32x4 a4, u4;
#pragma unroll
            for (int r = 0; r < 4; ++r) { const float g_r = fast_sigmoid(gr[r] + ba[r]), g_i = fast_sigmoid(gi[r] + bx[r]);
                const float la = lc[r] * g_r, x2 = 2.0f * la;
                const float em = (x2 > -0.0625f) ? -x2 * (1.0f + x2 * (0.5f + x2 * (0.16666667f + x2 * 0.041666668f))) : 1.0f - __expf(x2);
                a4[r] = la; u4[r] = sqrtf(em) * g_i * xc4[r]; }
            const u32x2 lap = pk4(a4), up_ = pk4(u4); const f32x4 laf = up4(lap); u4 = up4(up_);
#pragma unroll
            for (int r = 0; r < 4; ++r) a4[r] = __expf(laf[r]);
            *(LAS f32x4*)(AA + tt * 64 + j) = a4; *(LAS f32x4*)(UU + tt * 64 + j) = u4;
            if (!c.dry) { *(u32x2*)(c.lruLA(b) + ((size_t)t0 + tt) * 512 + cg) = lap; *(u32x2*)(c.Y() + ((size_t)b * TP + t0 + tt) * 1024 + 512 + cg) = up_; } }
        lds_barrier();
        { const int chn = tid & 63, sg = tid >> 6; float ar[8], ur[8], h = 0.f, ap = 1.f;
#pragma unroll
            for (int q = 0; q < 8; ++q) { ar[q] = AA[(8 * sg + q) * 64 + chn]; ur[q] = UU[(8 * sg + q) * 64 + chn]; h = ar[q] * h + ur[q]; ap *= ar[q]; }
            SEGA[sg * 64 + chn] = ap; SEGH[sg * 64 + chn] = h;
            if (final) {
#pragma unroll
                for (int j = 0; j < 17; ++j) { const bool ok = (17 * sg + j) < ch; const float a2 = ok ? cra[j] : 1.f, h2 = ok ? crh[j] : 0.f; chh = a2 * chh + h2; ca *= a2; }
                CARA[sg * 64 + chn] = ca; CARH[sg * 64 + chn] = chh; }
            lds_barrier();
            const size_t si = ((size_t)b * NCH + ch) * 512 + 64 * n + chn;
            float cin = 0.f;
            if (!final) { if (sg == 7) { float at = 1.f;
#pragma unroll
                    for (int s2 = 0; s2 < 8; ++s2) { cin = SEGA[s2 * 64 + chn] * cin + SEGH[s2 * 64 + chn]; at *= SEGA[s2 * 64 + chn]; }
                    if (!c.dry) { c.lruA()[si] = at; c.lruH()[si] = cin; } } }
            else {
#pragma unroll
                for (int s2 = 0; s2 < 8; ++s2) cin = CARA[s2 * 64 + chn] * cin + CARH[s2 * 64 + chn];
                for (int s2 = 0; s2 < sg; ++s2) cin = SEGA[s2 * 64 + chn] * cin + SEGH[s2 * 64 + chn];
#pragma unroll
                for (int q = 0; q < 8; ++q) { cin = ar[q] * cin + ur[q]; UU[(8 * sg + q) * 64 + chn] = cin; } } }
        lds_barrier();
        if (final) { float g[8], o[8]; unpack8(gbv, g);
#pragma unroll
            for (int q = 0; q < 8; ++q) { const float x = g[q], uu2 = 1.5957691216057308f * (x + 0.044715f * x * x * x); o[q] = UU[i * 64 + j8 + q] * x * fast_sigmoid(uu2); }
            if (!c.dry) *(u32x4*)(c.Y() + ((size_t)b * TP + t) * 1024 + 512 + cg0) = pack8(o);
            lds_barrier(); }
    }
}
struct LruFin { u32x4 la, uu, gb; };
__device__ __forceinline__ LruFin lru_fin_load(const Ctx& c, const int u) {
    const int b = u / (NCH * 8), rem = u % (NCH * 8), ch = rem / 8, n = rem % 8;
    const int i = c.tid >> 3, cg0 = 64 * n + (c.tid & 7) * 8; const size_t t = (size_t)ch * 64 + i;
    LruFin R; R.la = *(const u32x4*)(c.lruLA(b) + t * 512 + cg0); R.uu = *(const u32x4*)(c.Y() + ((size_t)b * TP + t) * 1024 + 512 + cg0); R.gb = *(const u32x4*)(c.P() + ((size_t)b * TP + t) * EVEN_IN + 2304 + cg0);
    return R;
}
__device__ __forceinline__ void lru_final_run(const Ctx& c, const int vb, const int nvb) {
    const int tid = c.tid; const int NU = BATCH * NCH * 8;
    if (vb >= NU) return;
    lfloat* AA = (lfloat*)(c.lds + LDS_PH);
    lfloat* UU = AA + 4096;
    lfloat* SEGA = UU + 4096;
    lfloat* SEGH = SEGA + 512;
    lfloat* CARA = SEGH + 512;
    lfloat* CARH = CARA + 512;
    const int i = tid >> 3, j8 = (tid & 7) * 8, chn = tid & 63, sg = tid >> 6;
    LruFin R = lru_fin_load(c, vb);
    for (int u = vb; u < NU; u += nvb) {
        const int b = u / (NCH * 8), rem = u % (NCH * 8), ch = rem / 8, n = rem % 8, t0 = ch * 64;
        float cra[17], crh[17];
#pragma unroll
        for (int j = 0; j < 17; ++j) { const int c2 = 17 * sg + j, c3 = c2 < NCH ? c2 : NCH - 1; const size_t s2i = ((size_t)b * NCH + c3) * 512 + 64 * n + chn; cra[j] = c.lruA()[s2i]; crh[j] = c.lruH()[s2i]; }
        { float la[8], uu[8]; unpack8(R.la, la); unpack8(R.uu, uu);
            *(LAS f32x4*)(AA + i * 64 + j8) = (f32x4){__expf(la[0]), __expf(la[1]), __expf(la[2]), __expf(la[3])}; *(LAS f32x4*)(AA + i * 64 + j8 + 4) = (f32x4){__expf(la[4]), __expf(la[5]), __expf(la[6]), __expf(la[7])};
            *(LAS f32x4*)(UU + i * 64 + j8) = (f32x4){uu[0], uu[1], uu[2], uu[3]}; *(LAS f32x4*)(UU + i * 64 + j8 + 4) = (f32x4){uu[4], uu[5], uu[6], uu[7]}; }
        const u32x4 gbv = R.gb;
        if (u + nvb < NU) R = lru_fin_load(c, u + nvb);
        lds_barrier();
        { float ar[8], ur[8], h = 0.f, ap = 1.f;
#pragma unroll
            for (int q = 0; q < 8; ++q) { ar[q] = AA[(8 * sg + q) * 64 + chn]; ur[q] = UU[(8 * sg + q) * 64 + chn]; h = ar[q] * h + ur[q]; ap *= ar[q]; }
            SEGA[sg * 64 + chn] = ap; SEGH[sg * 64 + chn] = h;
            float ca = 1.f, chh = 0.f;
#pragma unroll
            for (int j = 0; j < 17; ++j) { const bool ok = (17 * sg + j) < ch; const float a2 = ok ? cra[j] : 1.f, h2 = ok ? crh[j] : 0.f; chh = a2 * chh + h2; ca *= a2; }
            CARA[sg * 64 + chn] = ca; CARH[sg * 64 + chn] = chh;
            lds_barrier();
            float cin = 0.f;
#pragma unroll
            for (int s2 = 0; s2 < 8; ++s2) cin = CARA[s2 * 64 + chn] * cin + CARH[s2 * 64 + chn];
            for (int s2 = 0; s2 < sg; ++s2) cin = SEGA[s2 * 64 + chn] * cin + SEGH[s2 * 64 + chn];
#pragma unroll
            for (int q = 0; q < 8; ++q) { cin = ar[q] * cin + ur[q]; UU[(8 * sg + q) * 64 + chn] = cin; } }
        lds_barrier();
        { float g[8], o[8]; unpack8(gbv, g);
#pragma unroll
            for (int q = 0; q < 8; ++q) { const float x = g[q], uu2 = 1.5957691216057308f * (x + 0.044715f * x * x * x); o[q] = UU[i * 64 + j8 + q] * x * fast_sigmoid(uu2); }
            if (!c.dry) *(u32x4*)(c.Y() + ((size_t)b * TP + t0 + i) * 1024 + 512 + 64 * n + j8) = pack8(o); }
        lds_barrier();
    }
}
__device__ __forceinline__ void ph_lru2(const Ctx& c, const bool final) { lru_run(c, final, c.bid, c.G); }

constexpr int RS = 64 * 72;
__device__ __forceinline__ bool rwkv_s1_task(const int tid, int& q, int& rb) {
    if (tid < 192) { const int g = tid % 24; rb = tid / 24; q = g < 8 ? 24 + g : 32 + g; return true; }
    if (tid < 448) { const int t2 = tid - 192, g = t2 & 31; rb = t2 >> 5; q = g < 24 ? g : 8 + g; return true; }
    q = 0; rb = 0; return false;
}
__device__ __forceinline__ int rwkv_col_of(const int q, const int h) { return q < 8 ? h * 64 + 8 * q : q < 16 ? 512 + h * 64 + 8 * (q - 8) : q < 24 ? 1024 + h * 64 + 8 * (q - 16) : 1536 + 8 * (q - 24); }
__device__ __forceinline__ void rwkv_load_rows(const Ctx& c, const int u, u32x4 (&xv)[9], f32x4 (&mv)[2]) {
    const int b = u / (8 * NCH), h = (u / NCH) % 8, ch = u % NCH, t0 = ch * 64;
    int q, rb;
    if (rwkv_s1_task(c.tid, q, rb)) { const int col = rwkv_col_of(q, h);
        mv[0] = *(const f32x4*)(c.p->in[I_EMU] + col); mv[1] = *(const f32x4*)(c.p->in[I_EMU] + col + 4);
#pragma unroll
        for (int j = 0; j < 9; ++j) { const int t = t0 + 8 * rb - 1 + j; const bool ok = t >= 0 && t < TT;
            const u32x4 x = *(const u32x4*)(c.P() + ((size_t)b * TP + (ok ? t : 0)) * EVEN_IN + col);
            xv[j] = ok ? x : (u32x4){0u, 0u, 0u, 0u}; } }
}
__device__ __forceinline__ void rwkv_prep_unit(const Ctx& c, const int u, u32x4 (&xv)[9], f32x4 (&mv)[2], const int unext) {
    const Params& p = *c.p; const int tid = c.tid, lane = c.lane, w = c.wave;
    const int b = u / (8 * NCH), h = (u / NCH) % 8, ch = u % NCH, t0 = ch * 64;
    lbf* S = (lbf*)(c.lds + LDS_PH);
    lbf *sKK = S, *sBB = S + RS, *sKM = S + 2 * RS, *sV = S + 3 * RS, *sR = S + 4 * RS, *sBh = S + 5 * RS, *sKh = S + 6 * RS, *sVc = S + 7 * RS, *sYA = S + 8 * RS,
        *sP1r = S + 10 * RS, *sP1c = S + 11 * RS, *sMak = S + 12 * RS, *sMrb = S + 13 * RS, *sMrk = S + 14 * RS;
    lfloat* CUM = (lfloat*)(S + 15 * RS);
    lfloat* BON = CUM + 4096;
    lfloat* SEG = BON + 64;
    lfloat* CST = SEG + 512;
    lfloat* A32 = (lfloat*)sP1r;
    lbf* sGD = sYA;
    const int mi = w >> 1, nb2 = 2 * (w & 1);
    const int fr = lane & 15, fq = lane >> 4;
    bf16x8 fDU[2][2], fIU[2][2], fGU[2][4];
#pragma unroll
    for (int n2 = 0; n2 < 2; ++n2) {
#pragma unroll
        for (int k = 0; k < 2; ++k) { fDU[n2][k] = gfrag(c.DUt(), 64, h * 64 + 16 * (nb2 + n2), 32 * k, lane); fIU[n2][k] = gfrag(c.IUt(), 64, h * 64 + 16 * (nb2 + n2), 32 * k, lane); } }
    { int q, rb;
      if (rwkv_s1_task(tid, q, rb)) {
        int col, ld = 72; lbf* dst;
        if (q < 8) { col = h * 64 + 8 * q; dst = sR + 8 * q; }
        else if (q < 16) { col = 512 + h * 64 + 8 * (q - 8); dst = sKM + 8 * (q - 8); }
        else if (q < 24) { col = 1024 + h * 64 + 8 * (q - 16); dst = sV + 8 * (q - 16); }
        else if (q < 32) { col = 1536 + 8 * (q - 24); dst = sBh + 8 * (q - 24); }
        else if (q < 40) { col = 1600 + 8 * (q - 32); dst = sKh + 8 * (q - 32); }
        else { col = 1664 + 8 * (q - 40); dst = sGD + 8 * (q - 40); ld = 136; }
        const bool trans = tid < 192;
        const bool is_tanh = q < 32;
        float m8[8];
        { const f32x4 m0 = mv[0], m1 = mv[1]; m8[0] = m0[0]; m8[1] = m0[1]; m8[2] = m0[2]; m8[3] = m0[3]; m8[4] = m1[0]; m8[5] = m1[1]; m8[6] = m1[2]; m8[7] = m1[3]; }
        const float sc = is_tanh ? -2.0f : -1.0f;
        float pv[8]; unpack8(xv[0], pv);
#pragma unroll
        for (int j = 0; j < 8; ++j) { float x[8]; unpack8(xv[j + 1], x); float o[8];
            const bool valid = (t0 + 8 * rb + j) < TT;
#pragma unroll
            for (int k = 0; k < 8; ++k) { float y = x[k] + m8[k] * (pv[k] - x[k]); pv[k] = x[k];
                if (trans) { const float sg = __builtin_amdgcn_rcpf(1.0f + __expf(sc * y)); y = is_tanh ? 2.0f * sg - 1.0f : sg; }
                o[k] = valid ? y : 0.f; }
            *(LAS u32x4*)(dst + (8 * rb + j) * ld) = pack8(o); } }
      else { const int hl = h * 64 + lane;
        CST[lane] = p.in[I_EKK][hl]; CST[64 + lane] = p.in[I_EKA][hl]; CST[128 + lane] = p.in[I_ERK][hl]; CST[192 + lane] = p.in[I_EDECAY0][hl]; CST[256 + lane] = p.in[I_EICLR0][hl];
        CST[320 + lane] = p.in[I_ELNG][hl]; CST[384 + lane] = p.in[I_ELNB][hl]; } }
    rwkv_load_rows(c, unext < NRU ? unext : NRU - 1, xv, mv);
    lds_barrier();
#pragma unroll
    for (int n2 = 0; n2 < 2; ++n2) { const int ni = nb2 + n2;
        f32x4 aw = (f32x4){0.f, 0.f, 0.f, 0.f}, aa = aw;
#pragma unroll
        for (int k0 = 0; k0 < 64; k0 += 32) { const bf16x8 fw = ldfrag(sBh, 72, 16 * mi, k0, lane), fa = ldfrag(sKh, 72, 16 * mi, k0, lane);
            aw = MFMA16(fDU[n2][k0 >> 5], fw, aw); aa = MFMA16(fIU[n2][k0 >> 5], fa, aa); }
        const int i = 16 * mi + fr, j = 16 * ni + 4 * fq, hj = h * 64 + j;
        const f32x4 d0 = *(const LAS f32x4*)(CST + 192 + j), i0 = *(const LAS f32x4*)(CST + 256 + j);
        f32x4 lw, av;
#pragma unroll
        for (int r = 0; r < 4; ++r) { lw[r] = -0.6065306597126334f * fast_sigmoid(d0[r] + aw[r]);
            av[r] = fast_sigmoid(i0[r] + aa[r]); }
        *(LAS f32x4*)(CUM + i * 64 + j) = lw; *(LAS f32x4*)(A32 + i * 64 + j) = av; }
#pragma unroll
    for (int n2 = 0; n2 < 2; ++n2) {
#pragma unroll
        for (int k = 0; k < 4; ++k) fGU[n2][k] = gfrag(c.GUt(), 128, h * 64 + 16 * (nb2 + n2), 32 * k, lane); }
    lds_barrier();
    { const int i = tid >> 3, j8 = (tid & 7) * 8, hj = h * 64 + j8;
        float k[8], r[8], kx[8], ss = 0.f, bon = 0.f;
        unpack8(*(const LAS u32x4*)(sKM + i * 72 + j8), k); unpack8(*(const LAS u32x4*)(sR + i * 72 + j8), r);
#pragma unroll
        for (int q = 0; q < 8; ++q) { kx[q] = k[q] * CST[j8 + q]; ss += kx[q] * kx[q]; }
        ss = sum8(ss);
        const float inv = 1.0f / fmaxf(sqrtf(ss), 1e-12f);
        float kk[8], km[8], bb[8];
#pragma unroll
        for (int q = 0; q < 8; ++q) { const float a = A32[i * 64 + j8 + q]; kk[q] = kx[q] * inv; km[q] = k[q] * (1.0f + (a - 1.0f) * CST[64 + j8 + q]); bb[q] = kk[q] * a;
            bon += r[q] * km[q] * CST[128 + j8 + q]; }
        bon = sum8(bon);
        *(LAS u32x4*)(sKK + i * 72 + j8) = pack8(kk); *(LAS u32x4*)(sKM + i * 72 + j8) = pack8(km); *(LAS u32x4*)(sBB + i * 72 + j8) = pack8(bb);
        if ((tid & 7) == 0) BON[i] = bon; }
    { const int k = tid & 63, sg = tid >> 6; float run = 0.f;
#pragma unroll
        for (int q = 0; q < 8; ++q) { run += CUM[(8 * sg + q) * 64 + k]; CUM[(8 * sg + q) * 64 + k] = run; }
        SEG[sg * 64 + k] = run; }
    lds_barrier();
#pragma unroll
    for (int n2 = 0; n2 < 2; ++n2) { const int ni = nb2 + n2;
        f32x4 ag = (f32x4){0.f, 0.f, 0.f, 0.f};
#pragma unroll
        for (int k0 = 0; k0 < 128; k0 += 32) ag = MFMA16(fGU[n2][k0 >> 5], ldfrag(sGD, 136, 16 * mi, k0, lane), ag);
        const int i = 16 * mi + fr, j = 16 * ni + 4 * fq, hj = h * 64 + j;
        const f32x4 lg = *(const LAS f32x4*)(CST + 320 + j), lb = *(const LAS f32x4*)(CST + 384 + j), v = up4(*(const LAS u32x2*)(sV + i * 72 + j));
        const float bon = BON[i]; f32x4 e1, e2;
#pragma unroll
        for (int r = 0; r < 4; ++r) { e1[r] = ag[r] * lg[r]; e2[r] = (lb[r] + bon * v[r]) * ag[r]; }
        if (!c.dry) *(u32x2*)(c.Y() + ((size_t)b * TP + t0 + i) * 1024 + hj) = pk4(e1);
        if (!c.dry) *(u32x2*)(c.rwE2() + (size_t)u * 4096 + i * 64 + j) = pk4(e2); }
    { const int k = tid & 63, sg = tid >> 6; float pre = 0.f;
        for (int s2 = 0; s2 < sg; ++s2) pre += SEG[s2 * 64 + k];
#pragma unroll
        for (int q = 0; q < 8; ++q) CUM[(8 * sg + q) * 64 + k] += pre; }
    lds_barrier();
    { const int i = tid >> 3, j8 = (tid & 7) * 8;
        float kk[8], bb[8], km[8], r[8];
        unpack8(*(const LAS u32x4*)(sKK + i * 72 + j8), kk); unpack8(*(const LAS u32x4*)(sBB + i * 72 + j8), bb);
        unpack8(*(const LAS u32x4*)(sKM + i * 72 + j8), km); unpack8(*(const LAS u32x4*)(sR + i * 72 + j8), r);
#pragma unroll
        for (int q = 0; q < 8; ++q) { const float cu = CUM[i * 64 + j8 + q], cp = i > 0 ? CUM[(i - 1) * 64 + j8 + q] : 0.f;
            const float en = __expf(-cu); kk[q] = -kk[q] * __expf(cp); bb[q] *= en; km[q] *= en; r[q] *= __expf(cu); }
        *(LAS u32x4*)(sKK + i * 72 + j8) = pack8(kk); *(LAS u32x4*)(sBB + i * 72 + j8) = pack8(bb);
        *(LAS u32x4*)(sKM + i * 72 + j8) = pack8(km); *(LAS u32x4*)(sR + i * 72 + j8) = pack8(r); }
    lds_barrier();
    { const int k = tid & 63, i8 = (tid >> 6) * 8;
        const float gl = __expf(CUM[63 * 64 + k]);
        float a[8], bh[8], kh[8], v[8];
#pragma unroll
        for (int q = 0; q < 8; ++q) { a[q] = bf2f(sKK[(i8 + q) * 72 + k]); bh[q] = bf2f(sBB[(i8 + q) * 72 + k]) * gl; kh[q] = bf2f(sKM[(i8 + q) * 72 + k]) * gl; v[q] = bf2f(sV[(i8 + q) * 72 + k]); }
        *(LAS u32x4*)(sYA + k * 72 + i8) = pack8(a); *(LAS u32x4*)(sBh + k * 72 + i8) = pack8(bh); *(LAS u32x4*)(sKh + k * 72 + i8) = pack8(kh); *(LAS u32x4*)(sVc + k * 72 + i8) = pack8(v);
        if (i8 == 0) if (!c.dry) c.rwGL()[(size_t)u * 64 + k] = gl; }
    lds_barrier();
    const f32x4 zero4 = (f32x4){0.f, 0.f, 0.f, 0.f};
    for (int tl = w; tl < 16; tl += 8) { const int tm = tl >> 2, tn = tl & 3;
        f32x4 mab = zero4, mabc = zero4, mak = zero4, mrb = zero4, mrk = zero4;
        if (tn <= tm) {
#pragma unroll
            for (int k0 = 0; k0 < 64; k0 += 32) { const bf16x8 fa = ldfrag(sKK, 72, 16 * tm, k0, lane), frr = ldfrag(sR, 72, 16 * tm, k0, lane), fb = ldfrag(sBB, 72, 16 * tn, k0, lane), fk = ldfrag(sKM, 72, 16 * tn, k0, lane);
                mab = MFMA16(fb, fa, mab); mak = MFMA16(fk, fa, mak); mrb = MFMA16(fb, frr, mrb); mrk = MFMA16(fk, frr, mrk);
                mabc = MFMA16(fa, fb, mabc); }
            if (tn == tm) {
#pragma unroll
                for (int r = 0; r < 4; ++r) { const int t = fr, s2 = 4 * fq + r; const bool st = s2 < t, le = s2 <= t;
                    mab[r] = st ? mab[r] : 0.f; mak[r] = st ? mak[r] : 0.f; mrb[r] = le ? mrb[r] : 0.f; mrk[r] = le ? mrk[r] : 0.f;
                    mabc[r] = (fr < 4 * fq + r) ? mabc[r] : 0.f; } } }
        st4(sP1r, 72, 16 * tn, 16 * tm, mab, lane); st4(sMak, 72, 16 * tn, 16 * tm, mak, lane); st4(sMrb, 72, 16 * tn, 16 * tm, mrb, lane); st4(sMrk, 72, 16 * tn, 16 * tm, mrk, lane);
        st4(sP1c, 72, 16 * tm, 16 * tn, mabc, lane); }
    lds_barrier();
    const bool two = mi >= 2;
    { const bf16x8 m0 = ldfrag(sMak, 72, 16 * mi, 0, lane), m1 = ldfrag(sMak, 72, 16 * mi, 32, lane);
#pragma unroll
        for (int n2 = 0; n2 < 2; ++n2) { const int ni = nb2 + n2; f32x4 acc = MFMA16(m0, ldfrag(sVc, 72, 16 * ni, 0, lane), zero4);
            if (two) acc = MFMA16(m1, ldfrag(sVc, 72, 16 * ni, 32, lane), acc);
            st4(sYA + 64 * 72, 72, 16 * mi, 16 * ni, acc, lane); } }
    lds_barrier();
    lbf *Yc = sYA, *Yn = sKM  , *Pr = sP1r, *Pc = sP1c, *P2r = sKK  , *P2c = sBB  ;
    for (int it = 0; it < 6; ++it) {
        const bf16x8 pr0 = ldfrag(Pr, 72, 16 * mi, 0, lane), pr1 = ldfrag(Pr, 72, 16 * mi, 32, lane);
#pragma unroll
        for (int n4 = 0; n4 < 4; ++n4) { const int ni = 4 * (w & 1) + n4;
            f32x4 acc = up4(*(const LAS u32x2*)(Yc + (16 * ni + fr) * 72 + 16 * mi + 4 * fq));
            acc = MFMA16(pr0, ldfrag(Yc, 72, 16 * ni, 0, lane), acc);
            if (two) acc = MFMA16(pr1, ldfrag(Yc, 72, 16 * ni, 32, lane), acc);
            st4(Yn, 72, 16 * mi, 16 * ni, acc, lane); }
        if (it < 5) {
#pragma unroll
            for (int n2 = 0; n2 < 2; ++n2) { const int ni = nb2 + n2;
                if (ni <= mi) { const bf16x8 pc0 = ldfrag(Pc, 72, 16 * ni, 0, lane);
                    f32x4 a1 = MFMA16(pr0, pc0, zero4), a2 = MFMA16(pc0, pr0, zero4);
                    if (two) { const bf16x8 pc1 = ldfrag(Pc, 72, 16 * ni, 32, lane); a1 = MFMA16(pr1, pc1, a1); a2 = MFMA16(pc1, pr1, a2); }
                    st4(P2c, 72, 16 * mi, 16 * ni, a1, lane);
                    st4(P2r, 72, 16 * ni, 16 * mi, a2, lane); }
                else if (it == 0) { st4(P2c, 72, 16 * mi, 16 * ni, zero4, lane); st4(P2r, 72, 16 * ni, 16 * mi, zero4, lane); } }
        }
        lds_barrier();
        { lbf* t1 = Yc; Yc = Yn; Yn = t1; t1 = Pr; Pr = P2r; P2r = t1; t1 = Pc; Pc = P2c; P2c = t1; }
    }
    const lbf* Wc = Yc; const lbf* Uc = Yc + 64 * 72;
    { const bf16x8 fmrb0 = ldfrag(sMrb, 72, 16 * mi, 0, lane), fmrb1 = ldfrag(sMrb, 72, 16 * mi, 32, lane), fmrk0 = ldfrag(sMrk, 72, 16 * mi, 0, lane), fmrk1 = ldfrag(sMrk, 72, 16 * mi, 32, lane);
        const bf16x8 fbh0 = ldfrag(sBh, 72, 16 * mi, 0, lane), fbh1 = ldfrag(sBh, 72, 16 * mi, 32, lane), fkh0 = ldfrag(sKh, 72, 16 * mi, 0, lane), fkh1 = ldfrag(sKh, 72, 16 * mi, 32, lane);
#pragma unroll
        for (int n2 = 0; n2 < 2; ++n2) { const int ni = nb2 + n2;
            const bf16x8 fw0 = ldfrag(Wc, 72, 16 * ni, 0, lane), fw1 = ldfrag(Wc, 72, 16 * ni, 32, lane), fu0 = ldfrag(Uc, 72, 16 * ni, 0, lane), fu1 = ldfrag(Uc, 72, 16 * ni, 32, lane);
            const bf16x8 fv0 = ldfrag(sVc, 72, 16 * ni, 0, lane), fv1 = ldfrag(sVc, 72, 16 * ni, 32, lane);
            f32x4 aq = up4(*(const LAS u32x2*)(sR + (16 * mi + fr) * 72 + 16 * ni + 4 * fq));
            aq = MFMA16(fw0, fmrb0, aq);
            f32x4 ao = MFMA16(fu0, fmrb0, zero4); ao = MFMA16(fv0, fmrk0, ao);
            if (two) { aq = MFMA16(fw1, fmrb1, aq); ao = MFMA16(fu1, fmrb1, ao); ao = MFMA16(fv1, fmrk1, ao); }
            f32x4 ag = MFMA16(fw0, fbh0, zero4); ag = MFMA16(fw1, fbh1, ag);
            f32x4 ah = MFMA16(fbh0, fu0, zero4); ah = MFMA16(fbh1, fu1, ah); ah = MFMA16(fkh0, fv0, ah); ah = MFMA16(fkh1, fv1, ah);
            const size_t ub = (size_t)u * 4096;
            if (!c.dry) { *(u32x2*)(c.rwQE() + ub + (16 * mi + fr) * 64 + 16 * ni + 4 * fq) = pk4(aq);
                *(u32x2*)(c.rwOO() + ub + (16 * mi + fr) * 64 + 16 * ni + 4 * fq) = pk4(ao);
                *(u32x2*)(c.rwGP() + ub + (16 * mi + fr) * 64 + 16 * ni + 4 * fq) = pk4(ag);
                *(u32x2*)(c.rwHC() + ub + (16 * ni + fr) * 64 + 16 * mi + 4 * fq) = pk4(ah); } } }
    lds_barrier();
}

struct RwStage { u32x4 gp, qe, hc, oo, gl; };
__device__ __forceinline__ void rw_stage_load(const Ctx& c, RwStage& S, const size_t ug) {
    const int tid = c.tid; const size_t ub = ug * 8192; const unsigned lo = (unsigned)tid * 16u;
    S.gp = *(const u32x4*)((const char*)c.rwGP() + ub + lo); S.qe = *(const u32x4*)((const char*)c.rwQE() + ub + lo); S.hc = *(const u32x4*)((const char*)c.rwHC() + ub + lo); S.oo = *(const u32x4*)((const char*)c.rwOO() + ub + lo);
    S.gl = *(const u32x4*)((const char*)c.rwGL() + ug * 256 + (lo & 255u));
}
constexpr int RSG_GP = 0, RSG_QE = RS, RSG_HC = 2 * RS, RSG_OO = 3 * RS, RSG_GL = 4 * RS, RSG_SIZE = 4 * RS + 128;
__device__ __forceinline__ void rw_stage_put(lbf* B, const RwStage& S, const int tid) {
    const int o = (tid >> 3) * 72 + (tid & 7) * 8;
    *(LAS u32x4*)(B + RSG_GP + o) = S.gp; *(LAS u32x4*)(B + RSG_QE + o) = S.qe; *(LAS u32x4*)(B + RSG_HC + o) = S.hc; *(LAS u32x4*)(B + RSG_OO + o) = S.oo;
    if (tid < 16) *(LAS u32x4*)(B + RSG_GL + tid * 8) = S.gl;
}
__device__ __forceinline__ void rwkv_seq_unit3(const Ctx& c, const int bh) {
    const int tid = c.tid, lane = c.lane, w = c.wave, fr = lane & 15, fq = lane >> 4, mi = w >> 1, nb2 = 2 * (w & 1);
    lbf* SB = (lbf*)(c.lds + LDS_PH);
    lbf* Zb = SB + 2 * RSG_SIZE;
    f32x4 z[2] = {(f32x4){0.f, 0.f, 0.f, 0.f}, (f32x4){0.f, 0.f, 0.f, 0.f}};
    const size_t u0 = (size_t)bh * NCH;
    RwStage R0, R1;
    rw_stage_load(c, R0, u0); rw_stage_load(c, R1, u0 + 1);
#define RW_STEP(RS_, ch_, s3_) do { const int ch = (ch_); \
        lbf* B = SB + (s3_) * RSG_SIZE; lbf* Zc = Zb + (s3_) * RS; \
        rw_stage_put(B, RS_, tid); \
        _Pragma("unroll") for (int n2 = 0; n2 < 2; ++n2) st4(Zc, 72, 16 * mi, 16 * (nb2 + n2), z[n2], lane); \
        if (ch + 2 < NCH) rw_stage_load(c, RS_, u0 + ch + 2); \
        lds_barrier(); \
        const size_t ub = (u0 + ch) * 4096; \
        const f32x4 gl = *(const LAS f32x4*)((const LAS float*)(B + RSG_GL) + 16 * mi + 4 * fq); \
        const bf16x8 g0 = ldfrag(B + RSG_GP, 72, 16 * mi, 0, lane), g1 = ldfrag(B + RSG_GP, 72, 16 * mi, 32, lane), q0 = ldfrag(B + RSG_QE, 72, 16 * mi, 0, lane), q1 = ldfrag(B + RSG_QE, 72, 16 * mi, 32, lane); \
        _Pragma("unroll") for (int n2 = 0; n2 < 2; ++n2) { const int ni = nb2 + n2; \
            f32x4 a = z[n2] * gl + up4(*(const LAS u32x2*)(B + RSG_HC + (16 * ni + fr) * 72 + 16 * mi + 4 * fq)); \
            f32x4 o = up4(*(const LAS u32x2*)(B + RSG_OO + (16 * mi + fr) * 72 + 16 * ni + 4 * fq)); \
            const bf16x8 fz0 = ldfrag(Zc, 72, 16 * ni, 0, lane), fz1 = ldfrag(Zc, 72, 16 * ni, 32, lane); \
            a = MFMA16(g0, fz0, a); a = MFMA16(g1, fz1, a); o = MFMA16(fz0, q0, o); o = MFMA16(fz1, q1, o); \
            z[n2] = a; \
            int l2 = lane; asm volatile("" : "+v"(l2)); \
            if (!c.dry) *(u32x2*)(c.rwOO() + ub + (16 * mi + (l2 & 15)) * 64 + 16 * ni + 4 * (l2 >> 4)) = pk4(o); } \
    } while (0)
#pragma unroll 1
    for (int ch0 = 0; ch0 + 1 < NCH; ch0 += 2) { RW_STEP(R0, ch0, 0); RW_STEP(R1, ch0 + 1, 1); }
    RW_STEP(R0, NCH - 1, 0);
#undef RW_STEP
    lds_barrier();
}
__device__ __forceinline__ void ph_rwkv_prep(const Ctx& c) {
    if (c.bid >= NRU) return;
    u32x4 xv[9]; f32x4 mv[2];
    rwkv_load_rows(c, c.bid, xv, mv);
    for (int u = c.bid; u < NRU; u += c.G) rwkv_prep_unit(c, u, xv, mv, u + c.G);
}
__device__ __forceinline__ void ph_rwkv_seq(const Ctx& c) {
    if (c.G >= 128) {
        if (c.bid < 64) rwkv_seq_unit3(c, c.bid);
        else { const int vb = c.bid - 64, nvb = c.G - 64;
            lru_final_run(c, vb, nvb);
            filler_A(c, vb, nvb); }
    } else {
        for (int u = c.bid; u < 64; u += c.G) rwkv_seq_unit3(c, u);
        lru_final_run(c, c.bid, c.G);
        filler_A(c, c.bid, c.G);
    }
}
__device__ __forceinline__ void ph_rwkv_post(const Ctx& c) {
    for (int u = c.bid; u < NRU; u += c.G) {
        const int b = u / (8 * NCH), h = (u / NCH) % 8, ch = u % NCH;
        const int i = c.tid >> 3, j8 = (c.tid & 7) * 8;
        float o[8], e1[8], e2[8];
        bf16_t* yp = c.Y() + ((size_t)b * TP + ch * 64 + i) * 1024 + h * 64 + j8;
        unpack8(*(const u32x4*)(c.rwOO() + (size_t)u * 4096 + i * 64 + j8), o); unpack8(*(const u32x4*)yp, e1); unpack8(*(const u32x4*)(c.rwE2() + (size_t)u * 4096 + i * 64 + j8), e2);
        float s1 = 0.f;
#pragma unroll
        for (int q = 0; q < 8; ++q) s1 += o[q];
        s1 = sum8(s1); const float mean = s1 * (1.0f / 64.0f);
        float s2 = 0.f;
#pragma unroll
        for (int q = 0; q < 8; ++q) { const float d = o[q] - mean; s2 += d * d; }
        s2 = sum8(s2); const float rstd = rsqrtf(s2 * (1.0f / 64.0f) + 64e-5f);
        float y[8];
#pragma unroll
        for (int q = 0; q < 8; ++q) y[q] = (o[q] - mean) * rstd * e1[q] + e2[q];
        if (!c.dry) *(u32x4*)yp = pack8(y);
    }
}

constexpr int SELCAP = 1088;
__device__ __forceinline__ void ph_router4(const Ctx& c, const int l) {
    const Params& p = *c.p; const int tid = c.tid, lane = c.lane, w = c.wave, fr = lane & 15, fq = lane >> 4;
    lfloat* PART = (lfloat*)(c.lds + LDS_PH);
    lfloat* SSQ = PART + 8 * 32 * 48;
    lfloat* SROW = SSQ + 256;
    lfloat* LG = SROW + 32;
    lint* sel_e = (lint*)(LG + 32 * 48);
    lfloat* sel_w = (lfloat*)(sel_e + 2 * SELCAP);
    lint* sel_row = (lint*)(sel_w + 2 * SELCAP);
    lint* sel_pos = sel_row + SELCAP;
    lfloat* sel_s = (lfloat*)(sel_pos + 2 * SELCAP);
    lint* lcnt = (lint*)(sel_s + SELCAP);
    lint* gbase = lcnt + 32;
    if (tid < 32) lcnt[tid] = 0;
    const bf16_t* WH = c.WrH() + (size_t)l * 48 * 1024; const bf16_t* WL = c.WrL() + (size_t)l * 48 * 1024;
    const float* bg = p.in[I_MBGROUP] + l * 4; const float* br = p.in[I_MBROUTER] + l * 32;
    bf16x8 bh[3][4], bl[3][4];
#pragma unroll
    for (int ni = 0; ni < 3; ++ni)
#pragma unroll
        for (int ks = 0; ks < 4; ++ks) { bh[ni][ks] = gfrag(WH, 1024, 16 * ni, 128 * w + 32 * ks, lane); bl[ni][ks] = gfrag(WL, 1024, 16 * ni, 128 * w + 32 * ks, lane); }
    const int cb = 128 * w + 8 * fq;
    int nloc = 0;
    u32x4 hN[2][4];
    for (int it = 0;; ++it) {
        const int idx0 = (it * c.G + c.bid) * 32; if (idx0 >= NTOK) break;
        nloc = it * 32 + 32;
#define RT_LOAD(dst_, idx0_) do { _Pragma("unroll") for (int mi_ = 0; mi_ < 2; ++mi_) { const int idx = (idx0_) + 16 * mi_ + fr, idc = idx < NTOK ? idx : NTOK - 1; const int b = idc / TT, t = idc % TT; \
            const bf16_t* hrow = c.H() + (size_t)(b * TP + t) * 1024 + cb; \
            _Pragma("unroll") for (int ks = 0; ks < 4; ++ks) dst_[mi_][ks] = *(const u32x4*)(hrow + 32 * ks); } } while (0)
        u32x4 hC[2][4];
        if (it == 0) RT_LOAD(hN, idx0);
#pragma unroll
        for (int mi = 0; mi < 2; ++mi)
#pragma unroll
            for (int ks = 0; ks < 4; ++ks) hC[mi][ks] = hN[mi][ks];
        RT_LOAD(hN, idx0 + c.G * 32);
#pragma unroll
        for (int mi = 0; mi < 2; ++mi) { float ss = 0.f;
#pragma unroll
            for (int ks = 0; ks < 4; ++ks) { float hb[8]; unpack8(hC[mi][ks], hb);
                ss += hb[0] * hb[0] + hb[1] * hb[1] + hb[2] * hb[2] + hb[3] * hb[3] + hb[4] * hb[4] + hb[5] * hb[5] + hb[6] * hb[6] + hb[7] * hb[7]; }
            ss += __shfl_xor(ss, 16); ss += __shfl_xor(ss, 32);
            if (fq == 0) SSQ[w * 32 + 16 * mi + fr] = ss;
#pragma unroll
            for (int ni = 0; ni < 3; ++ni) { f32x4 acc = (f32x4){0.f, 0.f, 0.f, 0.f};
#pragma unroll
                for (int ks = 0; ks < 4; ++ks) { const bf16x8 ah = __builtin_bit_cast(bf16x8, hC[mi][ks]); acc = MFMA16(ah, bh[ni][ks], acc); acc = MFMA16(ah, bl[ni][ks], acc); }
#pragma unroll
                for (int r = 0; r < 4; ++r) PART[(w * 32 + 16 * mi + 4 * fq + r) * 48 + 16 * ni + fr] = acc[r]; } }
        __syncthreads();
        { const int t = tid >> 4, e3 = tid & 15;
            float ssum = 0.f;
#pragma unroll
            for (int k = 0; k < 8; ++k) ssum += SSQ[k * 32 + t];
            const float s = rsqrtf(ssum * (1.0f / 1024.0f) + 1e-6f);
            if (e3 == 0) SROW[t] = s;
#pragma unroll
            for (int j = 0; j < 3; ++j) { const int e = e3 + 16 * j; float a = 0.f;
#pragma unroll
                for (int k = 0; k < 8; ++k) a += PART[(k * 32 + t) * 48 + e];
                LG[t * 48 + e] = a * s; } }
        __syncthreads();
        if (tid < 32) { const int idx = idx0 + tid, slot = it * 32 + tid;
            if (idx < NTOK) { const lfloat* lg = LG + tid * 48;
                const float g0 = lg[0] + bg[0], g1 = lg[1] + bg[1], g2 = lg[2] + bg[2], g3 = lg[3] + bg[3];
                int gi = 0; float gm = g0; if (g1 > gm) { gm = g1; gi = 1; } if (g2 > gm) { gm = g2; gi = 2; } if (g3 > gm) { gm = g3; gi = 3; }
                const float gprob = 1.0f / (__expf(g0 - gm) + __expf(g1 - gm) + __expf(g2 - gm) + __expf(g3 - gm));
                float el[8];
#pragma unroll
                for (int j = 0; j < 8; ++j) el[j] = lg[4 + gi * 8 + j] + br[gi * 8 + j];
                int i1 = 0; float v1 = el[0];
#pragma unroll
                for (int j = 1; j < 8; ++j) if (el[j] > v1) { v1 = el[j]; i1 = j; }
                int i2 = -1; float v2 = -3.0e38f;
#pragma unroll
                for (int j = 0; j < 8; ++j) if (j != i1 && el[j] > v2) { v2 = el[j]; i2 = j; }
                if (i2 < 0) { i2 = (i1 + 1) & 7; v2 = v1; }
                const float e2 = __expf(v2 - v1), w1 = gprob / (1.0f + e2), w2 = gprob * e2 / (1.0f + e2);
                const int b = idx / TT, t = idx % TT;
                sel_e[slot] = gi * 8 + i1; sel_e[SELCAP + slot] = gi * 8 + i2; sel_w[slot] = w1; sel_w[SELCAP + slot] = w2; sel_row[slot] = b * TP + t; sel_s[slot] = SROW[tid];
            } else sel_row[slot] = -1; }
        __syncthreads();
    }
    __syncthreads();
    for (int sx = tid; sx < nloc; sx += NTHREADS) if (sel_row[sx] >= 0) { sel_pos[sx] = __hip_atomic_fetch_add(&lcnt[sel_e[sx]], 1, __ATOMIC_RELAXED, __HIP_MEMORY_SCOPE_WORKGROUP); sel_pos[SELCAP + sx] = __hip_atomic_fetch_add(&lcnt[sel_e[SELCAP + sx]], 1, __ATOMIC_RELAXED, __HIP_MEMORY_SCOPE_WORKGROUP); }
    __syncthreads();
    if (tid < 32) gbase[tid] = (lcnt[tid] > 0 && !c.dry) ? atomicAdd(&c.mcnt()[l * 32 + tid], lcnt[tid]) : 0;
    __syncthreads();
    for (int sx = tid; sx < nloc; sx += NTHREADS) if (sel_row[sx] >= 0 && !c.dry) {
#pragma unroll
        for (int sl = 0; sl < 2; ++sl) { const int e = sel_e[sl * SELCAP + sx]; const size_t pos = (size_t)e * MCAP + gbase[e] + sel_pos[sl * SELCAP + sx];
            c.mlist()[pos] = sel_row[sx] * 2 + sl; c.mlw()[pos] = sel_w[sl * SELCAP + sx]; c.mls()[pos] = sel_s[sx]; } }
    __syncthreads();
}

__device__ __forceinline__ void ph_combine_norm(const Ctx& c, const float* gain, const int mode) {
    for (int row = c.bid * 8 + c.wave; row < NP; row += c.G * 8) {
        const int b = row / TP, t = row % TP;
        if (t >= TT) { if (mode == 0) { bf16_t* zrow = c.H() + (size_t)row * 1024;
#pragma unroll
                for (int i = 0; i < 4; ++i) if (!c.dry) *(u32x2*)(zrow + 4 * c.lane + 256 * i) = (u32x2){0u, 0u};
                if (c.lane == 0 && !c.dry) c.srow()[row] = 0.f; }
            continue; }
        if (mode == 1 && t < NMETA) continue;
        bf16_t* hrow = c.H() + (size_t)row * 1024; const bf16_t* y0 = c.YM() + (size_t)row * 2048; const bf16_t* y1 = y0 + 1024;
        f32x4 v[4]; float ss = 0.f;
#pragma unroll
        for (int i = 0; i < 4; ++i) { v[i] = up4(*(const u32x2*)(hrow + 4 * c.lane + 256 * i));
            const u32x2 a = *(const u32x2*)(y0 + 4 * c.lane + 256 * i), d = *(const u32x2*)(y1 + 4 * c.lane + 256 * i);
            v[i][0] += bf2f(a.x & 0xffffu) + bf2f(d.x & 0xffffu); v[i][1] += bf2f(a.x >> 16) + bf2f(d.x >> 16);
            v[i][2] += bf2f(a.y & 0xffffu) + bf2f(d.y & 0xffffu); v[i][3] += bf2f(a.y >> 16) + bf2f(d.y >> 16);
            ss += v[i][0] * v[i][0] + v[i][1] * v[i][1] + v[i][2] * v[i][2] + v[i][3] * v[i][3]; }
        ss = wave_sum(ss);
        const float s = rsqrtf(ss * (1.0f / 1024.0f) + 1e-6f);
        float* orow = c.p->out + ((size_t)b * SEQ + (t - NMETA)) * 1024;
        if (mode == 0 && c.lane == 0 && !c.dry) c.srow()[row] = s;
#pragma unroll
        for (int i = 0; i < 4; ++i) {
            if (mode == 0) { if (!c.dry) *(u32x2*)(hrow + 4 * c.lane + 256 * i) = pk4(v[i]); }
            else { const f32x4 g = *(const f32x4*)(gain + 4 * c.lane + 256 * i); f32x4 o; o[0] = v[i][0] * s * g[0]; o[1] = v[i][1] * s * g[1]; o[2] = v[i][2] * s * g[2]; o[3] = v[i][3] * s * g[3]; if (!c.dry) *(f32x4*)(orow + 4 * c.lane + 256 * i) = o; } }
    }
}

__device__ __forceinline__ void moe_table(const Ctx& c, const int l) {
    lint* ts = (lint*)(c.lds + LDS_MISC);
    if (c.tid == 0) { int a = 0; for (int e = 0; e < 32; ++e) { ts[e] = a; a += (c.mcnt()[l * 32 + e] + 255) >> 8; } ts[32] = a; }
    __syncthreads();
}

__device__ __forceinline__ float logsigmoidf_(float x) { return fminf(x, 0.f) - log1pf(__expf(-fabsf(x))); }
__device__ __forceinline__ float fast_logsigmoid(float x) { return fminf(x, 0.f) - __logf(1.0f + __expf(-fabsf(x))); }
struct GlaPrepLoads { u32x4 q0, q1, k0, k1, vv[4], gd; };
__device__ __forceinline__ void gla_prep_load(const Ctx& c, const int u, GlaPrepLoads& L) {
    const int b = u / (4 * NCH), hd = (u / NCH) % 4, ch = u % NCH, tid = c.tid;
    const int i = tid >> 3, j16 = (tid & 7) * 16, d32 = (tid & 7) * 32;
    const bf16_t* rp = c.P() + ((size_t)b * TP + ch * 64 + i) * ODD_IN;
    L.q0 = *(const u32x4*)(rp + hd * 128 + j16); L.q1 = *(const u32x4*)(rp + hd * 128 + j16 + 8);
    L.k0 = *(const u32x4*)(rp + 512 + hd * 128 + j16); L.k1 = *(const u32x4*)(rp + 512 + hd * 128 + j16 + 8);
#pragma unroll
    for (int q = 0; q < 4; ++q) L.vv[q] = *(const u32x4*)(rp + 1024 + hd * 256 + d32 + 8 * q);
    L.gd = *(const u32x4*)(rp + 2048 + 8 * (tid & 1));
}
__device__ __forceinline__ void gla_prep_unit(const Ctx& c, const int u, GlaPrepLoads& L, const int unext) {
    const Params& p = *c.p; const int tid = c.tid, lane = c.lane, w = c.wave, fr = lane & 15, fq = lane >> 4;
    const int b = u / (4 * NCH), hd = (u / NCH) % 4, ch = u % NCH;
    const size_t row0 = (size_t)b * TP + ch * 64;
    lbf* Qr = (lbf*)(c.lds + LDS_PH);
    lbf* Kr = Qr + 64 * 136;
    lbf* KHc = Kr + 64 * 136;
    lbf* Vc = KHc + 128 * 72;
    lbf* Sr = Vc + 256 * 72;
    lfloat* CUM = (lfloat*)(Sr + 64 * 72);
    lbf* Vr = (lbf*)CUM;
    lfloat* GD = CUM + 64 * 128;
    lbf* GDb = (lbf*)GD;
    lfloat* SEG = GD + 1024;
    const float* g_up = p.in[I_OGUP]; const float* g_b = p.in[I_OGB];
    const int i = tid >> 3, j16 = (tid & 7) * 16, d32 = (tid & 7) * 32;
    const u32x4 q0 = L.q0, q1 = L.q1, k0 = L.k0, k1 = L.k1;
    { lbf* GDb_ = (lbf*)GD;
        if ((tid & 7) < 2) *(LAS u32x4*)(GDb_ + i * 32 + 8 * (tid & 7)) = L.gd; else if ((tid & 7) < 4) *(LAS u32x4*)(GDb_ + i * 32 + 8 * (tid & 7)) = (u32x4){0u, 0u, 0u, 0u}; }
    lds_barrier();
    { const int ti = w >> 1;
#pragma unroll
        for (int n4 = 0; n4 < 4; ++n4) { const int ni = 4 * (w & 1) + n4;
            const f32x4 z4 = (f32x4){0.f, 0.f, 0.f, 0.f};
            const f32x4 acc = MFMA16(gfrag(c.GLUt(), 32, hd * 128 + 16 * ni, 0, lane), ldfrag(GDb, 32, 16 * ti, 0, lane), z4);
            const f32x4 gb4 = *(const f32x4*)(g_b + hd * 128 + 16 * ni + 4 * fq); f32x4 la;
#pragma unroll
            for (int r = 0; r < 4; ++r) la[r] = fast_logsigmoid(acc[r] + gb4[r]) * (1.0f / 16.0f);
            *(LAS f32x4*)(CUM + (16 * ti + fr) * 128 + 16 * ni + 4 * fq) = la; } }
    lds_barrier();
    { const int k = tid & 127, sg = tid >> 7; float run = 0.f;
#pragma unroll
        for (int q = 0; q < 16; ++q) { run += CUM[(16 * sg + q) * 128 + k]; CUM[(16 * sg + q) * 128 + k] = run; }
        SEG[sg * 128 + k] = run; }
    lds_barrier();
    { const int k = tid & 127, sg = tid >> 7; float pre = 0.f;
        for (int s2 = 0; s2 < sg; ++s2) pre += SEG[s2 * 128 + k];
        if (sg > 0) {
#pragma unroll
            for (int q = 0; q < 16; ++q) CUM[(16 * sg + q) * 128 + k] += pre; } }
    lds_barrier();
    { float q[16], k[16]; unpack8(q0, q); unpack8(q1, q + 8); unpack8(k0, k); unpack8(k1, k + 8);
#pragma unroll
        for (int e = 0; e < 16; ++e) { const float cu = CUM[i * 128 + j16 + e]; q[e] = q[e] * 0.08838834764831845f * __expf(cu); k[e] = k[e] * __expf(-cu); }
        const u32x4 qa = pack8(q), qb = pack8(q + 8);
        *(LAS u32x4*)(Qr + i * 136 + j16) = qa; *(LAS u32x4*)(Qr + i * 136 + j16 + 8) = qb;
        *(LAS u32x4*)(Kr + i * 136 + j16) = pack8(k); *(LAS u32x4*)(Kr + i * 136 + j16 + 8) = pack8(k + 8);
        bf16_t* wp = c.P() + (row0 + i) * ODD_IN + hd * 128 + j16;
        if (!c.dry) { *(u32x4*)wp = qa; *(u32x4*)(wp + 8) = qb; } }
    float gl = 0.f;
    if (tid < 128) { gl = __expf(CUM[63 * 128 + tid]); if (!c.dry) c.glaG()[(size_t)u * 128 + tid] = gl; }
    lds_barrier();
#pragma unroll
    for (int q = 0; q < 4; ++q) *(LAS u32x4*)(Vr + i * 256 + d32 + 8 * q) = L.vv[q];
    if (unext < BATCH * 4 * NCH) gla_prep_load(c, unext, L);
    if (tid < 128) SEG[tid] = gl;
    { const int ti = w >> 1;
#pragma unroll
        for (int n2 = 0; n2 < 2; ++n2) { const int si = 2 * (w & 1) + n2; f32x4 acc = (f32x4){0.f, 0.f, 0.f, 0.f};
            if (si <= ti) {
#pragma unroll
                for (int kk = 0; kk < 128; kk += 32) acc = MFMA16(ldfrag(Kr, 136, 16 * si, kk, lane), ldfrag(Qr, 136, 16 * ti, kk, lane), acc);
#pragma unroll
                for (int r = 0; r < 4; ++r) { const int t = 16 * ti + fr, s2 = 16 * si + 4 * fq + r; acc[r] = (s2 <= t) ? acc[r] : 0.f; } }
            st4(Sr, 72, 16 * si, 16 * ti, acc, lane); } }
    lds_barrier();
    { const int k = tid & 127, i16 = (tid >> 7) * 16; const float g = SEG[k]; float o[16];
#pragma unroll
        for (int q = 0; q < 16; ++q) o[q] = bf2f(Kr[(i16 + q) * 136 + k]) * g;
        const u32x4 oa = pack8(o), ob = pack8(o + 8);
        bf16_t* gp = c.gKH() + (size_t)u * 8192 + k * 64 + i16;
        if (!c.dry) { *(u32x4*)gp = oa; *(u32x4*)(gp + 8) = ob; } }
    { const int dv = tid & 255, i32 = (tid >> 8) * 32;
        bf16_t* gp = c.gVC() + (size_t)u * 16384 + dv * 64 + i32;
#pragma unroll
        for (int q4 = 0; q4 < 4; ++q4) { u32x4 wv; unsigned t8[8];
#pragma unroll
            for (int q = 0; q < 8; ++q) t8[q] = Vr[(i32 + 8 * q4 + q) * 256 + dv];
            wv.x = t8[0] | (t8[1] << 16); wv.y = t8[2] | (t8[3] << 16); wv.z = t8[4] | (t8[5] << 16); wv.w = t8[6] | (t8[7] << 16);
            *(LAS u32x4*)(Vc + dv * 72 + i32 + 8 * q4) = wv;
            if (!c.dry) *(u32x4*)(gp + 8 * q4) = wv; } }
    lds_barrier();
    { const int ti = w >> 1; const bf16x8 s0 = ldfrag(Sr, 72, 16 * ti, 0, lane), s1 = ldfrag(Sr, 72, 16 * ti, 32, lane);
#pragma unroll
        for (int d8 = 0; d8 < 8; ++d8) { const int di = 8 * (w & 1) + d8; f32x4 acc = (f32x4){0.f, 0.f, 0.f, 0.f};
            acc = MFMA16(ldfrag(Vc, 72, 16 * di, 0, lane), s0, acc); acc = MFMA16(ldfrag(Vc, 72, 16 * di, 32, lane), s1, acc);
            if (!c.dry) *(u32x2*)(c.HN() + (row0 + 16 * ti + fr) * 1024 + hd * 256 + 16 * di + 4 * fq) = pk4(acc); } }
    lds_barrier();
}
__device__ __forceinline__ void ph_gla_prep2(const Ctx& c) {
    if (c.bid >= BATCH * 4 * NCH) return;
    GlaPrepLoads L; gla_prep_load(c, c.bid, L);
    for (int u = c.bid; u < BATCH * 4 * NCH; u += c.G) gla_prep_unit(c, u, L, u + c.G);
}

struct GlaStage4 { u32x4 kh[2], vo, qt[2], gl; };
__device__ __forceinline__ void gla4_stage_load(const Ctx& c, GlaStage4& S, const int bh, const int dq, const int ch) {
    const int tid = c.tid, b = bh >> 2, hd = bh & 3; const size_t ug = (size_t)bh * NCH + ch, r0 = (size_t)b * TP + ch * 64;
    const bf16_t* kb = c.gKH() + ug * 8192;
    S.kh[0] = *(const u32x4*)(kb + tid * 8); S.kh[1] = *(const u32x4*)(kb + 4096 + tid * 8);
    const int t2 = tid & 255;
    const bf16_t* vp = c.gVC() + ug * 16384 + (size_t)(dq * 32) * 64 + t2 * 8;
    const bf16_t* op = c.HN() + (r0 + (t2 >> 2)) * 1024 + hd * 256 + dq * 32 + (t2 & 3) * 8;
    S.vo = *(const u32x4*)(tid < 256 ? vp : op);
    S.qt[0] = *(const u32x4*)(c.P() + (r0 + (tid >> 4)) * ODD_IN + hd * 128 + (tid & 15) * 8); S.qt[1] = *(const u32x4*)(c.P() + (r0 + 32 + (tid >> 4)) * ODD_IN + hd * 128 + (tid & 15) * 8);
    S.gl = *(const u32x4*)(c.glaG() + ug * 128 + (tid & 31) * 4);
}
constexpr int G4_K = 0, G4_V = 128 * 72, G4_Q = G4_V + 32 * 72, G4_O = G4_Q + 64 * 136, G4_G = G4_O + 64 * 40, G4_SIZE = G4_G + 256;
__device__ __forceinline__ void gla4_stage_put(lbf* B, const GlaStage4& S, const int tid) {
    *(LAS u32x4*)(B + G4_K + (tid >> 3) * 72 + (tid & 7) * 8) = S.kh[0]; *(LAS u32x4*)(B + G4_K + (64 + (tid >> 3)) * 72 + (tid & 7) * 8) = S.kh[1];
    const int t2 = tid & 255;
    if (tid < 256) *(LAS u32x4*)(B + G4_V + (t2 >> 3) * 72 + (t2 & 7) * 8) = S.vo; else *(LAS u32x4*)(B + G4_O + (t2 >> 2) * 40 + (t2 & 3) * 8) = S.vo;
    *(LAS u32x4*)(B + G4_Q + (tid >> 4) * 136 + (tid & 15) * 8) = S.qt[0]; *(LAS u32x4*)(B + G4_Q + (32 + (tid >> 4)) * 136 + (tid & 15) * 8) = S.qt[1];
    if (tid < 32) *(LAS u32x4*)(B + G4_G + tid * 8) = S.gl;
}
__device__ __forceinline__ void gla_seq_unit4(const Ctx& c, const int u) {
    const int tid = c.tid, lane = c.lane, w = c.wave, fr = lane & 15, fq = lane >> 4;
    const int bh = u >> 3, dq = u & 7, b = bh >> 2, hd = bh & 3;
    lbf* SB = (lbf*)(c.lds + LDS_PH);
    lbf* Zb = SB + 2 * G4_SIZE;
    f32x4 z[2] = {(f32x4){0.f, 0.f, 0.f, 0.f}, (f32x4){0.f, 0.f, 0.f, 0.f}};
    const int ti = w >> 1, dt = w & 1;
    GlaStage4 R0, R1, R2;
    gla4_stage_load(c, R0, bh, dq, 0); gla4_stage_load(c, R1, bh, dq, 1); gla4_stage_load(c, R2, bh, dq, 2);
#define GLA4_STEP(RS_, ch_) do { const int ch = (ch_); \
        lbf* B = SB + (ch & 1) * G4_SIZE; lbf* Zc = Zb + (ch & 1) * (32 * 136); \
        gla4_stage_put(B, RS_, tid); \
        _Pragma("unroll") for (int d = 0; d < 2; ++d) st4(Zc, 136, 16 * w, 16 * d, z[d], lane); \
        if (ch + 3 < NCH) gla4_stage_load(c, RS_, bh, dq, ch + 3); \
        lds_barrier(); \
        const size_t r0 = (size_t)b * TP + ch * 64; \
        { f32x4 o = up4(*(const LAS u32x2*)(B + G4_O + (16 * ti + fr) * 40 + 16 * dt + 4 * fq)); \
            _Pragma("unroll") for (int k = 0; k < 4; ++k) o = MFMA16(ldfrag(Zc, 136, 16 * dt, 32 * k, lane), ldfrag(B + G4_Q, 136, 16 * ti, 32 * k, lane), o); \
            int l2 = lane; asm volatile("" : "+v"(l2)); \
            if (!c.dry) *(u32x2*)(c.HN() + (r0 + 16 * ti + (l2 & 15)) * 1024 + hd * 256 + dq * 32 + 16 * dt + 4 * (l2 >> 4)) = pk4(o); } \
        { const f32x4 gl = *(const LAS f32x4*)((const LAS float*)(B + G4_G) + 16 * w + 4 * fq); \
            const bf16x8 k0 = ldfrag(B + G4_K, 72, 16 * w, 0, lane), k1 = ldfrag(B + G4_K, 72, 16 * w, 32, lane); \
            _Pragma("unroll") for (int d = 0; d < 2; ++d) { f32x4 a = z[d] * gl; a = MFMA16(k0, ldfrag(B + G4_V, 72, 16 * d, 0, lane), a); a = MFMA16(k1, ldfrag(B + G4_V, 72, 16 * d, 32, lane), a); z[d] = a; } } \
    } while (0)
#pragma unroll 1
    for (int ch0 = 0; ch0 < NCH; ch0 += 3) { GLA4_STEP(R0, ch0); GLA4_STEP(R1, ch0 + 1); GLA4_STEP(R2, ch0 + 2); }
#undef GLA4_STEP
    lds_barrier();
}
__device__ __forceinline__ void ph_gla_seq2(const Ctx& c) {
    for (int v = c.bid; v < BATCH * 4 * 8; v += c.G) { const int xcd = v & 7, slot = v >> 3; const int u = ((xcd * 4 + (slot >> 3)) << 3) | (slot & 7); gla_seq_unit4(c, u); }
}
__device__ __forceinline__ void ph_gla_finish(const Ctx& c) {
    const Params& p = *c.p; const float* hg = p.in[I_OHEADGAIN];
    for (int row = c.bid * 8 + c.wave; row < NP; row += c.G * 8) {
        const bf16_t* op = c.HN() + (size_t)row * 1024 + 16 * c.lane; const bf16_t* rp = c.P() + (size_t)row * ODD_IN + 2064 + 16 * c.lane;
        float o[16], r[16];
        unpack8(*(const u32x4*)op, o); unpack8(*(const u32x4*)(op + 8), o + 8); unpack8(*(const u32x4*)rp, r); unpack8(*(const u32x4*)(rp + 8), r + 8);
        float ss = 0.f;
#pragma unroll
        for (int q = 0; q < 16; ++q) ss += o[q] * o[q];
        ss += __shfl_xor(ss, 1); ss += __shfl_xor(ss, 2); ss += __shfl_xor(ss, 4); ss += __shfl_xor(ss, 8);
        const float inv = rsqrtf(ss * (1.0f / 256.0f) + 1e-6f); float y[16];
#pragma unroll
        for (int q = 0; q < 16; ++q) y[q] = o[q] * inv * hg[16 * c.lane + q] * (r[q] / (1.0f + __expf(-r[q])));
        bf16_t* yp = c.Y() + (size_t)row * 1024 + 16 * c.lane;
        if (!c.dry) *(u32x4*)yp = pack8(y); if (!c.dry) *(u32x4*)(yp + 8) = pack8(y + 8);
    }
}

constexpr int N_PHASES = 19;
__global__ void __launch_bounds__(NTHREADS, 2) fwd(const Params p, const int lo, const int hi, const int probe) {
    extern __shared__ __attribute__((aligned(16))) unsigned char smem[];
    Ctx c; c.p = &p; c.lds = (LAS unsigned char*)smem; c.tid = threadIdx.x; c.lane = c.tid & 63; c.wave = __builtin_amdgcn_readfirstlane(c.tid >> 6); c.G = gridDim.x; c.bid = blockIdx.x; c.dry = 0;
    unsigned char* ws = p.ws;
    c.ws = ws; c.dsc = (unsigned char*)p.out;
    LAS unsigned char* glds = c.lds + LDS_PH;

    if (c.tid < 4) ((volatile LAS unsigned*)smem)[c.tid] = 0u;
    __syncthreads();
    XcdBarrier bar; bar.bar = (unsigned*)(ws + WS_CTL); bar.x = 0; bar.st = (volatile LAS unsigned*)smem;
    if (hi - lo > 1) bar = xcd_barrier_post((unsigned*)(ws + WS_CTL), (volatile LAS unsigned*)smem);
#ifndef PHMASK
#define PHMASK 0x7FFFF
#endif
#define IN(k) (((PHMASK >> (k)) & 1) && lo <= (k) && (k) < hi)
#define SEAM(k) do { if (IN(k) && IN((k) + 1)) xcd_barrier(bar); } while (0)
#if PROBE_MASK
#define RUN(k, ...) do { if (IN(k)) { if ((PROBE_MASK >> (k)) & 1) { for (int rep = ((probe >> (k)) & 1) ? 0 : 1; rep < 2; ++rep) { c.dry = (rep == 0); __VA_ARGS__; } } else { c.dry = 0; __VA_ARGS__; } } } while (0)
#else
#define RUN(k, ...) do { if (IN(k)) { __VA_ARGS__; } } while (0)
#endif

    RUN(0, ph_prologue(c));
    SEAM(0);
    if ((probe >> 30) & 1) { for (int k = 0; k < 16; ++k) xcd_barrier(bar); }
    if (IN(1)) { pg8::DenseOrder S; S.init(NP, EVEN_IN, 1024, c.WinE(), c.G, c.bid); pg8::EpiStoreBf16T<true, false> E{c.P(), EVEN_IN, EVEN_IN, c.dry, c.srow(), nullptr};
        pg8::gemm_phase(glds, (const char*)c.XB(), 1024, S, E); }
    SEAM(1);
    RUN(2, { ph_rwkv_prep(c); ph_lru2(c, false); });
    SEAM(2);
    RUN(3, ph_rwkv_seq(c));
    SEAM(3);
    RUN(4, ph_rwkv_post(c));
    SEAM(4);
    if (IN(5)) { pg8::DenseOrder S; S.init(NP, 1024, 1024, c.WoutE(), c.G, c.bid); pg8::EpiStoreBf16T<false, true> E{c.H(), 1024, 1024, c.dry, nullptr, c.XB()};
        pg8::gemm_phase(glds, (const char*)c.Y(), 1024, S, E); }
    SEAM(5);
    RUN(6, ph_router4(c, 0));
    SEAM(6);
    if (IN(7)) { moe_table(c, 0);
        pg8::MoeOrder S{(const LAS int*)(glds + 131072), c.mcnt(), c.mlist(), (const char*)c.W1(), (size_t)512 * 1024 * 2, 2, c.G, c.bid, 1024, 1}; pg8::EpiSwiglu E{c.HID(), c.dry, c.mls()};
        pg8::gemm_phase(glds, (const char*)c.H(), 1024, S, E); }
    SEAM(7);
    if (IN(8)) { moe_table(c, 0);
        pg8::MoeOrder S{(const LAS int*)(glds + 131072), c.mcnt(), c.mlist(), (const char*)c.W2(), (size_t)1024 * 256 * 2, 4, c.G, c.bid, 256, 0}; pg8::EpiScatter E{c.YM(), c.mlist(), c.mlw(), c.dry};
        pg8::gemm_phase(glds, (const char*)c.HID(), 256, S, E); }
    SEAM(8);
    RUN(9, ph_combine_norm(c, p.in[I_ONORM], 0));
    SEAM(9);
    if (IN(10)) { pg8::DenseOrder S; S.init(NP, ODD_IN_PAD, 1024, c.WinO(), c.G, c.bid); pg8::EpiStoreBf16T<true, false> E{c.P(), ODD_IN, ODD_IN, c.dry, c.srow(), nullptr};
        pg8::gemm_phase(glds, (const char*)c.H(), 1024, S, E); }
    SEAM(10);
    RUN(11, ph_gla_prep2(c));
    SEAM(11);
    RUN(12, ph_gla_seq2(c));
    SEAM(12);
    RUN(13, { ph_gla_finish(c); filler_B(c, c.bid, c.G); });
    SEAM(13);
    if (IN(14)) { pg8::DenseOrder S; S.init(NP, 1024, 1024, c.WoutO(), c.G, c.bid); pg8::EpiStoreBf16T<false, true> E{c.H(), 1024, 1024, c.dry, nullptr, c.H()};
        pg8::gemm_phase(glds, (const char*)c.Y(), 1024, S, E); }
    SEAM(14);
    RUN(15, ph_router4(c, 1));
    SEAM(15);
    if (IN(16)) { moe_table(c, 1);
        pg8::MoeOrder S{(const LAS int*)(glds + 131072), c.mcnt() + 32, c.mlist(), (const char*)(c.W1() + (size_t)32 * 512 * 1024), (size_t)512 * 1024 * 2, 2, c.G, c.bid, 1024, 1}; pg8::EpiSwiglu E{c.HID(), c.dry, c.mls()};
        pg8::gemm_phase(glds, (const char*)c.H(), 1024, S, E); }
    SEAM(16);
    if (IN(17)) { moe_table(c, 1);
        pg8::MoeOrder S{(const LAS int*)(glds + 131072), c.mcnt() + 32, c.mlist(), (const char*)(c.W2() + (size_t)32 * 1024 * 256), (size_t)1024 * 256 * 2, 4, c.G, c.bid, 256, 0}; pg8::EpiScatter E{c.YM(), c.mlist(), c.mlw(), c.dry};
        pg8::gemm_phase(glds, (const char*)c.HID(), 256, S, E); }
    SEAM(17);
    RUN(18, ph_combine_norm(c, p.in[I_FINALNORM], 1));
#undef IN
#undef SEAM
#undef RUN
}

extern "C" void kernel_launch(void* const* d_in, const int* in_sizes, int n_in, void* d_out, int out_size, void* d_ws, size_t ws_size, hipStream_t stream) {
    static int grid = 0;
    if (grid == 0) {
        if (n_in != 38 || ws_size < WS_END) { fprintf(stderr, "kernel_launch: unexpected n_in %d or ws_size %zu (< %zu)\n", n_in, ws_size, (size_t)WS_END); grid = -1; return; }
        int dev = 0, cus = 0, per_cu = 0;
        if (hipGetDevice(&dev) != hipSuccess || hipDeviceGetAttribute(&cus, hipDeviceAttributeMultiprocessorCount, dev) != hipSuccess) { grid = -1; return; }
        if (hipFuncSetAttribute((const void*)fwd, hipFuncAttributeMaxDynamicSharedMemorySize, LDS_BYTES) != hipSuccess) { fprintf(stderr, "kernel_launch: hipFuncSetAttribute failed\n"); grid = -1; return; }
        if (hipOccupancyMaxActiveBlocksPerMultiprocessor(&per_cu, (const void*)fwd, NTHREADS, LDS_BYTES) != hipSuccess || per_cu < 1) fprintf(stderr, "kernel_launch: occupancy query says %d\n", per_cu);
        (void)hipGetLastError();
        grid = cus;
    }
    if (grid < 0) return;
    (void)hipMemsetAsync((char*)d_ws + WS_CTL, 0, 32768, stream);
    Params p{};
    for (int i = 0; i < 38; ++i) p.in[i] = (const float*)d_in[i];
    p.out = (float*)d_out; p.ws = (unsigned char*)d_ws;
#if ONE_LAUNCH
    hipLaunchKernelGGL(fwd, dim3(grid), dim3(NTHREADS), LDS_BYTES, stream, p, 0, N_PHASES, (int)PROBE_MASK);
#else
    for (int k = 0; k < N_PHASES; ++k) hipLaunchKernelGGL(fwd, dim3(grid), dim3(NTHREADS), LDS_BYTES, stream, p, k, k + 1, (int)PROBE_MASK);
#endif
}
```

```cpp
#include <hip/hip_runtime.h>
#include <stdint.h>
#include <stdio.h>

typedef unsigned short bf16_t;
typedef short bf16x8 __attribute__((ext_vector_type(8)));
typedef float f32x4 __attribute__((ext_vector_type(4)));
typedef unsigned u32x4 __attribute__((ext_vector_type(4)));
typedef unsigned u32x2 __attribute__((ext_vector_type(2)));
#define LAS __attribute__((address_space(3)))
typedef LAS float lfloat;
typedef LAS int lint;

#ifndef PROBE_MASK
#define PROBE_MASK 0
#endif
#ifndef ONE_LAUNCH
#define ONE_LAUNCH 1
#endif

constexpr int BATCH = 8, SEQ = 8192, DM = 1024, NMETA = 16, TT = SEQ + NMETA  , TP = 8256  , NP = BATCH * TP  , NTOK = BATCH * TT;
constexpr int NCH = TP / 64;
constexpr int EVEN_IN = 2816, ODD_IN = 3088, ODD_IN_PAD = 3328;
constexpr int MCAP = 65792;
constexpr int NTHREADS = 512;
constexpr int LDS_BYTES = 161792;
constexpr int LDS_PH = 64;
constexpr int LDS_MISC = 64 + 131072;

constexpr size_t WS_CTL = 0;
constexpr size_t WS_H = 32768;
constexpr size_t WS_P = WS_H + (size_t)NP * 1024 * 4;
constexpr size_t WS_Y = WS_P + (size_t)NP * ODD_IN * 2;
constexpr size_t WS_HN = WS_Y + (size_t)NP * 1024 * 2;
constexpr size_t WS_WINE = WS_HN + (size_t)NP * 1024 * 2;
constexpr size_t WS_WOUTE = WS_WINE + (size_t)EVEN_IN * 1024 * 2;
constexpr size_t WS_WINO = WS_WOUTE + (size_t)1024 * 1024 * 2;
constexpr size_t WS_WOUTO = WS_WINO + (size_t)ODD_IN_PAD * 1024 * 2;
constexpr size_t WS_W1 = WS_WOUTO + (size_t)1024 * 1024 * 2;
constexpr size_t WS_W2 = WS_W1 + (size_t)2 * 32 * 512 * 1024 * 2;
constexpr size_t WS_WRT = WS_W2 + (size_t)2 * 32 * 1024 * 256 * 2;
constexpr size_t WS_DUT = WS_WRT + (size_t)2 * 36 * 1024 * 4;
constexpr size_t WS_IUT = WS_DUT + 512 * 64 * 2;
constexpr size_t WS_GUT = WS_IUT + 512 * 64 * 2;
constexpr size_t WS_WAT = WS_GUT + 512 * 128 * 2;
constexpr size_t WS_WXT = WS_WAT + 8 * 4096 * 2;
constexpr size_t WS_LAMC = WS_WXT + 8 * 4096 * 2;
constexpr size_t WS_WRH = WS_LAMC + 512 * 4;
constexpr size_t WS_WRL = WS_WRH + (size_t)2 * 48 * 1024 * 2;
constexpr size_t WS_GLU = WS_WRL + (size_t)2 * 48 * 1024 * 2;
constexpr size_t WS_SROW = WS_GLU + 512 * 32 * 2;
constexpr size_t WS_END = WS_SROW + (size_t)NP * 4;
constexpr size_t PO_YM = 0;
constexpr size_t PO_HID = (size_t)2 * NP * 1024 * 2;
constexpr size_t PO_LIST = PO_HID + (size_t)(2 * NTOK + 32 * 256) * 256 * 2;
constexpr size_t PO_LW = PO_LIST + (size_t)32 * MCAP * 4;
constexpr size_t PO_LS = PO_LW + (size_t)32 * MCAP * 4;
constexpr size_t PO_END = PO_LS + (size_t)32 * MCAP * 4;
static_assert(PO_END <= (size_t)NP * EVEN_IN * 2, "MoE scratch must fit the P region");
constexpr size_t DO_LRUA = 0;
constexpr size_t DO_LRUH = DO_LRUA + (size_t)BATCH * NCH * 512 * 4;
constexpr size_t DO_LRUC = DO_LRUH + (size_t)BATCH * NCH * 512 * 4;
constexpr size_t DO_GLAG = DO_LRUC + (size_t)BATCH * NCH * 512 * 4;
constexpr int NRU = BATCH * 8 * NCH;
constexpr size_t DO_RWHC = DO_GLAG + (size_t)BATCH * 4 * NCH * 128 * 4;
constexpr size_t DO_RWOO = DO_RWHC + (size_t)NRU * 4096 * 2;
constexpr size_t DO_RWE2 = DO_RWOO + (size_t)NRU * 4096 * 2;
constexpr size_t DO_RWGL = DO_RWE2 + (size_t)NRU * 4096 * 2;
constexpr size_t DO_END = DO_RWGL + (size_t)NRU * 64 * 4;
constexpr size_t LRU_LA_HALF = (size_t)4 * TP * 512 * 2;
static_assert(DO_END + LRU_LA_HALF <= (size_t)BATCH * SEQ * DM * 4, "d_out scratch");
static_assert((size_t)NP * EVEN_IN * 2 + LRU_LA_HALF <= (size_t)NP * ODD_IN * 2, "log a of batches 0-3 sits in the tail of the P region during the even layer");

#define XB_TMO      128
#define XB_XCNT(j)  (256  + 64 * (j))
#define XB_XSUB(j)  (1280 + 64 * (j))
#define XB_XGEN(j)  (2304 + 64 * (j))
#define XB_TOP      3328
#define XB_TOPGEN   3392
#define XCD_BAR_WORDS 3456
#define XB_SPIN_CAP (1u << 22)

__device__ __forceinline__ unsigned xb_ld(unsigned* p)              { return __hip_atomic_load(p, __ATOMIC_RELAXED, __HIP_MEMORY_SCOPE_AGENT); }
__device__ __forceinline__ unsigned xb_add(unsigned* p, unsigned v) { return __hip_atomic_fetch_add(p, v, __ATOMIC_RELAXED, __HIP_MEMORY_SCOPE_AGENT); }
__device__ __forceinline__ unsigned xb_xcc_id() { return (unsigned)__builtin_amdgcn_s_getreg((3 << 11) | 20) & 0xFu; }
#define XB_SPIN(cond, bar) do { unsigned _sp = 0; while (cond) { __builtin_amdgcn_s_sleep(1); \
    if ((++_sp & 255u) == 0u) { if (xb_ld(&(bar)[XB_TMO])) break; if (_sp > XB_SPIN_CAP) { atomicAdd(&(bar)[XB_TMO], 1u); break; } } } } while (0)

struct XcdBarrier { unsigned* bar; unsigned x; volatile LAS unsigned* st; };

__device__ __forceinline__ XcdBarrier xcd_barrier_post(unsigned* bar, volatile LAS unsigned* st) {
    XcdBarrier b; b.bar = bar; b.x = xb_xcc_id(); b.st = st;
    if (threadIdx.x == 0) (void)xb_add(&bar[XB_XCNT(b.x)], 1u);
    return b;
}
__device__ __forceinline__ void xcd_barrier_complete(unsigned* bar, unsigned x, unsigned& nloc, unsigned& nx) {
    const unsigned G = gridDim.x * gridDim.y * gridDim.z;
    unsigned sum, cnt, mine, sp = 0u;
    for (;;) {
        sum = 0u; cnt = 0u; mine = 0u;
#pragma unroll
        for (unsigned j = 0; j < 16; ++j) { const unsigned c = xb_ld(&bar[XB_XCNT(j)]); sum += c; cnt += (c > 0u) ? 1u : 0u; mine = (j == x) ? c : mine; }
        if (sum == G) break;
        __builtin_amdgcn_s_sleep(1);
        if ((++sp & 255u) == 0u) { if (xb_ld(&bar[XB_TMO])) break; if (sp > XB_SPIN_CAP) { atomicAdd(&bar[XB_TMO], 1u); break; } }
    }
    nloc = mine > 0u ? mine : 1u; nx = cnt > 0u ? cnt : 1u;
}
__device__ __forceinline__ void xcd_barrier(const XcdBarrier& b) {
    asm volatile("s_waitcnt vmcnt(0)" ::: "memory");
    __syncthreads();
    if (threadIdx.x == 0) {
        unsigned* bar = b.bar;
        __builtin_amdgcn_s_waitcnt(0);
        unsigned nloc = b.st[0], nx = b.st[1];
        if (nloc == 0u) { xcd_barrier_complete(bar, b.x, nloc, nx); b.st[0] = nloc; b.st[1] = nx; }
        const unsigned old = xb_add(&bar[XB_XSUB(b.x)], 1u);
        const unsigned gen = old / nloc;
        if (old + 1u == (gen + 1u) * nloc) {
            __builtin_amdgcn_fence(__ATOMIC_RELEASE, "agent");
            asm volatile("s_waitcnt vmcnt(0)" ::: "memory");
            const unsigned og = xb_add(&bar[XB_TOP], 1u);
            const unsigned tg = og / nx;
            if (og + 1u == (tg + 1u) * nx) xb_add(&bar[XB_TOPGEN], 1u);
            else XB_SPIN(xb_ld(&bar[XB_TOPGEN]) == tg, bar);
            __builtin_amdgcn_fence(__ATOMIC_ACQUIRE, "agent");
            xb_add(&bar[XB_XGEN(b.x)], 1u);
            asm volatile("s_waitcnt vmcnt(0)" ::: "memory");
        } else {
            XB_SPIN(xb_ld(&bar[XB_XGEN(b.x)]) == gen, bar);
            __builtin_amdgcn_fence(__ATOMIC_ACQUIRE, "agent");
            asm volatile("s_waitcnt vmcnt(0)" ::: "memory");
        }
    }
    __syncthreads();
}

struct Params {
    const float* in[38];
    float* out;
    unsigned char* ws;
};
enum { I_X = 0, I_META, I_ENORM, I_EWIN, I_EMU, I_EDECAY0, I_EDECAYUP, I_EICLR0, I_EICLRUP, I_EGATEUP, I_EKK, I_EKA, I_ERK, I_ELNG, I_ELNB,
       I_ECONVW, I_ECONVB, I_ELRUWA, I_ELRUBA, I_ELRUWX, I_ELRUBX, I_ELAMBDA, I_EWOUT, I_ONORM, I_OWIN, I_OGUP, I_OGB, I_OHEADGAIN, I_OWOUT,
       I_MNORM, I_MWGROUP, I_MBGROUP, I_MWROUTER, I_MBROUTER, I_MWGATE, I_MWUP, I_MWDOWN, I_FINALNORM };

__device__ __forceinline__ bf16_t f2bf(float f) { unsigned u = __float_as_uint(f); u += 0x7FFFu + ((u >> 16) & 1u); return (bf16_t)(u >> 16); }
__device__ __forceinline__ float bf2f(unsigned b) { return __uint_as_float(b << 16); }
typedef __bf16 bf16v2 __attribute__((ext_vector_type(2)));
__device__ __forceinline__ unsigned pack2(float lo, float hi) { bf16v2 v; v.x = (__bf16)lo; v.y = (__bf16)hi; return __builtin_bit_cast(unsigned, v); }
__device__ __forceinline__ void unpack8(const u32x4 v, float* o) {
    o[0] = bf2f(v.x & 0xffffu); o[1] = bf2f(v.x >> 16); o[2] = bf2f(v.y & 0xffffu); o[3] = bf2f(v.y >> 16);
    o[4] = bf2f(v.z & 0xffffu); o[5] = bf2f(v.z >> 16); o[6] = bf2f(v.w & 0xffffu); o[7] = bf2f(v.w >> 16);
}
__device__ __forceinline__ u32x4 pack8(const float* o) { u32x4 w; w.x = pack2(o[0], o[1]); w.y = pack2(o[2], o[3]); w.z = pack2(o[4], o[5]); w.w = pack2(o[6], o[7]); return w; }
__device__ __forceinline__ float wave_sum(float v) {
#pragma unroll
    for (int o = 32; o > 0; o >>= 1) v += __shfl_xor(v, o);
    return v;
}
__device__ __forceinline__ float sum8(float v) { v += __shfl_xor(v, 1); v += __shfl_xor(v, 2); v += __shfl_xor(v, 4); return v; }
__device__ __forceinline__ float sigmoidf_(float x) { return 1.0f / (1.0f + __expf(-x)); }
__device__ __forceinline__ float softplusf_(float x) { return fmaxf(x, 0.f) + log1pf(__expf(-fabsf(x))); }

__device__ __forceinline__ void lds_barrier() { asm volatile("s_waitcnt lgkmcnt(0)" ::: "memory"); __builtin_amdgcn_s_barrier(); asm volatile("" ::: "memory"); }
namespace pg8 {
__device__ __forceinline__ float bf2f_(unsigned v) { return __builtin_bit_cast(float, v << 16); }
constexpr int BM = 256, BK = 64, HALF = 128, HTB = HALF * BK * 2, STAGE_BYTES = 8 * HTB;
__device__ __forceinline__ int lds_byte(int r, int c) { const int st = (r >> 4) * 2 + (c >> 5), rr = r & 15, cc = c & 31, ob = rr * 64 + cc * 2; return st * 1024 + (ob ^ (((ob >> 9) & 1) << 5)); }
__device__ __forceinline__ void stage_rc(int b, int& R, int& C) { const int st = b / 1024, sb = b % 1024, swz = sb ^ (((sb >> 9) & 1) << 5); R = (st >> 1) * 16 + swz / 64; C = (st & 1) * 32 + (swz % 64) / 2; }
__device__ __forceinline__ int perm32(int rho) { const int n = rho >> 4, i = rho & 15; return 8 * (i >> 2) + 4 * n + (i & 3); }
__device__ __forceinline__ unsigned cvt_pk_bf16(float lo, float hi) { return pack2(lo, hi); }

struct Unit { const char* b; int row0, col0, cnt, lrow; };

struct DenseOrder {
    int nM, nN, nwg, G, c, K; const char* Bt;
    __device__ void init(int M, int N, int K_, const void* Bt_, int G_, int c_) { nM = M / BM; nN = N / BM; nwg = nM * nN; G = G_; c = c_; K = K_; Bt = (const char*)Bt_; }
    __device__ __forceinline__ bool next(int i, Unit& u) const {
        const long L = (long)i * G + c; if (L >= nwg) return false;
        int wgid = (int)L; { const int q = nwg / 8, r = nwg % 8, xcd = wgid % 8, off = wgid / 8; wgid = (xcd < r ? xcd * (q + 1) : r * (q + 1) + (xcd - r) * q) + off; }
        const int nig = 8 * nN, gid = wgid / nig, fm = gid * 8, gsz = (nM - fm) < 8 ? (nM - fm) : 8;
        const int pm = fm + ((wgid % nig) % gsz), pn = (wgid % nig) / gsz;
        u.row0 = pm * BM; u.col0 = pn * BM; u.b = Bt + (size_t)pn * BM * K * 2; u.cnt = BM; u.lrow = 0; return true;
    }
    __device__ __forceinline__ unsigned arow(const Unit& u, int r) const { return (unsigned)(u.row0 + r); }
};
struct MoeOrder {
    const LAS int* tstart; const int* cnt; const int* list; const char* W; size_t wstride; int npn, G, c, K, gather;
    __device__ __forceinline__ bool next(int i, Unit& u) const {
        const int L = i * G + c; const int total = tstart[32] * npn; if (L >= total) return false;
        const int grp = 8 * npn, g0 = L / grp, gr = L - g0 * grp; int tile = 8 * g0 + (gr & 7), pn = gr >> 3;
        const int ntile = tstart[32]; if (8 * g0 + 8 > ntile) { const int Lr = L - g0 * grp; tile = 8 * g0 + Lr / npn; pn = Lr - (Lr / npn) * npn; }
        int e = 0;
#pragma unroll 1
        for (int k = 1; k < 32; ++k) e = (tstart[k] <= tile) ? k : e;
        const int j = tile - tstart[e];
        int c2 = cnt[e] - 256 * j; u.cnt = c2 > 256 ? 256 : c2; u.lrow = e * MCAP + 256 * j; u.row0 = tile * 256; u.col0 = pn * 256;
        u.b = W + (size_t)e * wstride + (size_t)pn * 256 * K * 2; return true;
    }
    __device__ __forceinline__ unsigned arow(const Unit& u, int r) const {
        if (gather) return (r < u.cnt) ? (unsigned)(list[u.lrow + r] >> 1) : 0u;
        return (unsigned)(u.row0 + r);
    }
};

template <bool RS, bool RES> struct EpiStoreBf16T {
    static constexpr bool PERM = true;
    bf16_t* O; int ldc; int ncols; int dry; const float* rs; const bf16_t* res;
    __device__ __forceinline__ void operator()(const f32x4 (&acc)[2][2][4][2], const Unit& u, int wr, int wc, int fr, int fq) const {
        const int row0 = u.row0 + wr * 64 + fr, col0 = u.col0 + wc * 32 + 8 * fq;
#pragma unroll
        for (int ai = 0; ai < 2; ++ai)
#pragma unroll
            for (int m = 0; m < 4; ++m) { bf16_t* rowp = O + (size_t)(row0 + ai * HALF + m * 16) * ldc + col0; const float sc = RS ? rs[row0 + ai * HALF + m * 16] : 1.0f;
#pragma unroll
                for (int bj = 0; bj < 2; ++bj) { f32x4 v0 = acc[ai][bj][m][0] * sc, v1 = acc[ai][bj][m][1] * sc;
                    if (RES) { const u32x4 rr = *(const u32x4*)(res + (size_t)(row0 + ai * HALF + m * 16) * ldc + col0 + bj * HALF);
                        v0[0] += bf2f_(rr.x & 0xffffu); v0[1] += bf2f_(rr.x >> 16); v0[2] += bf2f_(rr.y & 0xffffu); v0[3] += bf2f_(rr.y >> 16);
                        v1[0] += bf2f_(rr.z & 0xffffu); v1[1] += bf2f_(rr.z >> 16); v1[2] += bf2f_(rr.w & 0xffffu); v1[3] += bf2f_(rr.w >> 16); }
                    u32x4 w; w.x = cvt_pk_bf16(v0[0], v0[1]); w.y = cvt_pk_bf16(v0[2], v0[3]); w.z = cvt_pk_bf16(v1[0], v1[1]); w.w = cvt_pk_bf16(v1[2], v1[3]);
                    if (col0 + bj * HALF < ncols && !dry) *(u32x4*)(rowp + bj * HALF) = w; } }
    }
};
struct EpiSwiglu {
    static constexpr bool PERM = false;
    bf16_t* HID; int dry; const float* ls;
    __device__ __forceinline__ void operator()(const f32x4 (&acc)[2][2][4][2], const Unit& u, int wr, int wc, int fr, int fq) const {
        const int row0 = u.row0 + wr * 64 + fr, hc0 = (u.col0 >> 1) + wc * 32 + 4 * fq;
        float scv[2][4];
#pragma unroll
        for (int ai = 0; ai < 2; ++ai)
#pragma unroll
            for (int m = 0; m < 4; ++m) { const int r = wr * 64 + fr + ai * HALF + m * 16; const float v = ls[u.lrow + (r < u.cnt ? r : 0)]; scv[ai][m] = r < u.cnt ? v : 0.f; }
#pragma unroll
        for (int ai = 0; ai < 2; ++ai)
#pragma unroll
            for (int m = 0; m < 4; ++m) { bf16_t* rowp = HID + (size_t)(row0 + ai * HALF + m * 16) * 256 + hc0; const float sc = scv[ai][m];
#pragma unroll
                for (int n = 0; n < 2; ++n) { const f32x4 g = acc[ai][0][m][n] * sc, up = acc[ai][1][m][n] * sc; float h[4];
#pragma unroll
                    for (int q = 0; q < 4; ++q) h[q] = g[q] / (1.0f + __expf(-g[q])) * up[q];
                    u32x2 w; w.x = cvt_pk_bf16(h[0], h[1]); w.y = cvt_pk_bf16(h[2], h[3]); if (!dry) *(u32x2*)(rowp + n * 16) = w; else asm volatile("" :: "v"(w)); } }
    }
};
struct EpiScatter {
    static constexpr bool PERM = true;
    bf16_t* YM; const int* list; const float* lw; int dry;
    __device__ __forceinline__ void operator()(const f32x4 (&acc)[2][2][4][2], const Unit& u, int wr, int wc, int fr, int fq) const {
        const int r0 = wr * 64 + fr, col0 = u.col0 + wc * 32 + 8 * fq;
        int entv[2][4]; float wgtv[2][4];
#pragma unroll
        for (int ai = 0; ai < 2; ++ai)
#pragma unroll
            for (int m = 0; m < 4; ++m) { const int r = r0 + ai * HALF + m * 16, rc = u.lrow + (r < u.cnt ? r : 0); entv[ai][m] = list[rc]; wgtv[ai][m] = lw[rc]; }
#pragma unroll
        for (int ai = 0; ai < 2; ++ai)
#pragma unroll
            for (int m = 0; m < 4; ++m) { const int r = r0 + ai * HALF + m * 16;
                if (r < u.cnt) { const int ent = entv[ai][m]; const float wgt = wgtv[ai][m]; bf16_t* rowp = YM + (size_t)ent * 1024 + col0;
#pragma unroll
                    for (int bj = 0; bj < 2; ++bj) { const f32x4 v0 = acc[ai][bj][m][0] * wgt, v1 = acc[ai][bj][m][1] * wgt;
                        u32x4 w; w.x = cvt_pk_bf16(v0[0], v0[1]); w.y = cvt_pk_bf16(v0[2], v0[3]); w.z = cvt_pk_bf16(v1[0], v1[1]); w.w = cvt_pk_bf16(v1[2], v1[3]);
                        if (!dry) *(u32x4*)(rowp + bj * HALF) = w; else asm volatile("" :: "v"(w)); } } }
    }
};

template <class Epi, class Sched, bool ALIGN_EPI = true, bool SP2 = true>
__device__ __forceinline__ void gemm_phase(LAS unsigned char* lds, const char* Abase, const int K, const Sched& S, const Epi& E) {
    const int tid = threadIdx.x, wid = __builtin_amdgcn_readfirstlane(tid >> 6), lane = tid & 63, wr = wid >> 2, wc = wid & 3, fr = lane & 15, fq = lane >> 4;
    const int nt = K / BK;
    int RA[2]; unsigned CA[2], voffB[2];
#pragma unroll
    for (int i = 0; i < 2; ++i) { int R, C; stage_rc(tid * 16 + i * 8192, R, C); const int Rb = Epi::PERM ? ((R & ~31) + perm32(R & 31)) : R;
        RA[i] = R; CA[i] = (unsigned)C * 2u; voffB[i] = (unsigned)(Rb * K + C) * 2u; }
    const size_t kstep = (size_t)(BK * 2);
    const size_t hstep = (size_t)HALF * K * 2;
    const unsigned rowb = (unsigned)K * 2u;
    const unsigned ldsw = (unsigned)wid * 1024u;
    const int aoff = lds_byte(wr * 64 + fr, fq * 8), boff = lds_byte(wc * 32 + fr, fq * 8);
#define PG8_SA(b, h) (((b) * 2 + (h)) * HTB)
#define PG8_SB(b, h) ((4 + (b) * 2 + (h)) * HTB)
#define PG8_STAGE_B(bufoff, gbase) do { _Pragma("unroll") for (int _i = 0; _i < 2; ++_i) \
        __builtin_amdgcn_global_load_lds((const unsigned*)((const char*)(gbase) + voffB[_i]), (LAS unsigned*)(lds + (bufoff) + ldsw + _i * 8192), 16, 0, 0); } while (0)
#define PG8_STAGE_A(bufoff, OFF, h, kb) do { _Pragma("unroll") for (int _i = 0; _i < 2; ++_i) \
        __builtin_amdgcn_global_load_lds((const unsigned*)(Abase + (size_t)(kb) + (OFF)[h][_i]), (LAS unsigned*)(lds + (bufoff) + ldsw + _i * 8192), 16, 0, 0); } while (0)
#define PG8_LDA(dst, b, h) do { _Pragma("unroll") for (int m = 0; m < 4; ++m) _Pragma("unroll") for (int k = 0; k < 2; ++k) dst[m][k] = *(const LAS bf16x8*)(lds + PG8_SA(b, h) + aoff + m * 2048 + k * 1024); } while (0)
#define PG8_LDB(dst, b, h) do { _Pragma("unroll") for (int n = 0; n < 2; ++n) _Pragma("unroll") for (int k = 0; k < 2; ++k) dst[n][k] = *(const LAS bf16x8*)(lds + PG8_SB(b, h) + boff + n * 2048 + k * 1024); } while (0)
#define PG8_MMA(ai, bj, At, Bt) do { __builtin_amdgcn_s_setprio(1); _Pragma("unroll") for (int m = 0; m < 4; ++m) _Pragma("unroll") for (int n = 0; n < 2; ++n) _Pragma("unroll") for (int k = 0; k < 2; ++k) \
        acc[ai][bj][m][n] = __builtin_amdgcn_mfma_f32_16x16x32_bf16(Bt[n][k], At[m][k], acc[ai][bj][m][n], 0, 0, 0); __builtin_amdgcn_s_setprio(0); } while (0)
#define PG8_WAIT_V(n) asm volatile("s_waitcnt vmcnt(" #n ")" ::: "memory")
#define PG8_WAIT_L(n) asm volatile("s_waitcnt lgkmcnt(" #n ")" ::: "memory")
#define PG8_BAR __builtin_amdgcn_s_barrier()
#define PG8_SCHED __builtin_amdgcn_sched_barrier(0)
    Unit cur, nxt; int ui = 0;
    if (!S.next(0, cur)) return;
    unsigned oc[2][2], on[2][2];
#pragma unroll
    for (int h = 0; h < 2; ++h)
#pragma unroll
        for (int i = 0; i < 2; ++i) oc[h][i] = S.arow(cur, h * HALF + RA[i]) * rowb + CA[i];
    f32x4 acc[2][2][4][2];
#pragma unroll
    for (int a = 0; a < 2; ++a)
#pragma unroll
        for (int b = 0; b < 2; ++b)
#pragma unroll
            for (int m = 0; m < 4; ++m)
#pragma unroll
                for (int n = 0; n < 2; ++n) acc[a][b][m][n] = (f32x4){0.f, 0.f, 0.f, 0.f};
    bf16x8 At[4][2], B0[2][2], B1[2][2];
    const char* cB = cur.b;
    if constexpr (SP2) {
        PG8_STAGE_B(PG8_SB(0, 0), cB); PG8_STAGE_B(PG8_SB(0, 1), cB + hstep); PG8_STAGE_A(PG8_SA(0, 0), oc, 0, 0); PG8_STAGE_A(PG8_SA(0, 1), oc, 1, 0);
        if (wr == 1) PG8_BAR;
        PG8_WAIT_V(2); PG8_BAR;
        PG8_STAGE_B(PG8_SB(1, 0), cB + kstep); PG8_STAGE_A(PG8_SA(1, 0), oc, 0, kstep); PG8_STAGE_B(PG8_SB(1, 1), cB + hstep + kstep);
        PG8_WAIT_V(6); PG8_BAR;
    } else {
    PG8_STAGE_B(PG8_SB(0, 0), cB); PG8_STAGE_A(PG8_SA(0, 0), oc, 0, 0); PG8_STAGE_B(PG8_SB(0, 1), cB + hstep); PG8_STAGE_A(PG8_SA(0, 1), oc, 1, 0);
    if (wr == 1) PG8_BAR;
    PG8_WAIT_V(4); PG8_BAR;
    PG8_STAGE_B(PG8_SB(1, 0), cB + kstep); PG8_STAGE_A(PG8_SA(1, 0), oc, 0, kstep); PG8_STAGE_B(PG8_SB(1, 1), cB + hstep + kstep);
    PG8_WAIT_V(6); PG8_BAR;
    }
    for (;;) {
        const bool has_next = S.next(ui + 1, nxt);
        const char* nB = has_next ? nxt.b : cB;
#pragma unroll
        for (int h = 0; h < 2; ++h)
#pragma unroll
            for (int i = 0; i < 2; ++i) on[h][i] = has_next ? (S.arow(nxt, h * HALF + RA[i]) * rowb + CA[i]) : oc[h][i];
        for (int t = 0; t < nt; t += 2) {
            const bool last = (t == nt - 2);
            const size_t k1 = (size_t)(t + 1) * kstep;
            const size_t k2 = last ? (size_t)0 : (size_t)(t + 2) * kstep, k3 = k2 + kstep;
            const char* b2 = last ? nB : cB + (size_t)(t + 2) * kstep; const char* b3 = b2 + kstep;
            unsigned o2[2][2];
#pragma unroll
            for (int h = 0; h < 2; ++h)
#pragma unroll
                for (int i = 0; i < 2; ++i) o2[h][i] = last ? on[h][i] : oc[h][i];
            if constexpr (SP2) {
            PG8_LDB(B0, 0, 0); PG8_LDB(B1, 0, 1); PG8_SCHED; PG8_LDA(At, 0, 0); PG8_STAGE_A(PG8_SA(1, 1), oc, 1, k1);
            PG8_WAIT_V(8); PG8_WAIT_L(0); PG8_BAR; PG8_MMA(0, 0, At, B0); PG8_MMA(0, 1, At, B1); PG8_BAR; PG8_SCHED;
            PG8_LDA(At, 0, 1); PG8_STAGE_B(PG8_SB(0, 0), b2); PG8_STAGE_B(PG8_SB(0, 1), b2 + hstep); PG8_STAGE_A(PG8_SA(0, 0), o2, 0, k2);
            PG8_WAIT_V(8); PG8_WAIT_L(0); PG8_BAR; PG8_MMA(1, 0, At, B0); PG8_MMA(1, 1, At, B1); PG8_BAR; PG8_SCHED;
            PG8_LDB(B0, 1, 0); PG8_LDB(B1, 1, 1); PG8_SCHED; PG8_LDA(At, 1, 0); PG8_STAGE_A(PG8_SA(0, 1), o2, 1, k2);
            PG8_WAIT_V(8); PG8_WAIT_L(0); PG8_BAR; PG8_MMA(0, 0, At, B0); PG8_MMA(0, 1, At, B1); PG8_BAR; PG8_SCHED;
            PG8_LDA(At, 1, 1); PG8_STAGE_B(PG8_SB(1, 0), b3); PG8_STAGE_B(PG8_SB(1, 1), b3 + hstep); PG8_STAGE_A(PG8_SA(1, 0), o2, 0, k3);
            PG8_WAIT_V(8); PG8_WAIT_L(0); PG8_BAR; PG8_MMA(1, 0, At, B0); PG8_MMA(1, 1, At, B1); PG8_BAR; PG8_SCHED;
            } else {
            PG8_LDB(B0, 0, 0); PG8_SCHED; PG8_LDA(At, 0, 0); PG8_STAGE_A(PG8_SA(1, 1), oc, 1, k1);
            PG8_WAIT_L(8); PG8_BAR; PG8_WAIT_L(0); PG8_MMA(0, 0, At, B0); PG8_BAR; PG8_SCHED;
            PG8_LDB(B1, 0, 1); PG8_STAGE_B(PG8_SB(0, 0), b2);
            PG8_BAR; PG8_WAIT_L(0); PG8_MMA(0, 1, At, B1); PG8_BAR;
            PG8_LDA(At, 0, 1); PG8_STAGE_A(PG8_SA(0, 0), o2, 0, k2);
            PG8_BAR; PG8_WAIT_L(0); PG8_MMA(1, 0, At, B0); PG8_BAR; PG8_SCHED;
            PG8_STAGE_B(PG8_SB(0, 1), b2 + hstep);
            PG8_WAIT_V(6); PG8_BAR; PG8_MMA(1, 1, At, B1); PG8_BAR;
            PG8_LDB(B0, 1, 0); PG8_SCHED; PG8_LDA(At, 1, 0); PG8_STAGE_A(PG8_SA(0, 1), o2, 1, k2);
            PG8_WAIT_L(8); PG8_BAR; PG8_WAIT_L(0); PG8_MMA(0, 0, At, B0); PG8_BAR; PG8_SCHED;
            PG8_LDB(B1, 1, 1); PG8_STAGE_B(PG8_SB(1, 0), b3);
            PG8_BAR; PG8_WAIT_L(0); PG8_MMA(0, 1, At, B1); PG8_BAR;
            PG8_LDA(At, 1, 1); PG8_STAGE_A(PG8_SA(1, 0), o2, 0, k3);
            PG8_BAR; PG8_WAIT_L(0); PG8_MMA(1, 0, At, B0); PG8_BAR; PG8_SCHED;
            PG8_STAGE_B(PG8_SB(1, 1), b3 + hstep);
            PG8_WAIT_V(6); PG8_BAR; PG8_MMA(1, 1, At, B1); PG8_BAR;
            }
        }
        if constexpr (ALIGN_EPI) { if (wr == 0) PG8_BAR; }
        E(acc, cur, wr, wc, fr, fq);
        if (!has_next) break;
#pragma unroll
        for (int a = 0; a < 2; ++a)
#pragma unroll
            for (int b = 0; b < 2; ++b)
#pragma unroll
                for (int m = 0; m < 4; ++m)
#pragma unroll
                    for (int n = 0; n < 2; ++n) acc[a][b][m][n] = (f32x4){0.f, 0.f, 0.f, 0.f};
        cur = nxt; cB = nB; ++ui;
#pragma unroll
        for (int h = 0; h < 2; ++h)
#pragma unroll
            for (int i = 0; i < 2; ++i) oc[h][i] = on[h][i];
        if constexpr (ALIGN_EPI) { if (wr == 1) PG8_BAR; }
    }
    PG8_WAIT_V(0);
    if constexpr (!ALIGN_EPI) { if (wr == 0) PG8_BAR; }
    PG8_BAR;
#undef PG8_SA
#undef PG8_SB
#undef PG8_STAGE_A
#undef PG8_STAGE_B
#undef PG8_LDA
#undef PG8_LDB
#undef PG8_MMA
#undef PG8_WAIT_V
#undef PG8_WAIT_L
#undef PG8_BAR
#undef PG8_SCHED
}
}

struct Ctx {
    const Params* p; LAS unsigned char* lds; int tid, lane, wave, G, bid, dry;
    unsigned char* ws; unsigned char* dsc;
#define WSP(T, name, off) __device__ __forceinline__ T* name() const { return (T*)(ws + (off)); }
#define DSP(T, name, off) __device__ __forceinline__ T* name() const { return (T*)(dsc + (off)); }
    WSP(bf16_t, H, WS_H) WSP(bf16_t, P, WS_P) WSP(bf16_t, Y, WS_Y) WSP(bf16_t, HN, WS_HN)
    WSP(bf16_t, WinE, WS_WINE) WSP(bf16_t, WoutE, WS_WOUTE) WSP(bf16_t, WinO, WS_WINO) WSP(bf16_t, WoutO, WS_WOUTO) WSP(bf16_t, W1, WS_W1) WSP(bf16_t, W2, WS_W2)
    WSP(int, mcnt, WS_CTL + 16384)
    WSP(bf16_t, YM, WS_P + PO_YM) WSP(bf16_t, HID, WS_P + PO_HID) WSP(int, mlist, WS_P + PO_LIST) WSP(float, mlw, WS_P + PO_LW) WSP(float, mls, WS_P + PO_LS) WSP(float, srow, WS_SROW) WSP(bf16_t, XB, WS_H + (size_t)NP * 1024 * 2)
    DSP(float, lruA, DO_LRUA) DSP(float, lruH, DO_LRUH) DSP(float, lruC, DO_LRUC) DSP(float, glaG, DO_GLAG)
    WSP(bf16_t, DUt, WS_DUT) WSP(bf16_t, IUt, WS_IUT) WSP(bf16_t, GUt, WS_GUT) WSP(bf16_t, WAt, WS_WAT) WSP(bf16_t, WXt, WS_WXT) WSP(bf16_t, WrH, WS_WRH) WSP(bf16_t, WrL, WS_WRL) WSP(float, LAMC, WS_LAMC)
    WSP(bf16_t, GLUt, WS_GLU)
    WSP(bf16_t, rwGP, WS_HN) WSP(bf16_t, rwQE, WS_HN + (size_t)NRU * 4096 * 2)
    DSP(bf16_t, rwHC, DO_RWHC) DSP(bf16_t, rwOO, DO_RWOO) DSP(bf16_t, rwE2, DO_RWE2) DSP(float, rwGL, DO_RWGL)
    __device__ __forceinline__ bf16_t* lruLA(const int b) const { return b < 4 ? (bf16_t*)(ws + WS_P + (size_t)NP * EVEN_IN * 2) + (size_t)b * TP * 512 : (bf16_t*)(dsc + DO_END) + (size_t)(b - 4) * TP * 512; }
    DSP(bf16_t, gKH, DO_RWHC) DSP(bf16_t, gVC, DO_RWHC + (size_t)BATCH * 4 * NCH * 8192 * 2)
#undef WSP
#undef DSP
};

constexpr int NJ_WINE = 16 * 44, NJ_WOUT = 256, NJ_WINO = 16 * 49, NJ_W1 = 64 * 128, NJ_W2 = 64 * 64;
constexpr int J1 = NJ_WINE, J2 = J1 + NJ_WOUT, J3 = J2 + NJ_WINO, J4 = J3 + NJ_WOUT, J5 = J4 + NJ_W1, J6 = J5 + NJ_W2, J7 = J6 + 48;
struct ConvJob { const float* src; bf16_t* dst; const float* ksc; int lds_src, ldd, nvalid; };
__device__ __forceinline__ ConvJob conv_decode(const Ctx& c, const int job) {
    const Params& p = *c.p; ConvJob J; J.nvalid = 64; J.ksc = nullptr;
    int j = job;
    if (j < J1) { const int kt = j / 44, nt = j % 44; J.src = p.in[I_EWIN] + (size_t)kt * 64 * EVEN_IN + nt * 64; J.lds_src = EVEN_IN; J.ksc = p.in[I_ENORM] + kt * 64; J.dst = c.WinE() + (size_t)nt * 64 * 1024 + kt * 64; J.ldd = 1024; }
    else if (j < J2) { j -= J1; const int kt = j / 16, nt = j % 16; J.src = p.in[I_EWOUT] + (size_t)kt * 64 * 1024 + nt * 64; J.lds_src = 1024; J.dst = c.WoutE() + (size_t)nt * 64 * 1024 + kt * 64; J.ldd = 1024; }
    else if (j < J3) { j -= J2; const int kt = j / 49, nt = j % 49; J.src = p.in[I_OWIN] + (size_t)kt * 64 * ODD_IN + nt * 64; J.lds_src = ODD_IN; J.ksc = p.in[I_ONORM] + kt * 64; J.nvalid = (ODD_IN - nt * 64) < 64 ? (ODD_IN - nt * 64) : 64;
        J.dst = c.WinO() + (size_t)nt * 64 * 1024 + kt * 64; J.ldd = 1024; }
    else if (j < J4) { j -= J3; const int kt = j / 16, nt = j % 16; J.src = p.in[I_OWOUT] + (size_t)kt * 64 * 1024 + nt * 64; J.lds_src = 1024; J.dst = c.WoutO() + (size_t)nt * 64 * 1024 + kt * 64; J.ldd = 1024; }
    else if (j < J5) { j -= J4; const int le = j / 128, r = j % 128, which = r / 64, r2 = r % 64, kt = r2 / 4, nt = r2 % 4;
        J.src = p.in[which ? I_MWUP : I_MWGATE] + (size_t)le * 1024 * 256 + (size_t)kt * 64 * 256 + nt * 64; J.lds_src = 256; J.ksc = p.in[I_MNORM] + (le >> 5) * 1024 + kt * 64;
        const int row0 = (nt >> 1) * 256 + (nt & 1) * 64 + which * 128;
        J.dst = c.W1() + (size_t)le * 512 * 1024 + (size_t)row0 * 1024 + kt * 64; J.ldd = 1024; }
    else if (j >= J6) { j -= J6;
        if (j < 8) { J.src = p.in[I_EDECAYUP] + j * 64; J.lds_src = 512; J.dst = c.DUt() + (size_t)j * 64 * 64; J.ldd = 64; }
        else if (j < 16) { j -= 8; J.src = p.in[I_EICLRUP] + j * 64; J.lds_src = 512; J.dst = c.IUt() + (size_t)j * 64 * 64; J.ldd = 64; }
        else if (j < 32) { j -= 16; const int kt = j / 8, nt = j % 8; J.src = p.in[I_EGATEUP] + (size_t)kt * 64 * 512 + nt * 64; J.lds_src = 512; J.dst = c.GUt() + (size_t)nt * 64 * 128 + kt * 64; J.ldd = 128; }
        else if (j < 40) { j -= 32; J.src = p.in[I_ELRUWA] + (size_t)j * 4096; J.lds_src = 64; J.dst = c.WAt() + (size_t)j * 4096; J.ldd = 64; }
        else { j -= 40; J.src = p.in[I_ELRUWX] + (size_t)j * 4096; J.lds_src = 64; J.dst = c.WXt() + (size_t)j * 4096; J.ldd = 64; } }
    else { j -= J5; const int le = j / 64, r = j % 64, kt = r / 16, nt = r % 16;
        J.src = p.in[I_MWDOWN] + (size_t)le * 256 * 1024 + (size_t)kt * 64 * 1024 + nt * 64; J.lds_src = 1024;
        J.dst = c.W2() + (size_t)le * 1024 * 256 + (size_t)nt * 64 * 256 + kt * 64; J.ldd = 256; }
    return J;
}
constexpr int CONV_T = 2;
template <bool FAST> __device__ __forceinline__ void conv_range(const Ctx& c, const int lo, const int hi, const int vb, const int nvb) {
    const int tid = c.tid;
    lfloat* tile = (lfloat*)(c.lds + LDS_PH);
    for (int j0 = lo + CONV_T * vb; j0 < hi; j0 += CONV_T * nvb) {
        f32x4 v[CONV_T][2]; float gk[CONV_T][2];
#pragma unroll
        for (int q = 0; q < CONV_T; ++q) { const int job = (j0 + q) < hi ? (j0 + q) : (hi - 1); const ConvJob J = conv_decode(c, job); const float* kp = J.ksc ? J.ksc : c.p->in[I_ENORM];
#pragma unroll
            for (int i = 0; i < 2; ++i) { const int k = (tid >> 4) + 32 * i, n4 = (tid & 15) * 4; { const float g = kp[k]; gk[q][i] = J.ksc ? g : 1.0f; }
                if (FAST) v[q][i] = *(const f32x4*)(J.src + (size_t)k * J.lds_src + (n4 < J.nvalid ? n4 : 0));
                else { v[q][i] = (f32x4){0.f, 0.f, 0.f, 0.f}; if (n4 < J.nvalid) v[q][i] = *(const f32x4*)(J.src + (size_t)k * J.lds_src + n4); } } }
#pragma unroll
        for (int q = 0; q < CONV_T; ++q)
#pragma unroll
            for (int i = 0; i < 2; ++i) { const int k = (tid >> 4) + 32 * i, n4 = (tid & 15) * 4; lfloat* tp = tile + q * 4160 + k * 65 + n4; const float g = gk[q][i];
                tp[0] = v[q][i][0] * g; tp[1] = v[q][i][1] * g; tp[2] = v[q][i][2] * g; tp[3] = v[q][i][3] * g; }
        __syncthreads();
#pragma unroll
        for (int q = 0; q < CONV_T; ++q) { const int job = j0 + q;
            if (job < hi) { const ConvJob J = conv_decode(c, job); const int n = tid >> 3, k8 = (tid & 7) * 8;
                if (n < J.nvalid) { float o[8];
#pragma unroll
                    for (int e = 0; e < 8; ++e) o[e] = tile[q * 4160 + (k8 + e) * 65 + n];
                    if (!c.dry) *(u32x4*)(J.dst + (size_t)n * J.ldd + k8) = pack8(o); } } }
        __syncthreads();
    }
}

__device__ __forceinline__ void ph_prologue(const Ctx& c) {
    const Params& p = *c.p; const int tid = c.tid;
    conv_range<true>(c, 0, J1, c.bid, c.G); conv_range<true>(c, J6, J7, c.bid, c.G);
    if (c.bid == 0 && !c.dry) c.LAMC()[tid] = -8.0f * softplusf_(-p.in[I_ELAMBDA][tid]);
    for (int row = c.bid * 8 + c.wave; row < NP; row += c.G * 8) {
        const int b = row / TP, t = row % TP;
        bf16_t* nrow = c.XB() + (size_t)row * 1024;
        if (t >= TT) {
#pragma unroll
            for (int i = 0; i < 4; ++i) { if (!c.dry) *(u32x2*)(nrow + 4 * c.lane + 256 * i) = (u32x2){0u, 0u}; }
            if (c.lane == 0 && !c.dry) c.srow()[row] = 0.f;
            continue;
        }
        const float* src = t < NMETA ? p.in[I_META] + (size_t)t * 1024 : p.in[I_X] + ((size_t)b * SEQ + (t - NMETA)) * 1024;
        f32x4 v[4]; float ss = 0.f;
#pragma unroll
        for (int i = 0; i < 4; ++i) { v[i] = *(const f32x4*)(src + 4 * c.lane + 256 * i); ss += v[i][0] * v[i][0] + v[i][1] * v[i][1] + v[i][2] * v[i][2] + v[i][3] * v[i][3]; }
        ss = wave_sum(ss);
        if (c.lane == 0 && !c.dry) c.srow()[row] = rsqrtf(ss * (1.0f / 1024.0f) + 1e-6f);
#pragma unroll
        for (int i = 0; i < 4; ++i) { u32x2 w; w.x = pack2(v[i][0], v[i][1]); w.y = pack2(v[i][2], v[i][3]); if (!c.dry) *(u32x2*)(nrow + 4 * c.lane + 256 * i) = w; }
    }
}
__device__ __forceinline__ void filler_A(const Ctx& c, const int vb, const int nvb) {
    const Params& p = *c.p; const int tid = c.tid;
    conv_range<true>(c, J1, J4 + 4096, vb, nvb); conv_range<true>(c, J5, J5 + 2048, vb, nvb);
    for (int idx = vb * NTHREADS + tid; idx < 2 * 48 * 1024; idx += nvb * NTHREADS) {
        const int l = idx / (48 * 1024), r = idx % (48 * 1024), e = r / 1024, k = r % 1024;
        const float val = (e < 4 ? p.in[I_MWGROUP][((size_t)l * 1024 + k) * 4 + e] : e < 36 ? p.in[I_MWROUTER][((size_t)l * 1024 + k) * 32 + (e - 4)] : 0.f) * p.in[I_MNORM][(size_t)l * 1024 + k];
        const bf16_t hi = f2bf(val); const bf16_t lo = f2bf(val - bf2f(hi));
        if (!c.dry) { c.WrH()[idx] = hi; c.WrL()[idx] = lo; } }
    for (int idx = vb * NTHREADS + tid; idx < 512 * 32; idx += nvb * NTHREADS) { const int n = idx >> 5, k = idx & 31; if (!c.dry) c.GLUt()[idx] = k < 16 ? f2bf(p.in[I_OGUP][k * 512 + n]) : (bf16_t)0; }
    for (int idx = vb * NTHREADS + tid; idx < (ODD_IN_PAD - ODD_IN) * 1024 / 8; idx += nvb * NTHREADS)
        if (!c.dry) *(u32x4*)(c.WinO() + (size_t)ODD_IN * 1024 + (size_t)idx * 8) = (u32x4){0u, 0u, 0u, 0u};
}
__device__ __forceinline__ void filler_B(const Ctx& c, const int vb, const int nvb) { conv_range<true>(c, J4 + 4096, J5, vb, nvb); conv_range<true>(c, J5 + 2048, J6, vb, nvb); }

typedef LAS bf16_t lbf;
#define MFMA16(a, b, c) __builtin_amdgcn_mfma_f32_16x16x32_bf16(a, b, c, 0, 0, 0)
__device__ __forceinline__ bf16x8 ldfrag(const lbf* base, int ld, int row0, int k0, int lane) { return *(const LAS bf16x8*)(base + (row0 + (lane & 15)) * ld + k0 + (lane >> 4) * 8); }
__device__ __forceinline__ bf16x8 gfrag(const bf16_t* base, int ld, int row0, int k0, int lane) { return *(const bf16x8*)(base + (size_t)(row0 + (lane & 15)) * ld + k0 + (lane >> 4) * 8); }
__device__ __forceinline__ u32x2 pk4(const f32x4 a) { u32x2 w; w.x = pg8::cvt_pk_bf16(a[0], a[1]); w.y = pg8::cvt_pk_bf16(a[2], a[3]); return w; }
__device__ __forceinline__ f32x4 up4(const u32x2 w) { return (f32x4){bf2f(w.x & 0xffffu), bf2f(w.x >> 16), bf2f(w.y & 0xffffu), bf2f(w.y >> 16)}; }
__device__ __forceinline__ void st4(lbf* base, int ld, int i0, int j0, const f32x4 a, int lane) { *(LAS u32x2*)(base + (j0 + (lane & 15)) * ld + i0 + 4 * (lane >> 4)) = pk4(a); }


__device__ __forceinline__ float fast_sigmoid(float x) { return __builtin_amdgcn_rcpf(1.0f + __expf(-x)); }
struct LruRows { u32x4 xv[4]; u32x4 gb; };
__device__ __forceinline__ LruRows lru_load_rows(const Ctx& c, const int u, const bool final) {
    const int b = u / (NCH * 8), rem = u % (NCH * 8), ch = rem / 8, n = rem % 8;
    const int i = c.tid >> 3, cg0 = 64 * n + (c.tid & 7) * 8, t = ch * 64 + i;
    LruRows R; R.gb = (u32x4){0u, 0u, 0u, 0u};
#pragma unroll
    for (int j = 0; j < 4; ++j) { const int tj = t - 3 + j; const bool ok = tj >= 0 && tj < TT;
        const u32x4 x = *(const u32x4*)(c.P() + ((size_t)b * TP + (ok ? tj : 0)) * EVEN_IN + 1792 + cg0);
        R.xv[j] = ok ? x : (u32x4){0u, 0u, 0u, 0u}; }
    if (final) R.gb = *(const u32x4*)(c.P() + ((size_t)b * TP + t) * EVEN_IN + 2304 + cg0);
    return R;
}
__device__ __forceinline__ void lru_run(const Ctx& c, const bool final, const int vb, const int nvb) {
    const Params& p = *c.p; const int tid = c.tid, lane = c.lane, w = c.wave, fr = lane & 15, fq = lane >> 4;
    const int NU = BATCH * NCH * 8;
    if (vb >= NU) return;
    lbf* XA = (lbf*)(c.lds + LDS_PH);
    lfloat* XC = (lfloat*)(XA + 64 * 72);
    lfloat* AA = XC + 4096;
    lfloat* UU = AA + 4096;
    lfloat* SEGA = UU + 4096;
    lfloat* SEGH = SEGA + 512;
    lfloat* CARA = SEGH + 512;
    lfloat* CARH = CARA + 512;
    const int i = tid >> 3, j8 = (tid & 7) * 8, mi = w >> 1;
    const bool fixed_n = (nvb % 8) == 0;
    bf16x8 fwa[2][2], fwx[2][2];
    if (fixed_n) { const int n = vb % 8;
#pragma unroll
        for (int n2 = 0; n2 < 2; ++n2)
#pragma unroll
            for (int k = 0; k < 2; ++k) { fwa[n2][k] = gfrag(c.WAt() + n * 4096, 64, 16 * (2 * (w & 1) + n2), 32 * k, lane); fwx[n2][k] = gfrag(c.WXt() + n * 4096, 64, 16 * (2 * (w & 1) + n2), 32 * k, lane); } }
    LruRows R = lru_load_rows(c, vb, final);
    for (int u = vb; u < NU; u += nvb) {
        const int b = u / (NCH * 8), rem = u % (NCH * 8), ch = rem / 8, n = rem % 8, t0 = ch * 64, cg0 = 64 * n + j8, t = t0 + i;
        if (!fixed_n) {
#pragma unroll
            for (int n2 = 0; n2 < 2; ++n2)
#pragma unroll
                for (int k = 0; k < 2; ++k) { fwa[n2][k] = gfrag(c.WAt() + n * 4096, 64, 16 * (2 * (w & 1) + n2), 32 * k, lane); fwx[n2][k] = gfrag(c.WXt() + n * 4096, 64, 16 * (2 * (w & 1) + n2), 32 * k, lane); } }
        float ca = 1.f, chh = 0.f;
        float cra[17], crh[17];
        if (final) { const int chn = tid & 63, sg = tid >> 6;
#pragma unroll
            for (int j = 0; j < 17; ++j) { const int c2 = 17 * sg + j, c3 = c2 < NCH ? c2 : NCH - 1; const size_t s2i = ((size_t)b * NCH + c3) * 512 + 64 * n + chn; cra[j] = c.lruA()[s2i]; crh[j] = c.lruH()[s2i]; } }
        const u32x4 gbv = R.gb;
        { float xc[8];
            const f32x4 cb0 = *(const f32x4*)(p.in[I_ECONVB] + cg0), cb1 = *(const f32x4*)(p.in[I_ECONVB] + cg0 + 4);
            xc[0] = cb0[0]; xc[1] = cb0[1]; xc[2] = cb0[2]; xc[3] = cb0[3]; xc[4] = cb1[0]; xc[5] = cb1[1]; xc[6] = cb1[2]; xc[7] = cb1[3];
#pragma unroll
            for (int j = 0; j < 4; ++j) { float x[8]; unpack8(R.xv[j], x);
                const f32x4 w0 = *(const f32x4*)(p.in[I_ECONVW] + j * 512 + cg0), w1 = *(const f32x4*)(p.in[I_ECONVW] + j * 512 + cg0 + 4);
                xc[0] += w0[0] * x[0]; xc[1] += w0[1] * x[1]; xc[2] += w0[2] * x[2]; xc[3] += w0[3] * x[3];
                xc[4] += w1[0] * x[4]; xc[5] += w1[1] * x[5]; xc[6] += w1[2] * x[6]; xc[7] += w1[3] * x[7]; }
            *(LAS u32x4*)(XA + i * 72 + j8) = pack8(xc);
            *(LAS f32x4*)(XC + i * 64 + j8) = (f32x4){xc[0], xc[1], xc[2], xc[3]}; *(LAS f32x4*)(XC + i * 64 + j8 + 4) = (f32x4){xc[4], xc[5], xc[6], xc[7]}; }
        if (u + nvb < NU) R = lru_load_rows(c, u + nvb, final);
        lds_barrier();
#pragma unroll
        for (int n2 = 0; n2 < 2; ++n2) { const int ni = 2 * (w & 1) + n2; f32x4 gr = (f32x4){0.f, 0.f, 0.f, 0.f}, gi = gr;
#pragma unroll
            for (int k = 0; k < 2; ++k) { const bf16x8 xa = ldfrag(XA, 72, 16 * mi, 32 * k, lane); gr = MFMA16(fwa[n2][k], xa, gr); gi = MFMA16(fwx[n2][k], xa, gi); }
            const int tt = 16 * mi + fr, j = 16 * ni + 4 * fq, cg = 64 * n + j;
            const f32x4 xc4 = *(const LAS f32x4*)(XC + tt * 64 + j), ba = *(const f32x4*)(p.in[I_ELRUBA] + cg), bx = *(const f32x4*)(p.in[I_ELRUBX] + cg), lc = *(const f32x4*)(c.LAMC() + cg);
            f32x4 a4, u4;
#pragma unroll
            for (int r = 0; r < 4; ++r) { const float g_r = fast_sigmoid(gr[r] + ba[r]), g_i = fast_sigmoid(gi[r] + bx[r]);
                const float la = lc[r] * g_r, x2 = 2.0f * la;
                const float em = (x2 > -0.0625f) ? -x2 * (1.0f + x2 * (0.5f + x2 * (0.16666667f + x2 * 0.041666668f))) : 1.0f - __expf(x2);
                a4[r] = la; u4[r] = sqrtf(em) * g_i * xc4[r]; }
            const u32x2 lap = pk4(a4), up_ = pk4(u4); const f32x4 laf = up4(lap); u4 = up4(up_);
#pragma unroll
            for (int r = 0; r < 4; ++r) a4[r] = __expf(laf[r]);
            *(LAS f32x4*)(AA + tt * 64 + j) = a4; *(LAS f32x4*)(UU + tt * 64 + j) = u4;
            if (!c.dry) { *(u32x2*)(c.lruLA(b) + ((size_t)t0 + tt) * 512 + cg) = lap; *(u32x2*)(c.Y() + ((size_t)b * TP + t0 + tt) * 1024 + 512 + cg) = up_; } }
        lds_barrier();
        { const int chn = tid & 63, sg = tid >> 6; float ar[8], ur[8], h = 0.f, ap = 1.f;
#pragma unroll
            for (int q = 0; q < 8; ++q) { ar[q] = AA[(8 * sg + q) * 64 + chn]; ur[q] = UU[(8 * sg + q) * 64 + chn]; h = ar[q] * h + ur[q]; ap *= ar[q]; }
            SEGA[sg * 64 + chn] = ap; SEGH[sg * 64 + chn] = h;
            if (final) {
#pragma unroll
                for (int j = 0; j < 17; ++j) { const bool ok = (17 * sg + j) < ch; const float a2 = ok ? cra[j] : 1.f, h2 = ok ? crh[j] : 0.f; chh = a2 * chh + h2; ca *= a2; }
                CARA[sg * 64 + chn] = ca; CARH[sg * 64 + chn] = chh; }
            lds_barrier();
            const size_t si = ((size_t)b * NCH + ch) * 512 + 64 * n + chn;
            float cin = 0.f;
            if (!final) { if (sg == 7) { float at = 1.f;
#pragma unroll
                    for (int s2 = 0; s2 < 8; ++s2) { cin = SEGA[s2 * 64 + chn] * cin + SEGH[s2 * 64 + chn]; at *= SEGA[s2 * 64 + chn]; }
                    if (!c.dry) { c.lruA()[si] = at; c.lruH()[si] = cin; } } }
            else {
#pragma unroll
                for (int s2 = 0; s2 < 8; ++s2) cin = CARA[s2 * 64 + chn] * cin + CARH[s2 * 64 + chn];
                for (int s2 = 0; s2 < sg; ++s2) cin = SEGA[s2 * 64 + chn] * cin + SEGH[s2 * 64 + chn];
#pragma unroll
                for (int q = 0; q < 8; ++q) { cin = ar[q] * cin + ur[q]; UU[(8 * sg + q) * 64 + chn] = cin; } } }
        lds_barrier();
        if (final) { float g[8], o[8]; unpack8(gbv, g);
#pragma unroll
            for (int q = 0; q < 8; ++q) { const float x = g[q], uu2 = 1.5957691216057308f * (x + 0.044715f * x * x * x); o[q] = UU[i * 64 + j8 + q] * x * fast_sigmoid(uu2); }
            if (!c.dry) *(u32x4*)(c.Y() + ((size_t)b * TP + t) * 1024 + 512 + cg0) = pack8(o);
            lds_barrier(); }
    }
}
struct LruFin { u32x4 la, uu, gb; };
__device__ __forceinline__ LruFin lru_fin_load(const Ctx& c, const int u) {
    const int b = u / (NCH * 8), rem = u % (NCH * 8), ch = rem / 8, n = rem % 8;
    const int i = c.tid >> 3, cg0 = 64 * n + (c.tid & 7) * 8; const size_t t = (size_t)ch * 64 + i;
    LruFin R; R.la = *(const u32x4*)(c.lruLA(b) + t * 512 + cg0); R.uu = *(const u32x4*)(c.Y() + ((size_t)b * TP + t) * 1024 + 512 + cg0); R.gb = *(const u32x4*)(c.P() + ((size_t)b * TP + t) * EVEN_IN + 2304 + cg0);
    return R;
}
__device__ __forceinline__ void lru_final_run(const Ctx& c, const int vb, const int nvb) {
    const int tid = c.tid; const int NU = BATCH * NCH * 8;
    if (vb >= NU) return;
    lfloat* AA = (lfloat*)(c.lds + LDS_PH);
    lfloat* UU = AA + 4096;
    lfloat* SEGA = UU + 4096;
    lfloat* SEGH = SEGA + 512;
    lfloat* CARA = SEGH + 512;
    lfloat* CARH = CARA + 512;
    const int i = tid >> 3, j8 = (tid & 7) * 8, chn = tid & 63, sg = tid >> 6;
    LruFin R = lru_fin_load(c, vb);
    for (int u = vb; u < NU; u += nvb) {
        const int b = u / (NCH * 8), rem = u % (NCH * 8), ch = rem / 8, n = rem % 8, t0 = ch * 64;
        float cra[17], crh[17];
#pragma unroll
        for (int j = 0; j < 17; ++j) { const int c2 = 17 * sg + j, c3 = c2 < NCH ? c2 : NCH - 1; const size_t s2i = ((size_t)b * NCH + c3) * 512 + 64 * n + chn; cra[j] = c.lruA()[s2i]; crh[j] = c.lruH()[s2i]; }
        { float la[8], uu[8]; unpack8(R.la, la); unpack8(R.uu, uu);
            *(LAS f32x4*)(AA + i * 64 + j8) = (f32x4){__expf(la[0]), __expf(la[1]), __expf(la[2]), __expf(la[3])}; *(LAS f32x4*)(AA + i * 64 + j8 + 4) = (f32x4){__expf(la[4]), __expf(la[5]), __expf(la[6]), __expf(la[7])};
            *(LAS f32x4*)(UU + i * 64 + j8) = (f32x4){uu[0], uu[1], uu[2], uu[3]}; *(LAS f32x4*)(UU + i * 64 + j8 + 4) = (f32x4){uu[4], uu[5], uu[6], uu[7]}; }
        const u32x4 gbv = R.gb;
        if (u + nvb < NU) R = lru_fin_load(c, u + nvb);
        lds_barrier();
        { float ar[8], ur[8], h = 0.f, ap = 1.f;
#pragma unroll
            for (int q = 0; q < 8; ++q) { ar[q] = AA[(8 * sg + q) * 64 + chn]; ur[q] = UU[(8 * sg + q) * 64 + chn]; h = ar[q] * h + ur[q]; ap *= ar[q]; }
            SEGA[sg * 64 + chn] = ap; SEGH[sg * 64 + chn] = h;
            float ca = 1.f, chh = 0.f;
#pragma unroll
            for (int j = 0; j < 17; ++j) { const bool ok = (17 * sg + j) < ch; const float a2 = ok ? cra[j] : 1.f, h2 = ok ? crh[j] : 0.f; chh = a2 * chh + h2; ca *= a2; }
            CARA[sg * 64 + chn] = ca; CARH[sg * 64 + chn] = chh;
            lds_barrier();
            float cin = 0.f;
#pragma unroll
            for (int s2 = 0; s2 < 8; ++s2) cin = CARA[s2 * 64 + chn] * cin + CARH[s2 * 64 + chn];
            for (int s2 = 0; s2 < sg; ++s2) cin = SEGA[s2 * 64 + chn] * cin + SEGH[s2 * 64 + chn];
#pragma unroll
            for (int q = 0; q < 8; ++q) { cin = ar[q] * cin + ur[q]; UU[(8 * sg + q) * 64 + chn] = cin; } }
        lds_barrier();
        { float g[8], o[8]; unpack8(gbv, g);
#pragma unroll
            for (int q = 0; q < 8; ++q) { const float x = g[q], uu2 = 1.5957691216057308f * (x + 0.044715f * x * x * x); o[q] = UU[i * 64 + j8 + q] * x * fast_sigmoid(uu2); }
            if (!c.dry) *(u32x4*)(c.Y() + ((size_t)b * TP + t0 + i) * 1024 + 512 + 64 * n + j8) = pack8(o); }
        lds_barrier();
    }
}
__device__ __forceinline__ void ph_lru2(const Ctx& c, const bool final) { lru_run(c, final, c.bid, c.G); }

constexpr int RS = 64 * 72;
__device__ __forceinline__ bool rwkv_s1_task(const int tid, int& q, int& rb) {
    if (tid < 192) { const int g = tid % 24; rb = tid / 24; q = g < 8 ? 24 + g : 32 + g; return true; }
    if (tid < 448) { const int t2 = tid - 192, g = t2 & 31; rb = t2 >> 5; q = g < 24 ? g : 8 + g; return true; }
    q = 0; rb = 0; return false;
}
__device__ __forceinline__ int rwkv_col_of(const int q, const int h) { return q < 8 ? h * 64 + 8 * q : q < 16 ? 512 + h * 64 + 8 * (q - 8) : q < 24 ? 1024 + h * 64 + 8 * (q - 16) : 1536 + 8 * (q - 24); }
__device__ __forceinline__ void rwkv_load_rows(const Ctx& c, const int u, u32x4 (&xv)[9], f32x4 (&mv)[2]) {
    const int b = u / (8 * NCH), h = (u / NCH) % 8, ch = u % NCH, t0 = ch * 64;
    int q, rb;
    if (rwkv_s1_task(c.tid, q, rb)) { const int col = rwkv_col_of(q, h);
        mv[0] = *(const f32x4*)(c.p->in[I_EMU] + col); mv[1] = *(const f32x4*)(c.p->in[I_EMU] + col + 4);
#pragma unroll
        for (int j = 0; j < 9; ++j) { const int t = t0 + 8 * rb - 1 + j; const bool ok = t >= 0 && t < TT;
            const u32x4 x = *(const u32x4*)(c.P() + ((size_t)b * TP + (ok ? t : 0)) * EVEN_IN + col);
            xv[j] = ok ? x : (u32x4){0u, 0u, 0u, 0u}; } }
}
__device__ __forceinline__ void rwkv_prep_unit(const Ctx& c, const int u, u32x4 (&xv)[9], f32x4 (&mv)[2], const int unext) {
    const Params& p = *c.p; const int tid = c.tid, lane = c.lane, w = c.wave;
    const int b = u / (8 * NCH), h = (u / NCH) % 8, ch = u % NCH, t0 = ch * 64;
    lbf* S = (lbf*)(c.lds + LDS_PH);
    lbf *sKK = S, *sBB = S + RS, *sKM = S + 2 * RS, *sV = S + 3 * RS, *sR = S + 4 * RS, *sBh = S + 5 * RS, *sKh = S + 6 * RS, *sVc = S + 7 * RS, *sYA = S + 8 * RS,
        *sP1r = S + 10 * RS, *sP1c = S + 11 * RS, *sMak = S + 12 * RS, *sMrb = S + 13 * RS, *sMrk = S + 14 * RS;
    lfloat* CUM = (lfloat*)(S + 15 * RS);
    lfloat* BON = CUM + 4096;
    lfloat* SEG = BON + 64;
    lfloat* CST = SEG + 512;
    lfloat* A32 = (lfloat*)sP1r;
    lbf* sGD = sYA;
    const int mi = w >> 1, nb2 = 2 * (w & 1);
    const int fr = lane & 15, fq = lane >> 4;
    bf16x8 fDU[2][2], fIU[2][2], fGU[2][4];
#pragma unroll
    for (int n2 = 0; n2 < 2; ++n2) {
#pragma unroll
        for (int k = 0; k < 2; ++k) { fDU[n2][k] = gfrag(c.DUt(), 64, h * 64 + 16 * (nb2 + n2), 32 * k, lane); fIU[n2][k] = gfrag(c.IUt(), 64, h * 64 + 16 * (nb2 + n2), 32 * k, lane); } }
    { int q, rb;
      if (rwkv_s1_task(tid, q, rb)) {
        int col, ld = 72; lbf* dst;
        if (q < 8) { col = h * 64 + 8 * q; dst = sR + 8 * q; }
        else if (q < 16) { col = 512 + h * 64 + 8 * (q - 8); dst = sKM + 8 * (q - 8); }
        else if (q < 24) { col = 1024 + h * 64 + 8 * (q - 16); dst = sV + 8 * (q - 16); }
        else if (q < 32) { col = 1536 + 8 * (q - 24); dst = sBh + 8 * (q - 24); }
        else if (q < 40) { col = 1600 + 8 * (q - 32); dst = sKh + 8 * (q - 32); }
        else { col = 1664 + 8 * (q - 40); dst = sGD + 8 * (q - 40); ld = 136; }
        const bool trans = tid < 192;
        const bool is_tanh = q < 32;
        float m8[8];
        { const f32x4 m0 = mv[0], m1 = mv[1]; m8[0] = m0[0]; m8[1] = m0[1]; m8[2] = m0[2]; m8[3] = m0[3]; m8[4] = m1[0]; m8[5] = m1[1]; m8[6] = m1[2]; m8[7] = m1[3]; }
        const float sc = is_tanh ? -2.0f : -1.0f;
        float pv[8]; unpack8(xv[0], pv);
#pragma unroll
        for (int j = 0; j < 8; ++j) { float x[8]; unpack8(xv[j + 1], x); float o[8];
            const bool valid = (t0 + 8 * rb + j) < TT;
#pragma unroll
            for (int k = 0; k < 8; ++k) { float y = x[k] + m8[k] * (pv[k] - x[k]); pv[k] = x[k];
                if (trans) { const float sg = __builtin_amdgcn_rcpf(1.0f + __expf(sc * y)); y = is_tanh ? 2.0f * sg - 1.0f : sg; }
                o[k] = valid ? y : 0.f; }
            *(LAS u32x4*)(dst + (8 * rb + j) * ld) = pack8(o); } }
      else { const int hl = h * 64 + lane;
        CST[lane] = p.in[I_EKK][hl]; CST[64 + lane] = p.in[I_EKA][hl]; CST[128 + lane] = p.in[I_ERK][hl]; CST[192 + lane] = p.in[I_EDECAY0][hl]; CST[256 + lane] = p.in[I_EICLR0][hl];
        CST[320 + lane] = p.in[I_ELNG][hl]; CST[384 + lane] = p.in[I_ELNB][hl]; } }
    rwkv_load_rows(c, unext < NRU ? unext : NRU - 1, xv, mv);
    lds_barrier();
#pragma unroll
    for (int n2 = 0; n2 < 2; ++n2) { const int ni = nb2 + n2;
        f32x4 aw = (f32x4){0.f, 0.f, 0.f, 0.f}, aa = aw;
#pragma unroll
        for (int k0 = 0; k0 < 64; k0 += 32) { const bf16x8 fw = ldfrag(sBh, 72, 16 * mi, k0, lane), fa = ldfrag(sKh, 72, 16 * mi, k0, lane);
            aw = MFMA16(fDU[n2][k0 >> 5], fw, aw); aa = MFMA16(fIU[n2][k0 >> 5], fa, aa); }
        const int i = 16 * mi + fr, j = 16 * ni + 4 * fq, hj = h * 64 + j;
        const f32x4 d0 = *(const LAS f32x4*)(CST + 192 + j), i0 = *(const LAS f32x4*)(CST + 256 + j);
        f32x4 lw, av;
#pragma unroll
        for (int r = 0; r < 4; ++r) { lw[r] = -0.6065306597126334f * fast_sigmoid(d0[r] + aw[r]);
            av[r] = fast_sigmoid(i0[r] + aa[r]); }
        *(LAS f32x4*)(CUM + i * 64 + j) = lw; *(LAS f32x4*)(A32 + i * 64 + j) = av; }
#pragma unroll
    for (int n2 = 0; n2 < 2; ++n2) {
#pragma unroll
        for (int k = 0; k < 4; ++k) fGU[n2][k] = gfrag(c.GUt(), 128, h * 64 + 16 * (nb2 + n2), 32 * k, lane); }
    lds_barrier();
    { const int i = tid >> 3, j8 = (tid & 7) * 8, hj = h * 64 + j8;
        float k[8], r[8], kx[8], ss = 0.f, bon = 0.f;
        unpack8(*(const LAS u32x4*)(sKM + i * 72 + j8), k); unpack8(*(const LAS u32x4*)(sR + i * 72 + j8), r);
#pragma unroll
        for (int q = 0; q < 8; ++q) { kx[q] = k[q] * CST[j8 + q]; ss += kx[q] * kx[q]; }
        ss = sum8(ss);
        const float inv = 1.0f / fmaxf(sqrtf(ss), 1e-12f);
        float kk[8], km[8], bb[8];
#pragma unroll
        for (int q = 0; q < 8; ++q) { const float a = A32[i * 64 + j8 + q]; kk[q] = kx[q] * inv; km[q] = k[q] * (1.0f + (a - 1.0f) * CST[64 + j8 + q]); bb[q] = kk[q] * a;
            bon += r[q] * km[q] * CST[128 + j8 + q]; }
        bon = sum8(bon);
        *(LAS u32x4*)(sKK + i * 72 + j8) = pack8(kk); *(LAS u32x4*)(sKM + i * 72 + j8) = pack8(km); *(LAS u32x4*)(sBB + i * 72 + j8) = pack8(bb);
        if ((tid & 7) == 0) BON[i] = bon; }
    { const int k = tid & 63, sg = tid >> 6; float run = 0.f;
#pragma unroll
        for (int q = 0; q < 8; ++q) { run += CUM[(8 * sg + q) * 64 + k]; CUM[(8 * sg + q) * 64 + k] = run; }
        SEG[sg * 64 + k] = run; }
    lds_barrier();
#pragma unroll
    for (int n2 = 0; n2 < 2; ++n2) { const int ni = nb2 + n2;
        f32x4 ag = (f32x4){0.f, 0.f, 0.f, 0.f};
#pragma unroll
        for (int k0 = 0; k0 < 128; k0 += 32) ag = MFMA16(fGU[n2][k0 >> 5], ldfrag(sGD, 136, 16 * mi, k0, lane), ag);
        const int i = 16 * mi + fr, j = 16 * ni + 4 * fq, hj = h * 64 + j;
        const f32x4 lg = *(const LAS f32x4*)(CST + 320 + j), lb = *(const LAS f32x4*)(CST + 384 + j), v = up4(*(const LAS u32x2*)(sV + i * 72 + j));
        const float bon = BON[i]; f32x4 e1, e2;
#pragma unroll
        for (int r = 0; r < 4; ++r) { e1[r] = ag[r] * lg[r]; e2[r] = (lb[r] + bon * v[r]) * ag[r]; }
        if (!c.dry) *(u32x2*)(c.Y() + ((size_t)b * TP + t0 + i) * 1024 + hj) = pk4(e1);
        if (!c.dry) *(u32x2*)(c.rwE2() + (size_t)u * 4096 + i * 64 + j) = pk4(e2); }
    { const int k = tid & 63, sg = tid >> 6; float pre = 0.f;
        for (int s2 = 0; s2 < sg; ++s2) pre += SEG[s2 * 64 + k];
#pragma unroll
        for (int q = 0; q < 8; ++q) CUM[(8 * sg + q) * 64 + k] += pre; }
    lds_barrier();
    { const int i = tid >> 3, j8 = (tid & 7) * 8;
        float kk[8], bb[8], km[8], r[8];
        unpack8(*(const LAS u32x4*)(sKK + i * 72 + j8), kk); unpack8(*(const LAS u32x4*)(sBB + i * 72 + j8), bb);
        unpack8(*(const LAS u32x4*)(sKM + i * 72 + j8), km); unpack8(*(const LAS u32x4*)(sR + i * 72 + j8), r);
#pragma unroll
        for (int q = 0; q < 8; ++q) { const float cu = CUM[i * 64 + j8 + q], cp = i > 0 ? CUM[(i - 1) * 64 + j8 + q] : 0.f;
            const float en = __expf(-cu); kk[q] = -kk[q] * __expf(cp); bb[q] *= en; km[q] *= en; r[q] *= __expf(cu); }
        *(LAS u32x4*)(sKK + i * 72 + j8) = pack8(kk); *(LAS u32x4*)(sBB + i * 72 + j8) = pack8(bb);
        *(LAS u32x4*)(sKM + i * 72 + j8) = pack8(km); *(LAS u32x4*)(sR + i * 72 + j8) = pack8(r); }
    lds_barrier();
    { const int k = tid & 63, i8 = (tid >> 6) * 8;
        const float gl = __expf(CUM[63 * 64 + k]);
        float a[8], bh[8], kh[8], v[8];
#pragma unroll
        for (int q = 0; q < 8; ++q) { a[q] = bf2f(sKK[(i8 + q) * 72 + k]); bh[q] = bf2f(sBB[(i8 + q) * 72 + k]) * gl; kh[q] = bf2f(sKM[(i8 + q) * 72 + k]) * gl; v[q] = bf2f(sV[(i8 + q) * 72 + k]); }
        *(LAS u32x4*)(sYA + k * 72 + i8) = pack8(a); *(LAS u32x4*)(sBh + k * 72 + i8) = pack8(bh); *(LAS u32x4*)(sKh + k * 72 + i8) = pack8(kh); *(LAS u32x4*)(sVc + k * 72 + i8) = pack8(v);
        if (i8 == 0) if (!c.dry) c.rwGL()[(size_t)u * 64 + k] = gl; }
    lds_barrier();
    const f32x4 zero4 = (f32x4){0.f, 0.f, 0.f, 0.f};
    for (int tl = w; tl < 16; tl += 8) { const int tm = tl >> 2, tn = tl & 3;
        f32x4 mab = zero4, mabc = zero4, mak = zero4, mrb = zero4, mrk = zero4;
        if (tn <= tm) {
#pragma unroll
            for (int k0 = 0; k0 < 64; k0 += 32) { const bf16x8 fa = ldfrag(sKK, 72, 16 * tm, k0, lane), frr = ldfrag(sR, 72, 16 * tm, k0, lane), fb = ldfrag(sBB, 72, 16 * tn, k0, lane), fk = ldfrag(sKM, 72, 16 * tn, k0, lane);
                mab = MFMA16(fb, fa, mab); mak = MFMA16(fk, fa, mak); mrb = MFMA16(fb, frr, mrb); mrk = MFMA16(fk, frr, mrk);
                mabc = MFMA16(fa, fb, mabc); }
            if (tn == tm) {
#pragma unroll
                for (int r = 0; r < 4; ++r) { const int t = fr, s2 = 4 * fq + r; const bool st = s2 < t, le = s2 <= t;
                    mab[r] = st ? mab[r] : 0.f; mak[r] = st ? mak[r] : 0.f; mrb[r] = le ? mrb[r] : 0.f; mrk[r] = le ? mrk[r] : 0.f;
                    mabc[r] = (fr < 4 * fq + r) ? mabc[r] : 0.f; } } }
        st4(sP1r, 72, 16 * tn, 16 * tm, mab, lane); st4(sMak, 72, 16 * tn, 16 * tm, mak, lane); st4(sMrb, 72, 16 * tn, 16 * tm, mrb, lane); st4(sMrk, 72, 16 * tn, 16 * tm, mrk, lane);
        st4(sP1c, 72, 16 * tm, 16 * tn, mabc, lane); }
    lds_barrier();
    const bool two = mi >= 2;
    { const bf16x8 m0 = ldfrag(sMak, 72, 16 * mi, 0, lane), m1 = ldfrag(sMak, 72, 16 * mi, 32, lane);
#pragma unroll
        for (int n2 = 0; n2 < 2; ++n2) { const int ni = nb2 + n2; f32x4 acc = MFMA16(m0, ldfrag(sVc, 72, 16 * ni, 0, lane), zero4);
            if (two) acc = MFMA16(m1, ldfrag(sVc, 72, 16 * ni, 32, lane), acc);
            st4(sYA + 64 * 72, 72, 16 * mi, 16 * ni, acc, lane); } }
    lds_barrier();
    lbf *Yc = sYA, *Yn = sKM  , *Pr = sP1r, *Pc = sP1c, *P2r = sKK  , *P2c = sBB  ;
    for (int it = 0; it < 6; ++it) {
        const bf16x8 pr0 = ldfrag(Pr, 72, 16 * mi, 0, lane), pr1 = ldfrag(Pr, 72, 16 * mi, 32, lane);
#pragma unroll
        for (int n4 = 0; n4 < 4; ++n4) { const int ni = 4 * (w & 1) + n4;
            f32x4 acc = up4(*(const LAS u32x2*)(Yc + (16 * ni + fr) * 72 + 16 * mi + 4 * fq));
            acc = MFMA16(pr0, ldfrag(Yc, 72, 16 * ni, 0, lane), acc);
            if (two) acc = MFMA16(pr1, ldfrag(Yc, 72, 16 * ni, 32, lane), acc);
            st4(Yn, 72, 16 * mi, 16 * ni, acc, lane); }
        if (it < 5) {
#pragma unroll
            for (int n2 = 0; n2 < 2; ++n2) { const int ni = nb2 + n2;
                if (ni <= mi) { const bf16x8 pc0 = ldfrag(Pc, 72, 16 * ni, 0, lane);
                    f32x4 a1 = MFMA16(pr0, pc0, zero4), a2 = MFMA16(pc0, pr0, zero4);
                    if (two) { const bf16x8 pc1 = ldfrag(Pc, 72, 16 * ni, 32, lane); a1 = MFMA16(pr1, pc1, a1); a2 = MFMA16(pc1, pr1, a2); }
                    st4(P2c, 72, 16 * mi, 16 * ni, a1, lane);
                    st4(P2r, 72, 16 * ni, 16 * mi, a2, lane); }
                else if (it == 0) { st4(P2c, 72, 16 * mi, 16 * ni, zero4, lane); st4(P2r, 72, 16 * ni, 16 * mi, zero4, lane); } }
        }
        lds_barrier();
        { lbf* t1 = Yc; Yc = Yn; Yn = t1; t1 = Pr; Pr = P2r; P2r = t1; t1 = Pc; Pc = P2c; P2c = t1; }
    }
    const lbf* Wc = Yc; const lbf* Uc = Yc + 64 * 72;
    { const bf16x8 fmrb0 = ldfrag(sMrb, 72, 16 * mi, 0, lane), fmrb1 = ldfrag(sMrb, 72, 16 * mi, 32, lane), fmrk0 = ldfrag(sMrk, 72, 16 * mi, 0, lane), fmrk1 = ldfrag(sMrk, 72, 16 * mi, 32, lane);
        const bf16x8 fbh0 = ldfrag(sBh, 72, 16 * mi, 0, lane), fbh1 = ldfrag(sBh, 72, 16 * mi, 32, lane), fkh0 = ldfrag(sKh, 72, 16 * mi, 0, lane), fkh1 = ldfrag(sKh, 72, 16 * mi, 32, lane);
#pragma unroll
        for (int n2 = 0; n2 < 2; ++n2) { const int ni = nb2 + n2;
            const bf16x8 fw0 = ldfrag(Wc, 72, 16 * ni, 0, lane), fw1 = ldfrag(Wc, 72, 16 * ni, 32, lane), fu0 = ldfrag(Uc, 72, 16 * ni, 0, lane), fu1 = ldfrag(Uc, 72, 16 * ni, 32, lane);
            const bf16x8 fv0 = ldfrag(sVc, 72, 16 * ni, 0, lane), fv1 = ldfrag(sVc, 72, 16 * ni, 32, lane);
            f32x4 aq = up4(*(const LAS u32x2*)(sR + (16 * mi + fr) * 72 + 16 * ni + 4 * fq));
            aq = MFMA16(fw0, fmrb0, aq);
            f32x4 ao = MFMA16(fu0, fmrb0, zero4); ao = MFMA16(fv0, fmrk0, ao);
            if (two) { aq = MFMA16(fw1, fmrb1, aq); ao = MFMA16(fu1, fmrb1, ao); ao = MFMA16(fv1, fmrk1, ao); }
            f32x4 ag = MFMA16(fw0, fbh0, zero4); ag = MFMA16(fw1, fbh1, ag);
            f32x4 ah = MFMA16(fbh0, fu0, zero4); ah = MFMA16(fbh1, fu1, ah); ah = MFMA16(fkh0, fv0, ah); ah = MFMA16(fkh1, fv1, ah);
            const size_t ub = (size_t)u * 4096;
            if (!c.dry) { *(u32x2*)(c.rwQE() + ub + (16 * mi + fr) * 64 + 16 * ni + 4 * fq) = pk4(aq);
                *(u32x2*)(c.rwOO() + ub + (16 * mi + fr) * 64 + 16 * ni + 4 * fq) = pk4(ao);
                *(u32x2*)(c.rwGP() + ub + (16 * mi + fr) * 64 + 16 * ni + 4 * fq) = pk4(ag);
                *(u32x2*)(c.rwHC() + ub + (16 * ni + fr) * 64 + 16 * mi + 4 * fq) = pk4(ah); } } }
    lds_barrier();
}

struct RwStage { u32x4 gp, qe, hc, oo, gl; };
__device__ __forceinline__ void rw_stage_load(const Ctx& c, RwStage& S, const size_t ug) {
    const int tid = c.tid; const size_t ub = ug * 8192; const unsigned lo = (unsigned)tid * 16u;
    S.gp = *(const u32x4*)((const char*)c.rwGP() + ub + lo); S.qe = *(const u32x4*)((const char*)c.rwQE() + ub + lo); S.hc = *(const u32x4*)((const char*)c.rwHC() + ub + lo); S.oo = *(const u32x4*)((const char*)c.rwOO() + ub + lo);
    S.gl = *(const u32x4*)((const char*)c.rwGL() + ug * 256 + (lo & 255u));
}
constexpr int RSG_GP = 0, RSG_QE = RS, RSG_HC = 2 * RS, RSG_OO = 3 * RS, RSG_GL = 4 * RS, RSG_SIZE = 4 * RS + 128;
__device__ __forceinline__ void rw_stage_put(lbf* B, const RwStage& S, const int tid) {
    const int o = (tid >> 3) * 72 + (tid & 7) * 8;
    *(LAS u32x4*)(B + RSG_GP + o) = S.gp; *(LAS u32x4*)(B + RSG_QE + o) = S.qe; *(LAS u32x4*)(B + RSG_HC + o) = S.hc; *(LAS u32x4*)(B + RSG_OO + o) = S.oo;
    if (tid < 16) *(LAS u32x4*)(B + RSG_GL + tid * 8) = S.gl;
}
__device__ __forceinline__ void rwkv_seq_unit3(const Ctx& c, const int bh) {
    const int tid = c.tid, lane = c.lane, w = c.wave, fr = lane & 15, fq = lane >> 4, mi = w >> 1, nb2 = 2 * (w & 1);
    lbf* SB = (lbf*)(c.lds + LDS_PH);
    lbf* Zb = SB + 2 * RSG_SIZE;
    f32x4 z[2] = {(f32x4){0.f, 0.f, 0.f, 0.f}, (f32x4){0.f, 0.f, 0.f, 0.f}};
    const size_t u0 = (size_t)bh * NCH;
    RwStage R0, R1;
    rw_stage_load(c, R0, u0); rw_stage_load(c, R1, u0 + 1);
#define RW_STEP(RS_, ch_, s3_) do { const int ch = (ch_); \
        lbf* B = SB + (s3_) * RSG_SIZE; lbf* Zc = Zb + (s3_) * RS; \
        rw_stage_put(B, RS_, tid); \
        _Pragma("unroll") for (int n2 = 0; n2 < 2; ++n2) st4(Zc, 72, 16 * mi, 16 * (nb2 + n2), z[n2], lane); \
        if (ch + 2 < NCH) rw_stage_load(c, RS_, u0 + ch + 2); \
        lds_barrier(); \
        const size_t ub = (u0 + ch) * 4096; \
        const f32x4 gl = *(const LAS f32x4*)((const LAS float*)(B + RSG_GL) + 16 * mi + 4 * fq); \
        const bf16x8 g0 = ldfrag(B + RSG_GP, 72, 16 * mi, 0, lane), g1 = ldfrag(B + RSG_GP, 72, 16 * mi, 32, lane), q0 = ldfrag(B + RSG_QE, 72, 16 * mi, 0, lane), q1 = ldfrag(B + RSG_QE, 72, 16 * mi, 32, lane); \
        _Pragma("unroll") for (int n2 = 0; n2 < 2; ++n2) { const int ni = nb2 + n2; \
            f32x4 a = z[n2] * gl + up4(*(const LAS u32x2*)(B + RSG_HC + (16 * ni + fr) * 72 + 16 * mi + 4 * fq)); \
            f32x4 o = up4(*(const LAS u32x2*)(B + RSG_OO + (16 * mi + fr) * 72 + 16 * ni + 4 * fq)); \
            const bf16x8 fz0 = ldfrag(Zc, 72, 16 * ni, 0, lane), fz1 = ldfrag(Zc, 72, 16 * ni, 32, lane); \
            a = MFMA16(g0, fz0, a); a = MFMA16(g1, fz1, a); o = MFMA16(fz0, q0, o); o = MFMA16(fz1, q1, o); \
            z[n2] = a; \
            int l2 = lane; asm volatile("" : "+v"(l2)); \
            if (!c.dry) *(u32x2*)(c.rwOO() + ub + (16 * mi + (l2 & 15)) * 64 + 16 * ni + 4 * (l2 >> 4)) = pk4(o); } \
    } while (0)
#pragma unroll 1
    for (int ch0 = 0; ch0 + 1 < NCH; ch0 += 2) { RW_STEP(R0, ch0, 0); RW_STEP(R1, ch0 + 1, 1); }
    RW_STEP(R0, NCH - 1, 0);
#undef RW_STEP
    lds_barrier();
}
__device__ __forceinline__ void ph_rwkv_prep(const Ctx& c) {
    if (c.bid >= NRU) return;
    u32x4 xv[9]; f32x4 mv[2];
    rwkv_load_rows(c, c.bid, xv, mv);
    for (int u = c.bid; u < NRU; u += c.G) rwkv_prep_unit(c, u, xv, mv, u + c.G);
}
__device__ __forceinline__ void ph_rwkv_seq(const Ctx& c) {
    if (c.G >= 128) {
        if (c.bid < 64) rwkv_seq_unit3(c, c.bid);
        else { const int vb = c.bid - 64, nvb = c.G - 64;
            lru_final_run(c, vb, nvb);
            filler_A(c, vb, nvb); }
    } else {
        for (int u = c.bid; u < 64; u += c.G) rwkv_seq_unit3(c, u);
        lru_final_run(c, c.bid, c.G);
        filler_A(c, c.bid, c.G);
    }
}
__device__ __forceinline__ void ph_rwkv_post(const Ctx& c) {
    for (int u = c.bid; u < NRU; u += c.G) {
        const int b = u / (8 * NCH), h = (u / NCH) % 8, ch = u % NCH;
        const int i = c.tid >> 3, j8 = (c.tid & 7) * 8;
        float o[8], e1[8], e2[8];
        bf16_t* yp = c.Y() + ((size_t)b * TP + ch * 64 + i) * 1024 + h * 64 + j8;
        unpack8(*(const u32x4*)(c.rwOO() + (size_t)u * 4096 + i * 64 + j8), o); unpack8(*(const u32x4*)yp, e1); unpack8(*(const u32x4*)(c.rwE2() + (size_t)u * 4096 + i * 64 + j8), e2);
        float s1 = 0.f;
#pragma unroll
        for (int q = 0; q < 8; ++q) s1 += o[q];
        s1 = sum8(s1); const float mean = s1 * (1.0f / 64.0f);
        float s2 = 0.f;
#pragma unroll
        for (int q = 0; q < 8; ++q) { const float d = o[q] - mean; s2 += d * d; }
        s2 = sum8(s2); const float rstd = rsqrtf(s2 * (1.0f / 64.0f) + 64e-5f);
        float y[8];
#pragma unroll
        for (int q = 0; q < 8; ++q) y[q] = (o[q] - mean) * rstd * e1[q] + e2[q];
        if (!c.dry) *(u32x4*)yp = pack8(y);
    }
}

constexpr int SELCAP = 1088;
__device__ __forceinline__ void ph_router4(const Ctx& c, const int l) {
    const Params& p = *c.p; const int tid = c.tid, lane = c.lane, w = c.wave, fr = lane & 15, fq = lane >> 4;
    lfloat* PART = (lfloat*)(c.lds + LDS_PH);
    lfloat* SSQ = PART + 8 * 32 * 48;
    lfloat* SROW = SSQ + 256;
    lfloat* LG = SROW + 32;
    lint* sel_e = (lint*)(LG + 32 * 48);
    lfloat* sel_w = (lfloat*)(sel_e + 2 * SELCAP);
    lint* sel_row = (lint*)(sel_w + 2 * SELCAP);
    lint* sel_pos = sel_row + SELCAP;
    lfloat* sel_s = (lfloat*)(sel_pos + 2 * SELCAP);
    lint* lcnt = (lint*)(sel_s + SELCAP);
    lint* gbase = lcnt + 32;
    if (tid < 32) lcnt[tid] = 0;
    const bf16_t* WH = c.WrH() + (size_t)l * 48 * 1024; const bf16_t* WL = c.WrL() + (size_t)l * 48 * 1024;
    const float* bg = p.in[I_MBGROUP] + l * 4; const float* br = p.in[I_MBROUTER] + l * 32;
    bf16x8 bh[3][4], bl[3][4];
#pragma unroll
    for (int ni = 0; ni < 3; ++ni)
#pragma unroll
        for (int ks = 0; ks < 4; ++ks) { bh[ni][ks] = gfrag(WH, 1024, 16 * ni, 128 * w + 32 * ks, lane); bl[ni][ks] = gfrag(WL, 1024, 16 * ni, 128 * w + 32 * ks, lane); }
    const int cb = 128 * w + 8 * fq;
    int nloc = 0;
    u32x4 hN[2][4];
    for (int it = 0;; ++it) {
        const int idx0 = (it * c.G + c.bid) * 32; if (idx0 >= NTOK) break;
        nloc = it * 32 + 32;
#define RT_LOAD(dst_, idx0_) do { _Pragma("unroll") for (int mi_ = 0; mi_ < 2; ++mi_) { const int idx = (idx0_) + 16 * mi_ + fr, idc = idx < NTOK ? idx : NTOK - 1; const int b = idc / TT, t = idc % TT; \
            const bf16_t* hrow = c.H() + (size_t)(b * TP + t) * 1024 + cb; \
            _Pragma("unroll") for (int ks = 0; ks < 4; ++ks) dst_[mi_][ks] = *(const u32x4*)(hrow + 32 * ks); } } while (0)
        u32x4 hC[2][4];
        if (it == 0) RT_LOAD(hN, idx0);
#pragma unroll
        for (int mi = 0; mi < 2; ++mi)
#pragma unroll
            for (int ks = 0; ks < 4; ++ks) hC[mi][ks] = hN[mi][ks];
        RT_LOAD(hN, idx0 + c.G * 32);
#pragma unroll
        for (int mi = 0; mi < 2; ++mi) { float ss = 0.f;
#pragma unroll
            for (int ks = 0; ks < 4; ++ks) { float hb[8]; unpack8(hC[mi][ks], hb);
                ss += hb[0] * hb[0] + hb[1] * hb[1] + hb[2] * hb[2] + hb[3] * hb[3] + hb[4] * hb[4] + hb[5] * hb[5] + hb[6] * hb[6] + hb[7] * hb[7]; }
            ss += __shfl_xor(ss, 16); ss += __shfl_xor(ss, 32);
            if (fq == 0) SSQ[w * 32 + 16 * mi + fr] = ss;
#pragma unroll
            for (int ni = 0; ni < 3; ++ni) { f32x4 acc = (f32x4){0.f, 0.f, 0.f, 0.f};
#pragma unroll
                for (int ks = 0; ks < 4; ++ks) { const bf16x8 ah = __builtin_bit_cast(bf16x8, hC[mi][ks]); acc = MFMA16(ah, bh[ni][ks], acc); acc = MFMA16(ah, bl[ni][ks], acc); }
#pragma unroll
                for (int r = 0; r < 4; ++r) PART[(w * 32 + 16 * mi + 4 * fq + r) * 48 + 16 * ni + fr] = acc[r]; } }
        __syncthreads();
        { const int t = tid >> 4, e3 = tid & 15;
            float ssum = 0.f;
#pragma unroll
            for (int k = 0; k < 8; ++k) ssum += SSQ[k * 32 + t];
            const float s = rsqrtf(ssum * (1.0f / 1024.0f) + 1e-6f);
            if (e3 == 0) SROW[t] = s;
#pragma unroll
            for (int j = 0; j < 3; ++j) { const int e = e3 + 16 * j; float a = 0.f;
#pragma unroll
                for (int k = 0; k < 8; ++k) a += PART[(k * 32 + t) * 48 + e];
                LG[t * 48 + e] = a * s; } }
        __syncthreads();
        if (tid < 32) { const int idx = idx0 + tid, slot = it * 32 + tid;
            if (idx < NTOK) { const lfloat* lg = LG + tid * 48;
                const float g0 = lg[0] + bg[0], g1 = lg[1] + bg[1], g2 = lg[2] + bg[2], g3 = lg[3] + bg[3];
                int gi = 0; float gm = g0; if (g1 > gm) { gm = g1; gi = 1; } if (g2 > gm) { gm = g2; gi = 2; } if (g3 > gm) { gm = g3; gi = 3; }
                const float gprob = 1.0f / (__expf(g0 - gm) + __expf(g1 - gm) + __expf(g2 - gm) + __expf(g3 - gm));
                float el[8];
#pragma unroll
                for (int j = 0; j < 8; ++j) el[j] = lg[4 + gi * 8 + j] + br[gi * 8 + j];
                int i1 = 0; float v1 = el[0];
#pragma unroll
                for (int j = 1; j < 8; ++j) if (el[j] > v1) { v1 = el[j]; i1 = j; }
                int i2 = -1; float v2 = -3.0e38f;
#pragma unroll
                for (int j = 0; j < 8; ++j) if (j != i1 && el[j] > v2) { v2 = el[j]; i2 = j; }
                if (i2 < 0) { i2 = (i1 + 1) & 7; v2 = v1; }
                const float e2 = __expf(v2 - v1), w1 = gprob / (1.0f + e2), w2 = gprob * e2 / (1.0f + e2);
                const int b = idx / TT, t = idx % TT;
                sel_e[slot] = gi * 8 + i1; sel_e[SELCAP + slot] = gi * 8 + i2; sel_w[slot] = w1; sel_w[SELCAP + slot] = w2; sel_row[slot] = b * TP + t; sel_s[slot] = SROW[tid];
            } else sel_row[slot] = -1; }
        __syncthreads();
    }
    __syncthreads();
    for (int sx = tid; sx < nloc; sx += NTHREADS) if (sel_row[sx] >= 0) { sel_pos[sx] = __hip_atomic_fetch_add(&lcnt[sel_e[sx]], 1, __ATOMIC_RELAXED, __HIP_MEMORY_SCOPE_WORKGROUP); sel_pos[SELCAP + sx] = __hip_atomic_fetch_add(&lcnt[sel_e[SELCAP + sx]], 1, __ATOMIC_RELAXED, __HIP_MEMORY_SCOPE_WORKGROUP); }
    __syncthreads();
    if (tid < 32) gbase[tid] = (lcnt[tid] > 0 && !c.dry) ? atomicAdd(&c.mcnt()[l * 32 + tid], lcnt[tid]) : 0;
    __syncthreads();
    for (int sx = tid; sx < nloc; sx += NTHREADS) if (sel_row[sx] >= 0 && !c.dry) {
#pragma unroll
        for (int sl = 0; sl < 2; ++sl) { const int e = sel_e[sl * SELCAP + sx]; const size_t pos = (size_t)e * MCAP + gbase[e] + sel_pos[sl * SELCAP + sx];
            c.mlist()[pos] = sel_row[sx] * 2 + sl; c.mlw()[pos] = sel_w[sl * SELCAP + sx]; c.mls()[pos] = sel_s[sx]; } }
    __syncthreads();
}

__device__ __forceinline__ void ph_combine_norm(const Ctx& c, const float* gain, const int mode) {
    for (int row = c.bid * 8 + c.wave; row < NP; row += c.G * 8) {
        const int b = row / TP, t = row % TP;
        if (t >= TT) { if (mode == 0) { bf16_t* zrow = c.H() + (size_t)row * 1024;
#pragma unroll
                for (int i = 0; i < 4; ++i) if (!c.dry) *(u32x2*)(zrow + 4 * c.lane + 256 * i) = (u32x2){0u, 0u};
                if (c.lane == 0 && !c.dry) c.srow()[row] = 0.f; }
            continue; }
        if (mode == 1 && t < NMETA) continue;
        bf16_t* hrow = c.H() + (size_t)row * 1024; const bf16_t* y0 = c.YM() + (size_t)row * 2048; const bf16_t* y1 = y0 + 1024;
        f32x4 v[4]; float ss = 0.f;
#pragma unroll
        for (int i = 0; i < 4; ++i) { v[i] = up4(*(const u32x2*)(hrow + 4 * c.lane + 256 * i));
            const u32x2 a = *(const u32x2*)(y0 + 4 * c.lane + 256 * i), d = *(const u32x2*)(y1 + 4 * c.lane + 256 * i);
            v[i][0] += bf2f(a.x & 0xffffu) + bf2f(d.x & 0xffffu); v[i][1] += bf2f(a.x >> 16) + bf2f(d.x >> 16);
            v[i][2] += bf2f(a.y & 0xffffu) + bf2f(d.y & 0xffffu); v[i][3] += bf2f(a.y >> 16) + bf2f(d.y >> 16);
            ss += v[i][0] * v[i][0] + v[i][1] * v[i][1] + v[i][2] * v[i][2] + v[i][3] * v[i][3]; }
        ss = wave_sum(ss);
        const float s = rsqrtf(ss * (1.0f / 1024.0f) + 1e-6f);
        float* orow = c.p->out + ((size_t)b * SEQ + (t - NMETA)) * 1024;
        if (mode == 0 && c.lane == 0 && !c.dry) c.srow()[row] = s;
#pragma unroll
        for (int i = 0; i < 4; ++i) {
            if (mode == 0) { if (!c.dry) *(u32x2*)(hrow + 4 * c.lane + 256 * i) = pk4(v[i]); }
            else { const f32x4 g = *(const f32x4*)(gain + 4 * c.lane + 256 * i); f32x4 o; o[0] = v[i][0] * s * g[0]; o[1] = v[i][1] * s * g[1]; o[2] = v[i][2] * s * g[2]; o[3] = v[i][3] * s * g[3]; if (!c.dry) *(f32x4*)(orow + 4 * c.lane + 256 * i) = o; } }
    }
}

__device__ __forceinline__ void moe_table(const Ctx& c, const int l) {
    lint* ts = (lint*)(c.lds + LDS_MISC);
    if (c.tid == 0) { int a = 0; for (int e = 0; e < 32; ++e) { ts[e] = a; a += (c.mcnt()[l * 32 + e] + 255) >> 8; } ts[32] = a; }
    __syncthreads();
}

__device__ __forceinline__ float logsigmoidf_(float x) { return fminf(x, 0.f) - log1pf(__expf(-fabsf(x))); }
__device__ __forceinline__ float fast_logsigmoid(float x) { return fminf(x, 0.f) - __logf(1.0f + __expf(-fabsf(x))); }
struct GlaPrepLoads { u32x4 q0, q1, k0, k1, vv[4], gd; };
__device__ __forceinline__ void gla_prep_load(const Ctx& c, const int u, GlaPrepLoads& L) {
    const int b = u / (4 * NCH), hd = (u / NCH) % 4, ch = u % NCH, tid = c.tid;
    const int i = tid >> 3, j16 = (tid & 7) * 16, d32 = (tid & 7) * 32;
    const bf16_t* rp = c.P() + ((size_t)b * TP + ch * 64 + i) * ODD_IN;
    L.q0 = *(const u32x4*)(rp + hd * 128 + j16); L.q1 = *(const u32x4*)(rp + hd * 128 + j16 + 8);
    L.k0 = *(const u32x4*)(rp + 512 + hd * 128 + j16); L.k1 = *(const u32x4*)(rp + 512 + hd * 128 + j16 + 8);
#pragma unroll
    for (int q = 0; q < 4; ++q) L.vv[q] = *(const u32x4*)(rp + 1024 + hd * 256 + d32 + 8 * q);
    L.gd = *(const u32x4*)(rp + 2048 + 8 * (tid & 1));
}
__device__ __forceinline__ void gla_prep_unit(const Ctx& c, const int u, GlaPrepLoads& L, const int unext) {
    const Params& p = *c.p; const int tid = c.tid, lane = c.lane, w = c.wave, fr = lane & 15, fq = lane >> 4;
    const int b = u / (4 * NCH), hd = (u / NCH) % 4, ch = u % NCH;
    const size_t row0 = (size_t)b * TP + ch * 64;
    lbf* Qr = (lbf*)(c.lds + LDS_PH);
    lbf* Kr = Qr + 64 * 136;
    lbf* KHc = Kr + 64 * 136;
    lbf* Vc = KHc + 128 * 72;
    lbf* Sr = Vc + 256 * 72;
    lfloat* CUM = (lfloat*)(Sr + 64 * 72);
    lbf* Vr = (lbf*)CUM;
    lfloat* GD = CUM + 64 * 128;
    lbf* GDb = (lbf*)GD;
    lfloat* SEG = GD + 1024;
    const float* g_up = p.in[I_OGUP]; const float* g_b = p.in[I_OGB];
    const int i = tid >> 3, j16 = (tid & 7) * 16, d32 = (tid & 7) * 32;
    const u32x4 q0 = L.q0, q1 = L.q1, k0 = L.k0, k1 = L.k1;
    { lbf* GDb_ = (lbf*)GD;
        if ((tid & 7) < 2) *(LAS u32x4*)(GDb_ + i * 32 + 8 * (tid & 7)) = L.gd; else if ((tid & 7) < 4) *(LAS u32x4*)(GDb_ + i * 32 + 8 * (tid & 7)) = (u32x4){0u, 0u, 0u, 0u}; }
    lds_barrier();
    { const int ti = w >> 1;
#pragma unroll
        for (int n4 = 0; n4 < 4; ++n4) { const int ni = 4 * (w & 1) + n4;
            const f32x4 z4 = (f32x4){0.f, 0.f, 0.f, 0.f};
            const f32x4 acc = MFMA16(gfrag(c.GLUt(), 32, hd * 128 + 16 * ni, 0, lane), ldfrag(GDb, 32, 16 * ti, 0, lane), z4);
            const f32x4 gb4 = *(const f32x4*)(g_b + hd * 128 + 16 * ni + 4 * fq); f32x4 la;
#pragma unroll
            for (int r = 0; r < 4; ++r) la[r] = fast_logsigmoid(acc[r] + gb4[r]) * (1.0f / 16.0f);
            *(LAS f32x4*)(CUM + (16 * ti + fr) * 128 + 16 * ni + 4 * fq) = la; } }
    lds_barrier();
    { const int k = tid & 127, sg = tid >> 7; float run = 0.f;
#pragma unroll
        for (int q = 0; q < 16; ++q) { run += CUM[(16 * sg + q) * 128 + k]; CUM[(16 * sg + q) * 128 + k] = run; }
        SEG[sg * 128 + k] = run; }
    lds_barrier();
    { const int k = tid & 127, sg = tid >> 7; float pre = 0.f;
        for (int s2 = 0; s2 < sg; ++s2) pre += SEG[s2 * 128 + k];
        if (sg > 0) {
#pragma unroll
            for (int q = 0; q < 16; ++q) CUM[(16 * sg + q) * 128 + k] += pre; } }
    lds_barrier();
    { float q[16], k[16]; unpack8(q0, q); unpack8(q1, q + 8); unpack8(k0, k); unpack8(k1, k + 8);
#pragma unroll
        for (int e = 0; e < 16; ++e) { const float cu = CUM[i * 128 + j16 + e]; q[e] = q[e] * 0.08838834764831845f * __expf(cu); k[e] = k[e] * __expf(-cu); }
        const u32x4 qa = pack8(q), qb = pack8(q + 8);
        *(LAS u32x4*)(Qr + i * 136 + j16) = qa; *(LAS u32x4*)(Qr + i * 136 + j16 + 8) = qb;
        *(LAS u32x4*)(Kr + i * 136 + j16) = pack8(k); *(LAS u32x4*)(Kr + i * 136 + j16 + 8) = pack8(k + 8);
        bf16_t* wp = c.P() + (row0 + i) * ODD_IN + hd * 128 + j16;
        if (!c.dry) { *(u32x4*)wp = qa; *(u32x4*)(wp + 8) = qb; } }
    float gl = 0.f;
    if (tid < 128) { gl = __expf(CUM[63 * 128 + tid]); if (!c.dry) c.glaG()[(size_t)u * 128 + tid] = gl; }
    lds_barrier();
#pragma unroll
    for (int q = 0; q < 4; ++q) *(LAS u32x4*)(Vr + i * 256 + d32 + 8 * q) = L.vv[q];
    if (unext < BATCH * 4 * NCH) gla_prep_load(c, unext, L);
    if (tid < 128) SEG[tid] = gl;
    { const int ti = w >> 1;
#pragma unroll
        for (int n2 = 0; n2 < 2; ++n2) { const int si = 2 * (w & 1) + n2; f32x4 acc = (f32x4){0.f, 0.f, 0.f, 0.f};
            if (si <= ti) {
#pragma unroll
                for (int kk = 0; kk < 128; kk += 32) acc = MFMA16(ldfrag(Kr, 136, 16 * si, kk, lane), ldfrag(Qr, 136, 16 * ti, kk, lane), acc);
#pragma unroll
                for (int r = 0; r < 4; ++r) { const int t = 16 * ti + fr, s2 = 16 * si + 4 * fq + r; acc[r] = (s2 <= t) ? acc[r] : 0.f; } }
            st4(Sr, 72, 16 * si, 16 * ti, acc, lane); } }
    lds_barrier();
    { const int k = tid & 127, i16 = (tid >> 7) * 16; const float g = SEG[k]; float o[16];
#pragma unroll
        for (int q = 0; q < 16; ++q) o[q] = bf2f(Kr[(i16 + q) * 136 + k]) * g;
        const u32x4 oa = pack8(o), ob = pack8(o + 8);
        bf16_t* gp = c.gKH() + (size_t)u * 8192 + k * 64 + i16;
        if (!c.dry) { *(u32x4*)gp = oa; *(u32x4*)(gp + 8) = ob; } }
    { const int dv = tid & 255, i32 = (tid >> 8) * 32;
        bf16_t* gp = c.gVC() + (size_t)u * 16384 + dv * 64 + i32;
#pragma unroll
        for (int q4 = 0; q4 < 4; ++q4) { u32x4 wv; unsigned t8[8];
#pragma unroll
            for (int q = 0; q < 8; ++q) t8[q] = Vr[(i32 + 8 * q4 + q) * 256 + dv];
            wv.x = t8[0] | (t8[1] << 16); wv.y = t8[2] | (t8[3] << 16); wv.z = t8[4] | (t8[5] << 16); wv.w = t8[6] | (t8[7] << 16);
            *(LAS u32x4*)(Vc + dv * 72 + i32 + 8 * q4) = wv;
            if (!c.dry) *(u32x4*)(gp + 8 * q4) = wv; } }
    lds_barrier();
    { const int ti = w >> 1; const bf16x8 s0 = ldfrag(Sr, 72, 16 * ti, 0, lane), s1 = ldfrag(Sr, 72, 16 * ti, 32, lane);
#pragma unroll
        for (int d8 = 0; d8 < 8; ++d8) { const int di = 8 * (w & 1) + d8; f32x4 acc = (f32x4){0.f, 0.f, 0.f, 0.f};
            acc = MFMA16(ldfrag(Vc, 72, 16 * di, 0, lane), s0, acc); acc = MFMA16(ldfrag(Vc, 72, 16 * di, 32, lane), s1, acc);
            if (!c.dry) *(u32x2*)(c.HN() + (row0 + 16 * ti + fr) * 1024 + hd * 256 + 16 * di + 4 * fq) = pk4(acc); } }
    lds_barrier();
}
__device__ __forceinline__ void ph_gla_prep2(const Ctx& c) {
    if (c.bid >= BATCH * 4 * NCH) return;
    GlaPrepLoads L; gla_prep_load(c, c.bid, L);
    for (int u = c.bid; u < BATCH * 4 * NCH; u += c.G) gla_prep_unit(c, u, L, u + c.G);
}

struct GlaStage4 { u32x4 kh[2], vo, qt[2], gl; };
__device__ __forceinline__ void gla4_stage_load(const Ctx& c, GlaStage4& S, const int bh, const int dq, const int ch) {
    const int tid = c.tid, b = bh >> 2, hd = bh & 3; const size_t ug = (size_t)bh * NCH + ch, r0 = (size_t)b * TP + ch * 64;
    const bf16_t* kb = c.gKH() + ug * 8192;
    S.kh[0] = *(const u32x4*)(kb + tid * 8); S.kh[1] = *(const u32x4*)(kb + 4096 + tid * 8);
    const int t2 = tid & 255;
    const bf16_t* vp = c.gVC() + ug * 16384 + (size_t)(dq * 32) * 64 + t2 * 8;
    const bf16_t* op = c.HN() + (r0 + (t2 >> 2)) * 1024 + hd * 256 + dq * 32 + (t2 & 3) * 8;
    S.vo = *(const u32x4*)(tid < 256 ? vp : op);
    S.qt[0] = *(const u32x4*)(c.P() + (r0 + (tid >> 4)) * ODD_IN + hd * 128 + (tid & 15) * 8); S.qt[1] = *(const u32x4*)(c.P() + (r0 + 32 + (tid >> 4)) * ODD_IN + hd * 128 + (tid & 15) * 8);
    S.gl = *(const u32x4*)(c.glaG() + ug * 128 + (tid & 31) * 4);
}
constexpr int G4_K = 0, G4_V = 128 * 72, G4_Q = G4_V + 32 * 72, G4_O = G4_Q + 64 * 136, G4_G = G4_O + 64 * 40, G4_SIZE = G4_G + 256;
__device__ __forceinline__ void gla4_stage_put(lbf* B, const GlaStage4& S, const int tid) {
    *(LAS u32x4*)(B + G4_K + (tid >> 3) * 72 + (tid & 7) * 8) = S.kh[0]; *(LAS u32x4*)(B + G4_K + (64 + (tid >> 3)) * 72 + (tid & 7) * 8) = S.kh[1];
    const int t2 = tid & 255;
    if (tid < 256) *(LAS u32x4*)(B + G4_V + (t2 >> 3) * 72 + (t2 & 7) * 8) = S.vo; else *(LAS u32x4*)(B + G4_O + (t2 >> 2) * 40 + (t2 & 3) * 8) = S.vo;
    *(LAS u32x4*)(B + G4_Q + (tid >> 4) * 136 + (tid & 15) * 8) = S.qt[0]; *(LAS u32x4*)(B + G4_Q + (32 + (tid >> 4)) * 136 + (tid & 15) * 8) = S.qt[1];
    if (tid < 32) *(LAS u32x4*)(B + G4_G + tid * 8) = S.gl;
}
__device__ __forceinline__ void gla_seq_unit4(const Ctx& c, const int u) {
    const int tid = c.tid, lane = c.lane, w = c.wave, fr = lane & 15, fq = lane >> 4;
    const int bh = u >> 3, dq = u & 7, b = bh >> 2, hd = bh & 3;
    lbf* SB = (lbf*)(c.lds + LDS_PH);
    lbf* Zb = SB + 2 * G4_SIZE;
    f32x4 z[2] = {(f32x4){0.f, 0.f, 0.f, 0.f}, (f32x4){0.f, 0.f, 0.f, 0.f}};
    const int ti = w >> 1, dt = w & 1;
    GlaStage4 R0, R1, R2;
    gla4_stage_load(c, R0, bh, dq, 0); gla4_stage_load(c, R1, bh, dq, 1); gla4_stage_load(c, R2, bh, dq, 2);
#define GLA4_STEP(RS_, ch_) do { const int ch = (ch_); \
        lbf* B = SB + (ch & 1) * G4_SIZE; lbf* Zc = Zb + (ch & 1) * (32 * 136); \
        gla4_stage_put(B, RS_, tid); \
        _Pragma("unroll") for (int d = 0; d < 2; ++d) st4(Zc, 136, 16 * w, 16 * d, z[d], lane); \
        if (ch + 3 < NCH) gla4_stage_load(c, RS_, bh, dq, ch + 3); \
        lds_barrier(); \
        const size_t r0 = (size_t)b * TP + ch * 64; \
        { f32x4 o = up4(*(const LAS u32x2*)(B + G4_O + (16 * ti + fr) * 40 + 16 * dt + 4 * fq)); \
            _Pragma("unroll") for (int k = 0; k < 4; ++k) o = MFMA16(ldfrag(Zc, 136, 16 * dt, 32 * k, lane), ldfrag(B + G4_Q, 136, 16 * ti, 32 * k, lane), o); \
            int l2 = lane; asm volatile("" : "+v"(l2)); \
            if (!c.dry) *(u32x2*)(c.HN() + (r0 + 16 * ti + (l2 & 15)) * 1024 + hd * 256 + dq * 32 + 16 * dt + 4 * (l2 >> 4)) = pk4(o); } \
        { const f32x4 gl = *(const LAS f32x4*)((const LAS float*)(B + G4_G) + 16 * w + 4 * fq); \
            const bf16x8 k0 = ldfrag(B + G4_K, 72, 16 * w, 0, lane), k1 = ldfrag(B + G4_K, 72, 16 * w, 32, lane); \
            _Pragma("unroll") for (int d = 0; d < 2; ++d) { f32x4 a = z[d] * gl; a = MFMA16(k0, ldfrag(B + G4_V, 72, 16 * d, 0, lane), a); a = MFMA16(k1, ldfrag(B + G4_V, 72, 16 * d, 32, lane), a); z[d] = a; } } \
    } while (0)
#pragma unroll 1
    for (int ch0 = 0; ch0 < NCH; ch0 += 3) { GLA4_STEP(R0, ch0); GLA4_STEP(R1, ch0 + 1); GLA4_STEP(R2, ch0 + 2); }
#undef GLA4_STEP
    lds_barrier();
}
__device__ __forceinline__ void ph_gla_seq2(const Ctx& c) {
    for (int v = c.bid; v < BATCH * 4 * 8; v += c.G) { const int xcd = v & 7, slot = v >> 3; const int u = ((xcd * 4 + (slot >> 3)) << 3) | (slot & 7); gla_seq_unit4(c, u); }
}
__device__ __forceinline__ void ph_gla_finish(const Ctx& c) {
    const Params& p = *c.p; const float* hg = p.in[I_OHEADGAIN];
    for (int row = c.bid * 8 + c.wave; row < NP; row += c.G * 8) {
        const bf16_t* op = c.HN() + (size_t)row * 1024 + 16 * c.lane; const bf16_t* rp = c.P() + (size_t)row * ODD_IN + 2064 + 16 * c.lane;
        float o[16], r[16];
        unpack8(*(const u32x4*)op, o); unpack8(*(const u32x4*)(op + 8), o + 8); unpack8(*(const u32x4*)rp, r); unpack8(*(const u32x4*)(rp + 8), r + 8);
        float ss = 0.f;
#pragma unroll
        for (int q = 0; q < 16; ++q) ss += o[q] * o[q];
        ss += __shfl_xor(ss, 1); ss += __shfl_xor(ss, 2); ss += __shfl_xor(ss, 4); ss += __shfl_xor(ss, 8);
        const float inv = rsqrtf(ss * (1.0f / 256.0f) + 1e-6f); float y[16];
#pragma unroll
        for (int q = 0; q < 16; ++q) y[q] = o[q] * inv * hg[16 * c.lane + q] * (r[q] / (1.0f + __expf(-r[q])));
        bf16_t* yp = c.Y() + (size_t)row * 1024 + 16 * c.lane;
        if (!c.dry) *(u32x4*)yp = pack8(y); if (!c.dry) *(u32x4*)(yp + 8) = pack8(y + 8);
    }
}

constexpr int N_PHASES = 19;
__global__ void __launch_bounds__(NTHREADS, 2) fwd(const Params p, const int lo, const int hi, const int probe) {
    extern __shared__ __attribute__((aligned(16))) unsigned char smem[];
    Ctx c; c.p = &p; c.lds = (LAS unsigned char*)smem; c.tid = threadIdx.x; c.lane = c.tid & 63; c.wave = __builtin_amdgcn_readfirstlane(c.tid >> 6); c.G = gridDim.x; c.bid = blockIdx.x; c.dry = 0;
    unsigned char* ws = p.ws;
    c.ws = ws; c.dsc = (unsigned char*)p.out;
    LAS unsigned char* glds = c.lds + LDS_PH;

    if (c.tid < 4) ((volatile LAS unsigned*)smem)[c.tid] = 0u;
    __syncthreads();
    XcdBarrier bar; bar.bar = (unsigned*)(ws + WS_CTL); bar.x = 0; bar.st = (volatile LAS unsigned*)smem;
    if (hi - lo > 1) bar = xcd_barrier_post((unsigned*)(ws + WS_CTL), (volatile LAS unsigned*)smem);
#ifndef PHMASK
#define PHMASK 0x7FFFF
#endif
#define IN(k) (((PHMASK >> (k)) & 1) && lo <= (k) && (k) < hi)
#define SEAM(k) do { if (IN(k) && IN((k) + 1)) xcd_barrier(bar); } while (0)
#if PROBE_MASK
#define RUN(k, ...) do { if (IN(k)) { if ((PROBE_MASK >> (k)) & 1) { for (int rep = ((probe >> (k)) & 1) ? 0 : 1; rep < 2; ++rep) { c.dry = (rep == 0); __VA_ARGS__; } } else { c.dry = 0; __VA_ARGS__; } } } while (0)
#else
#define RUN(k, ...) do { if (IN(k)) { __VA_ARGS__; } } while (0)
#endif

    RUN(0, ph_prologue(c));
    SEAM(0);
    if ((probe >> 30) & 1) { for (int k = 0; k < 16; ++k) xcd_barrier(bar); }
    if (IN(1)) { pg8::DenseOrder S; S.init(NP, EVEN_IN, 1024, c.WinE(), c.G, c.bid); pg8::EpiStoreBf16T<true, false> E{c.P(), EVEN_IN, EVEN_IN, c.dry, c.srow(), nullptr};
        pg8::gemm_phase(glds, (const char*)c.XB(), 1024, S, E); }
    SEAM(1);
    RUN(2, { ph_rwkv_prep(c); ph_lru2(c, false); });
    SEAM(2);
    RUN(3, ph_rwkv_seq(c));
    SEAM(3);
    RUN(4, ph_rwkv_post(c));
    SEAM(4);
    if (IN(5)) { pg8::DenseOrder S; S.init(NP, 1024, 1024, c.WoutE(), c.G, c.bid); pg8::EpiStoreBf16T<false, true> E{c.H(), 1024, 1024, c.dry, nullptr, c.XB()};
        pg8::gemm_phase(glds, (const char*)c.Y(), 1024, S, E); }
    SEAM(5);
    RUN(6, ph_router4(c, 0));
    SEAM(6);
    if (IN(7)) { moe_table(c, 0);
        pg8::MoeOrder S{(const LAS int*)(glds + 131072), c.mcnt(), c.mlist(), (const char*)c.W1(), (size_t)512 * 1024 * 2, 2, c.G, c.bid, 1024, 1}; pg8::EpiSwiglu E{c.HID(), c.dry, c.mls()};
        pg8::gemm_phase(glds, (const char*)c.H(), 1024, S, E); }
    SEAM(7);
    if (IN(8)) { moe_table(c, 0);
        pg8::MoeOrder S{(const LAS int*)(glds + 131072), c.mcnt(), c.mlist(), (const char*)c.W2(), (size_t)1024 * 256 * 2, 4, c.G, c.bid, 256, 0}; pg8::EpiScatter E{c.YM(), c.mlist(), c.mlw(), c.dry};
        pg8::gemm_phase(glds, (const char*)c.HID(), 256, S, E); }
    SEAM(8);
    RUN(9, ph_combine_norm(c, p.in[I_ONORM], 0));
    SEAM(9);
    if (IN(10)) { pg8::DenseOrder S; S.init(NP, ODD_IN_PAD, 1024, c.WinO(), c.G, c.bid); pg8::EpiStoreBf16T<true, false> E{c.P(), ODD_IN, ODD_IN, c.dry, c.srow(), nullptr};
        pg8::gemm_phase(glds, (const char*)c.H(), 1024, S, E); }
    SEAM(10);
    RUN(11, ph_gla_prep2(c));
    SEAM(11);
    RUN(12, ph_gla_seq2(c));
    SEAM(12);
    RUN(13, { ph_gla_finish(c); filler_B(c, c.bid, c.G); });
    SEAM(13);
    if (IN(14)) { pg8::DenseOrder S; S.init(NP, 1024, 1024, c.WoutO(), c.G, c.bid); pg8::EpiStoreBf16T<false, true> E{c.H(), 1024, 1024, c.dry, nullptr, c.H()};
        pg8::gemm_phase(glds, (const char*)c.Y(), 1024, S, E); }
    SEAM(14);
    RUN(15, ph_router4(c, 1));
    SEAM(15);
    if (IN(16)) { moe_table(c, 1);
        pg8::MoeOrder S{(const LAS int*)(glds + 131072), c.mcnt() + 32, c.mlist(), (const char*)(c.W1() + (size_t)32 * 512 * 1024), (size_t)512 * 1024 * 2, 2, c.G, c.bid, 1024, 1}; pg8::EpiSwiglu E{c.HID(), c.dry, c.mls()};
        pg8::gemm_phase(glds, (const char*)c.H(), 1024, S, E); }
    SEAM(16);
    if (IN(17)) { moe_table(c, 1);
        pg8::MoeOrder S{(const LAS int*)(glds + 131072), c.mcnt() + 32, c.mlist(), (const char*)(c.W2() + (size_t)32 * 1024 * 256), (size_t)1024 * 256 * 2, 4, c.G, c.bid, 256, 0}; pg8::EpiScatter E{c.YM(), c.mlist(), c.mlw(), c.dry};
        pg8::gemm_phase(glds, (const char*)c.HID(), 256, S, E); }
    SEAM(17);
    RUN(18, ph_combine_norm(c, p.in[I_FINALNORM], 1));
#undef IN
#undef SEAM
#undef RUN
}

extern "C" void kernel_launch(void* const* d_in, const int* in_sizes, int n_in, void* d_out, int out_size, void* d_ws, size_t ws_size, hipStream_t stream) {
    static int grid = 0;
    if (grid == 0) {
        if (n_in != 38 || ws_size < WS_END) { fprintf(stderr, "kernel_launch: unexpected n_in %d or ws_size %zu (< %zu)\n", n_in, ws_size, (size_t)WS_END); grid = -1; return; }
        int dev = 0, cus = 0, per_cu = 0;
        if (hipGetDevice(&dev) != hipSuccess || hipDeviceGetAttribute(&cus, hipDeviceAttributeMultiprocessorCount, dev) != hipSuccess) { grid = -1; return; }
        if (hipFuncSetAttribute((const void*)fwd, hipFuncAttributeMaxDynamicSharedMemorySize, LDS_BYTES) != hipSuccess) { fprintf(stderr, "kernel_launch: hipFuncSetAttribute failed\n"); grid = -1; return; }
        if (hipOccupancyMaxActiveBlocksPerMultiprocessor(&per_cu, (const void*)fwd, NTHREADS, LDS_BYTES) != hipSuccess || per_cu < 1) fprintf(stderr, "kernel_launch: occupancy query says %d\n", per_cu);
        (void)hipGetLastError();
        grid = cus;
    }
    if (grid < 0) return;
    (void)hipMemsetAsync((char*)d_ws + WS_CTL, 0, 32768, stream);
    Params p{};
    for (int i = 0; i < 38; ++i) p.in[i] = (const float*)d_in[i];
    p.out = (float*)d_out; p.ws = (unsigned char*)d_ws;
#if ONE_LAUNCH
    hipLaunchKernelGGL(fwd, dim3(grid), dim3(NTHREADS), LDS_BYTES, stream, p, 0, N_PHASES, (int)PROBE_MASK);
#else
    for (int k = 0; k < N_PHASES; ++k) hipLaunchKernelGGL(fwd, dim3(grid), dim3(NTHREADS), LDS_BYTES, stream, p, k, k + 1, (int)PROBE_MASK);
#endif
}
```

```cpp
#include <hip/hip_runtime.h>
#include <stdint.h>
#include <stdio.h>

typedef unsigned short bf16_t;
typedef short bf16x8 __attribute__((ext_vector_type(8)));
typedef float f32x4 __attribute__((ext_vector_type(4)));
typedef unsigned u32x4 __attribute__((ext_vector_type(4)));
typedef unsigned u32x2 __attribute__((ext_vector_type(2)));
#define LAS __attribute__((address_space(3)))
typedef LAS float lfloat;
typedef LAS int lint;

#ifndef PROBE_MASK
#define PROBE_MASK 0
#endif
#ifndef ONE_LAUNCH
#define ONE_LAUNCH 1
#endif

constexpr int BATCH = 8, SEQ = 8192, DM = 1024, NMETA = 16, TT = SEQ + NMETA  , TP = 8256  , NP = BATCH * TP  , NTOK = BATCH * TT;
constexpr int NCH = TP / 64;
constexpr int EVEN_IN = 2816, ODD_IN = 3088, ODD_IN_PAD = 3328;
constexpr int MCAP = 65792;
constexpr int NTHREADS = 512;
constexpr int LDS_BYTES = 161792;
constexpr int LDS_PH = 64;
constexpr int LDS_MISC = 64 + 131072;

constexpr size_t WS_CTL = 0;
constexpr size_t WS_H = 32768;
constexpr size_t WS_P = WS_H + (size_t)NP * 1024 * 4;
constexpr size_t WS_Y = WS_P + (size_t)NP * ODD_IN * 2;
constexpr size_t WS_HN = WS_Y + (size_t)NP * 1024 * 2;
constexpr size_t WS_WINE = WS_HN + (size_t)NP * 1024 * 2;
constexpr size_t WS_WOUTE = WS_WINE + (size_t)EVEN_IN * 1024 * 2;
constexpr size_t WS_WINO = WS_WOUTE + (size_t)1024 * 1024 * 2;
constexpr size_t WS_WOUTO = WS_WINO + (size_t)ODD_IN_PAD * 1024 * 2;
constexpr size_t WS_W1 = WS_WOUTO + (size_t)1024 * 1024 * 2;
constexpr size_t WS_W2 = WS_W1 + (size_t)2 * 32 * 512 * 1024 * 2;
constexpr size_t WS_WRT = WS_W2 + (size_t)2 * 32 * 1024 * 256 * 2;
constexpr size_t WS_DUT = WS_WRT + (size_t)2 * 36 * 1024 * 4;
constexpr size_t WS_IUT = WS_DUT + 512 * 64 * 2;
constexpr size_t WS_GUT = WS_IUT + 512 * 64 * 2;
constexpr size_t WS_WAT = WS_GUT + 512 * 128 * 2;
constexpr size_t WS_WXT = WS_WAT + 8 * 4096 * 2;
constexpr size_t WS_LAMC = WS_WXT + 8 * 4096 * 2;
constexpr size_t WS_WRH = WS_LAMC + 512 * 4;
constexpr size_t WS_WRL = WS_WRH + (size_t)2 * 48 * 1024 * 2;
constexpr size_t WS_GLU = WS_WRL + (size_t)2 * 48 * 1024 * 2;
constexpr size_t WS_SROW = WS_GLU + 512 * 32 * 2;
constexpr size_t WS_END = WS_SROW + (size_t)NP * 4;
constexpr size_t PO_YM = 0;
constexpr size_t PO_HID = (size_t)2 * NP * 1024 * 2;
constexpr size_t PO_LIST = PO_HID + (size_t)(2 * NTOK + 32 * 256) * 256 * 2;
constexpr size_t PO_LW = PO_LIST + (size_t)32 * MCAP * 4;
constexpr size_t PO_LS = PO_LW + (size_t)32 * MCAP * 4;
constexpr size_t PO_END = PO_LS + (size_t)32 * MCAP * 4;
static_assert(PO_END <= (size_t)NP * EVEN_IN * 2, "MoE scratch must fit the P region");
constexpr size_t DO_LRUA = 0;
constexpr size_t DO_LRUH = DO_LRUA + (size_t)BATCH * NCH * 512 * 4;
constexpr size_t DO_LRUC = DO_LRUH + (size_t)BATCH * NCH * 512 * 4;
constexpr size_t DO_GLAG = DO_LRUC + (size_t)BATCH * NCH * 512 * 4;
constexpr int NRU = BATCH * 8 * NCH;
constexpr size_t DO_RWHC = DO_GLAG + (size_t)BATCH * 4 * NCH * 128 * 4;
constexpr size_t DO_RWOO = DO_RWHC + (size_t)NRU * 4096 * 2;
constexpr size_t DO_RWE2 = DO_RWOO + (size_t)NRU * 4096 * 2;
constexpr size_t DO_RWGL = DO_RWE2 + (size_t)NRU * 4096 * 2;
constexpr size_t DO_END = DO_RWGL + (size_t)NRU * 64 * 4;
constexpr size_t LRU_LA_HALF = (size_t)4 * TP * 512 * 2;
static_assert(DO_END + LRU_LA_HALF <= (size_t)BATCH * SEQ * DM * 4, "d_out scratch");
static_assert((size_t)NP * EVEN_IN * 2 + LRU_LA_HALF <= (size_t)NP * ODD_IN * 2, "log a of batches 0-3 sits in the tail of the P region during the even layer");

#define XB_TMO      128
#define XB_XCNT(j)  (256  + 64 * (j))
#define XB_XSUB(j)  (1280 + 64 * (j))
#define XB_XGEN(j)  (2304 + 64 * (j))
#define XB_TOP      3328
#define XB_TOPGEN   3392
#define XCD_BAR_WORDS 3456
#define XB_SPIN_CAP (1u << 22)

__device__ __forceinline__ unsigned xb_ld(unsigned* p)              { return __hip_atomic_load(p, __ATOMIC_RELAXED, __HIP_MEMORY_SCOPE_AGENT); }
__device__ __forceinline__ unsigned xb_add(unsigned* p, unsigned v) { return __hip_atomic_fetch_add(p, v, __ATOMIC_RELAXED, __HIP_MEMORY_SCOPE_AGENT); }
__device__ __forceinline__ unsigned xb_xcc_id() { return (unsigned)__builtin_amdgcn_s_getreg((3 << 11) | 20) & 0xFu; }
#define XB_SPIN(cond, bar) do { unsigned _sp = 0; while (cond) { __builtin_amdgcn_s_sleep(1); \
    if ((++_sp & 255u) == 0u) { if (xb_ld(&(bar)[XB_TMO])) break; if (_sp > XB_SPIN_CAP) { atomicAdd(&(bar)[XB_TMO], 1u); break; } } } } while (0)

__device__ __forceinline__ int lane_now() { unsigned l; asm volatile("v_mbcnt_lo_u32_b32 %0, -1, 0\n\tv_mbcnt_hi_u32_b32 %0, -1, %0" : "=v"(l)); return (int)l; }
struct XcdBarrier { unsigned* bar; unsigned x; volatile LAS unsigned* st; int wave; };

__device__ __forceinline__ XcdBarrier xcd_barrier_post(unsigned* bar, volatile LAS unsigned* st) {
    XcdBarrier b; b.bar = bar; b.x = xb_xcc_id(); b.st = st; b.wave = __builtin_amdgcn_readfirstlane(threadIdx.x >> 6);
    if (threadIdx.x == 0) (void)xb_add(&bar[XB_XCNT(b.x)], 1u);
    return b;
}
__device__ __forceinline__ void xcd_barrier_complete(unsigned* bar, unsigned x, unsigned& nloc, unsigned& nx) {
    const unsigned G = gridDim.x * gridDim.y * gridDim.z;
    unsigned sum, cnt, mine, sp = 0u;
    for (;;) {
        sum = 0u; cnt = 0u; mine = 0u;
#pragma unroll
        for (unsigned j = 0; j < 16; ++j) { const unsigned c = xb_ld(&bar[XB_XCNT(j)]); sum += c; cnt += (c > 0u) ? 1u : 0u; mine = (j == x) ? c : mine; }
        if (sum == G) break;
        __builtin_amdgcn_s_sleep(1);
        if ((++sp & 255u) == 0u) { if (xb_ld(&bar[XB_TMO])) break; if (sp > XB_SPIN_CAP) { atomicAdd(&bar[XB_TMO], 1u); break; } }
    }
    nloc = mine > 0u ? mine : 1u; nx = cnt > 0u ? cnt : 1u;
}
__device__ __forceinline__ void xcd_barrier(const XcdBarrier& b) {
    asm volatile("s_waitcnt vmcnt(0)" ::: "memory");
    __syncthreads();
    if (b.wave == 0 && lane_now() == 0) {
        unsigned* bar = b.bar;
        __builtin_amdgcn_s_waitcnt(0);
        unsigned nloc = b.st[0], nx = b.st[1];
        if (nloc == 0u) { xcd_barrier_complete(bar, b.x, nloc, nx); b.st[0] = nloc; b.st[1] = nx; }
        const unsigned old = xb_add(&bar[XB_XSUB(b.x)], 1u);
        const unsigned gen = old / nloc;
        if (old + 1u == (gen + 1u) * nloc) {
            __builtin_amdgcn_fence(__ATOMIC_RELEASE, "agent");
            asm volatile("s_waitcnt vmcnt(0)" ::: "memory");
            const unsigned og = xb_add(&bar[XB_TOP], 1u);
            const unsigned tg = og / nx;
            if (og + 1u == (tg + 1u) * nx) xb_add(&bar[XB_TOPGEN], 1u);
            else XB_SPIN(xb_ld(&bar[XB_TOPGEN]) == tg, bar);
            __builtin_amdgcn_fence(__ATOMIC_ACQUIRE, "agent");
            xb_add(&bar[XB_XGEN(b.x)], 1u);
            asm volatile("s_waitcnt vmcnt(0)" ::: "memory");
        } else {
            XB_SPIN(xb_ld(&bar[XB_XGEN(b.x)]) == gen, bar);
            __builtin_amdgcn_fence(__ATOMIC_ACQUIRE, "agent");
            asm volatile("s_waitcnt vmcnt(0)" ::: "memory");
        }
    }
    __syncthreads();
}

struct Params {
    const float* in[38];
    float* out;
    unsigned char* ws;
};
enum { I_X = 0, I_META, I_ENORM, I_EWIN, I_EMU, I_EDECAY0, I_EDECAYUP, I_EICLR0, I_EICLRUP, I_EGATEUP, I_EKK, I_EKA, I_ERK, I_ELNG, I_ELNB,
       I_ECONVW, I_ECONVB, I_ELRUWA, I_ELRUBA, I_ELRUWX, I_ELRUBX, I_ELAMBDA, I_EWOUT, I_ONORM, I_OWIN, I_OGUP, I_OGB, I_OHEADGAIN, I_OWOUT,
       I_MNORM, I_MWGROUP, I_MBGROUP, I_MWROUTER, I_MBROUTER, I_MWGATE, I_MWUP, I_MWDOWN, I_FINALNORM };

__device__ __forceinline__ bf16_t f2bf(float f) { unsigned u = __float_as_uint(f); u += 0x7FFFu + ((u >> 16) & 1u); return (bf16_t)(u >> 16); }
__device__ __forceinline__ float bf2f(unsigned b) { return __uint_as_float(b << 16); }
typedef __bf16 bf16v2 __attribute__((ext_vector_type(2)));
__device__ __forceinline__ unsigned pack2(float lo, float hi) { bf16v2 v; v.x = (__bf16)lo; v.y = (__bf16)hi; return __builtin_bit_cast(unsigned, v); }
__device__ __forceinline__ void unpack8(const u32x4 v, float* o) {
    o[0] = bf2f(v.x & 0xffffu); o[1] = bf2f(v.x >> 16); o[2] = bf2f(v.y & 0xffffu); o[3] = bf2f(v.y >> 16);
    o[4] = bf2f(v.z & 0xffffu); o[5] = bf2f(v.z >> 16); o[6] = bf2f(v.w & 0xffffu); o[7] = bf2f(v.w >> 16);
}
__device__ __forceinline__ u32x4 pack8(const float* o) { u32x4 w; w.x = pack2(o[0], o[1]); w.y = pack2(o[2], o[3]); w.z = pack2(o[4], o[5]); w.w = pack2(o[6], o[7]); return w; }
__device__ __forceinline__ float wave_sum(float v) {
#pragma unroll
    for (int o = 32; o > 0; o >>= 1) v += __shfl_xor(v, o);
    return v;
}
__device__ __forceinline__ float sum8(float v) { v += __shfl_xor(v, 1); v += __shfl_xor(v, 2); v += __shfl_xor(v, 4); return v; }
__device__ __forceinline__ float sigmoidf_(float x) { return 1.0f / (1.0f + __expf(-x)); }
__device__ __forceinline__ float softplusf_(float x) { return fmaxf(x, 0.f) + log1pf(__expf(-fabsf(x))); }

__device__ __forceinline__ void lds_barrier() { asm volatile("s_waitcnt lgkmcnt(0)" ::: "memory"); __builtin_amdgcn_s_barrier(); asm volatile("" ::: "memory"); }
namespace pg8 {
__device__ __forceinline__ float bf2f_(unsigned v) { return __builtin_bit_cast(float, v << 16); }
constexpr int BM = 256, BK = 64, HALF = 128, HTB = HALF * BK * 2, STAGE_BYTES = 8 * HTB;
__device__ __forceinline__ int lds_byte(int r, int c) { const int st = (r >> 4) * 2 + (c >> 5), rr = r & 15, cc = c & 31, ob = rr * 64 + cc * 2; return st * 1024 + (ob ^ (((ob >> 9) & 1) << 5)); }
__device__ __forceinline__ void stage_rc(int b, int& R, int& C) { const int st = b / 1024, sb = b % 1024, swz = sb ^ (((sb >> 9) & 1) << 5); R = (st >> 1) * 16 + swz / 64; C = (st & 1) * 32 + (swz % 64) / 2; }
__device__ __forceinline__ int perm32(int rho) { const int n = rho >> 4, i = rho & 15; return 8 * (i >> 2) + 4 * n + (i & 3); }
__device__ __forceinline__ unsigned cvt_pk_bf16(float lo, float hi) { return pack2(lo, hi); }

struct Unit { const char* b; int row0, col0, cnt, lrow; };

struct DenseOrder {
    static constexpr bool GATHER = false;
    int nM, nN, nwg, G, c, K; const char* Bt;
    __device__ void init(int M, int N, int K_, const void* Bt_, int G_, int c_) { nM = M / BM; nN = N / BM; nwg = nM * nN; G = G_; c = c_; K = K_; Bt = (const char*)Bt_; }
    __device__ __forceinline__ bool next(int i, Unit& u) const {
        const long L = (long)i * G + c; if (L >= nwg) return false;
        int wgid = (int)L; { const int q = nwg / 8, r = nwg % 8, xcd = wgid % 8, off = wgid / 8; wgid = (xcd < r ? xcd * (q + 1) : r * (q + 1) + (xcd - r) * q) + off; }
        const int nig = 8 * nN, gid = wgid / nig, fm = gid * 8, gsz = (nM - fm) < 8 ? (nM - fm) : 8;
        const int pm = fm + ((wgid % nig) % gsz), pn = (wgid % nig) / gsz;
        u.row0 = pm * BM; u.col0 = pn * BM; u.b = Bt + (size_t)pn * BM * K * 2; u.cnt = BM; u.lrow = 0; return true;
    }
    __device__ __forceinline__ unsigned arow(const Unit& u, int r) const { return (unsigned)(u.row0 + r); }
};
template <bool GATHER_> struct MoeOrderT {
    static constexpr bool GATHER = GATHER_;
    const LAS int* tstart; const int* cnt; const int* list; const char* W; size_t wstride; int npn, G, c, K, gather;
    __device__ __forceinline__ bool next(int i, Unit& u) const {
        const int L = i * G + c; const int total = tstart[32] * npn; if (L >= total) return false;
        const int grp = 8 * npn, g0 = L / grp, gr = L - g0 * grp; int tile = 8 * g0 + (gr & 7), pn = gr >> 3;
        const int ntile = tstart[32]; if (8 * g0 + 8 > ntile) { const int Lr = L - g0 * grp; tile = 8 * g0 + Lr / npn; pn = Lr - (Lr / npn) * npn; }
        const int ln = lane_now(); const int tv = tstart[ln & 31];
        const int e = __popcll(__ballot(ln < 32 && tv <= tile)) - 1;
        const int j = tile - tstart[e];
        int c2 = tstart[33 + e] - 256 * j; u.cnt = c2 > 256 ? 256 : c2; u.lrow = e * MCAP + 256 * j; u.row0 = tile * 256; u.col0 = pn * 256;
        u.b = W + (size_t)e * wstride + (size_t)pn * 256 * K * 2; return true;
    }
    __device__ __forceinline__ unsigned arow(const Unit& u, int r) const {
        if (GATHER) { const int v = list[u.lrow + (r < u.cnt ? r : 0)]; return (r < u.cnt) ? (unsigned)(v >> 1) : 0u; }
        return (unsigned)(u.row0 + r);
    }
};

template <bool RS, bool RES> struct EpiStoreBf16T {
    static constexpr bool PERM = true;
    bf16_t* O; int ldc; int ncols; int dry; const float* rs; const bf16_t* res;
    __device__ __forceinline__ void stage(const Unit& u, LAS unsigned char* tab, int wid, int lane) const {
        if (RS && wid < 4) __builtin_amdgcn_global_load_lds((const unsigned*)((const char*)(rs + u.row0 + wid * 64) + (unsigned)lane * 4u), (LAS unsigned*)(tab + wid * 256), 4, 0, 0); }
    __device__ __forceinline__ void operator()(const f32x4 (&acc)[2][2][4][2], const Unit& u, int wr, int wc, int fr, int fq, const LAS unsigned char* tab) const {
        const int row0 = u.row0 + wr * 64 + fr, col0 = u.col0 + wc * 32 + 8 * fq;
        u32x4 rrv[RES ? 2 : 1][RES ? 4 : 1][2];
        if (RES) {
#pragma unroll
            for (int ai = 0; ai < 2; ++ai)
#pragma unroll
                for (int m = 0; m < 4; ++m)
#pragma unroll
                    for (int bj = 0; bj < 2; ++bj) rrv[RES ? ai : 0][RES ? m : 0][bj] = *(const u32x4*)(res + (size_t)(row0 + ai * HALF + m * 16) * ldc + col0 + bj * HALF);
            __builtin_amdgcn_sched_barrier(0); }
#pragma unroll
        for (int ai = 0; ai < 2; ++ai)
#pragma unroll
            for (int m = 0; m < 4; ++m) { bf16_t* rowp = O + (size_t)(row0 + ai * HALF + m * 16) * ldc + col0; const float sc = RS ? ((const LAS float*)tab)[wr * 64 + fr + ai * HALF + m * 16] : 1.0f;
#pragma unroll
                for (int bj = 0; bj < 2; ++bj) { f32x4 v0 = acc[ai][bj][m][0] * sc, v1 = acc[ai][bj][m][1] * sc;
                    if (RES) { const u32x4 rr = rrv[RES ? ai : 0][RES ? m : 0][bj];
                        v0[0] += bf2f_(rr.x & 0xffffu); v0[1] += bf2f_(rr.x >> 16); v0[2] += bf2f_(rr.y & 0xffffu); v0[3] += bf2f_(rr.y >> 16);
                        v1[0] += bf2f_(rr.z & 0xffffu); v1[1] += bf2f_(rr.z >> 16); v1[2] += bf2f_(rr.w & 0xffffu); v1[3] += bf2f_(rr.w >> 16); }
                    u32x4 w; w.x = cvt_pk_bf16(v0[0], v0[1]); w.y = cvt_pk_bf16(v0[2], v0[3]); w.z = cvt_pk_bf16(v1[0], v1[1]); w.w = cvt_pk_bf16(v1[2], v1[3]);
                    if ((RES || col0 + bj * HALF < ncols) && !dry) *(u32x4*)(rowp + bj * HALF) = w; } }
    }
};
struct EpiSwiglu {
    static constexpr bool PERM = true;
    bf16_t* HID; int dry; const float* ls;
    __device__ __forceinline__ void stage(const Unit& u, LAS unsigned char* tab, int wid, int lane) const {
        if (wid < 4) __builtin_amdgcn_global_load_lds((const unsigned*)((const char*)(ls + u.lrow + wid * 64) + (unsigned)lane * 4u), (LAS unsigned*)(tab + wid * 256), 4, 0, 0); }
    __device__ __forceinline__ void operator()(const f32x4 (&acc)[2][2][4][2], const Unit& u, int wr, int wc, int fr, int fq, const LAS unsigned char* tab) const {
        const int row0 = u.row0 + wr * 64 + fr, hc0 = (u.col0 >> 1) + wc * 32 + 8 * fq;
#pragma unroll
        for (int ai = 0; ai < 2; ++ai)
#pragma unroll
            for (int m = 0; m < 4; ++m) { bf16_t* rowp = HID + (size_t)(row0 + ai * HALF + m * 16) * 256 + hc0; const int r = wr * 64 + fr + ai * HALF + m * 16; const float sc = r < u.cnt ? ((const LAS float*)tab)[r] : 0.f;
                float h[8];
#pragma unroll
                for (int n = 0; n < 2; ++n) { const f32x4 g = acc[ai][0][m][n] * sc, up = acc[ai][1][m][n] * sc;
#pragma unroll
                    for (int q = 0; q < 4; ++q) h[4 * n + q] = g[q] * __builtin_amdgcn_rcpf(1.0f + __expf(-g[q])) * up[q]; }
                u32x4 w; w.x = cvt_pk_bf16(h[0], h[1]); w.y = cvt_pk_bf16(h[2], h[3]); w.z = cvt_pk_bf16(h[4], h[5]); w.w = cvt_pk_bf16(h[6], h[7]);
                if (!dry) *(u32x4*)rowp = w; else asm volatile("" :: "v"(w)); }
    }
};
struct EpiScatter {
    static constexpr bool PERM = true;
    bf16_t* YM; const int* list; const float* lw; int dry;
    __device__ __forceinline__ void stage(const Unit& u, LAS unsigned char* tab, int wid, int lane) const {
        const char* gsrc = wid < 4 ? (const char*)(list + u.lrow + wid * 64) : (const char*)(lw + u.lrow + (wid - 4) * 64);
        __builtin_amdgcn_global_load_lds((const unsigned*)(gsrc + (unsigned)lane * 4u), (LAS unsigned*)(tab + (wid < 4 ? wid * 256 : 1024 + (wid - 4) * 256)), 4, 0, 0); }
    __device__ __forceinline__ void operator()(const f32x4 (&acc)[2][2][4][2], const Unit& u, int wr, int wc, int fr, int fq, const LAS unsigned char* tab) const {
        { const int l2 = lane_now(); fr = l2 & 15; fq = l2 >> 4; }
        const int r0 = wr * 64 + fr, col0 = u.col0 + wc * 32 + 8 * fq;
#pragma unroll
        for (int ai = 0; ai < 2; ++ai)
#pragma unroll
            for (int m = 0; m < 4; ++m) { const int r = r0 + ai * HALF + m * 16;
                if (r < u.cnt) { const int ent = ((const LAS int*)tab)[r]; const float wgt = ((const LAS float*)(tab + 1024))[r]; bf16_t* rowp = YM + (size_t)ent * 1024 + col0;
#pragma unroll
                    for (int bj = 0; bj < 2; ++bj) { const f32x4 v0 = acc[ai][bj][m][0] * wgt, v1 = acc[ai][bj][m][1] * wgt;
                        u32x4 w; w.x = cvt_pk_bf16(v0[0], v0[1]); w.y = cvt_pk_bf16(v0[2], v0[3]); w.z = cvt_pk_bf16(v1[0], v1[1]); w.w = cvt_pk_bf16(v1[2], v1[3]);
                        if (!dry) *(u32x4*)(rowp + bj * HALF) = w; else asm volatile("" :: "v"(w)); } } }
    }
};

template <bool G> struct AOff;
template <> struct AOff<true> { unsigned v[2][2]; };
template <> struct AOff<false> { int row; };
__device__ __forceinline__ unsigned aoff_of(const AOff<true>& O, int h, int i, const int (&)[2], unsigned, const unsigned (&)[2]) { return O.v[h][i]; }
__device__ __forceinline__ unsigned aoff_of(const AOff<false>& O, int h, int i, const int (&RA)[2], unsigned rowb, const unsigned (&CA)[2]) { return (unsigned)(O.row + h * HALF + RA[i]) * rowb + CA[i]; }
template <class Sched> __device__ __forceinline__ void aoff_set(AOff<true>& O, const Sched& S, const Unit& u, const int (&RA)[2], unsigned rowb, const unsigned (&CA)[2]) {
#pragma unroll
    for (int h = 0; h < 2; ++h)
#pragma unroll
        for (int i = 0; i < 2; ++i) O.v[h][i] = S.arow(u, h * HALF + RA[i]) * rowb + CA[i]; }
template <class Sched> __device__ __forceinline__ void aoff_set(AOff<false>& O, const Sched&, const Unit& u, const int (&)[2], unsigned, const unsigned (&)[2]) { O.row = u.row0; }
__device__ __forceinline__ AOff<true> aoff_sel(bool c, const AOff<true>& a, const AOff<true>& b) { AOff<true> r;
#pragma unroll
    for (int h = 0; h < 2; ++h)
#pragma unroll
        for (int i = 0; i < 2; ++i) r.v[h][i] = c ? a.v[h][i] : b.v[h][i];
    return r; }
__device__ __forceinline__ AOff<false> aoff_sel(bool c, const AOff<false>& a, const AOff<false>& b) { AOff<false> r; r.row = c ? a.row : b.row; return r; }
template <class Epi, class Sched, bool ALIGN_EPI = true, bool SP2 = true>
__device__ __forceinline__ void gemm_phase(LAS unsigned char* lds, const char* Abase, const int K, const Sched& S, const Epi& E, const int wid) {
    const int lane = lane_now(), tid = wid * 64 + lane, wr = wid >> 2, wc = wid & 3, fr = lane & 15, fq = lane >> 4;
    const int nt = K / BK;
    const char* Ab = Abase; asm volatile("" : "+s"(Ab));
    int RA[2]; unsigned CA[2], voffB[2];
#pragma unroll
    for (int i = 0; i < 2; ++i) { int R, C; stage_rc(tid * 16 + i * 8192, R, C); const int Rb = Epi::PERM ? ((R & ~31) + perm32(R & 31)) : R;
        RA[i] = R; CA[i] = (unsigned)C * 2u; voffB[i] = (unsigned)(Rb * K + C) * 2u; }
    const size_t kstep = (size_t)(BK * 2);
    const size_t hstep = (size_t)HALF * K * 2;
    const unsigned rowb = (unsigned)K * 2u;
    const unsigned ldsw = (unsigned)wid * 1024u;
    const int aoff = lds_byte(wr * 64 + fr, fq * 8), boff = lds_byte(wc * 32 + fr, fq * 8);
#define PG8_SA(b, h) (((b) * 2 + (h)) * HTB)
#define PG8_SB(b, h) ((4 + (b) * 2 + (h)) * HTB)
#define PG8_STAGE_B(bufoff, gbase) do { _Pragma("unroll") for (int _i = 0; _i < 2; ++_i) { unsigned _vo = voffB[_i]; asm volatile("" : "+v"(_vo));     \
        __builtin_amdgcn_global_load_lds((const unsigned*)((const char*)(gbase) + _vo), (LAS unsigned*)(lds + (bufoff) + ldsw + _i * 8192), 16, 0, 0); } } while (0)
#define PG8_STAGE_A(bufoff, OFF, h, kb) do { _Pragma("unroll") for (int _i = 0; _i < 2; ++_i) { unsigned _vo = aoff_of(OFF, h, _i, RA, rowb, CA); asm volatile("" : "+v"(_vo)); \
        __builtin_amdgcn_global_load_lds((const unsigned*)(Ab + (size_t)(kb) + _vo), (LAS unsigned*)(lds + (bufoff) + ldsw + _i * 8192), 16, 0, 0); } } while (0)
#define PG8_LDA(dst, b, h) do { _Pragma("unroll") for (int m = 0; m < 4; ++m) _Pragma("unroll") for (int k = 0; k < 2; ++k) dst[m][k] = *(const LAS bf16x8*)(lds + PG8_SA(b, h) + aoff + m * 2048 + k * 1024); } while (0)
#define PG8_LDB(dst, b, h) do { _Pragma("unroll") for (int n = 0; n < 2; ++n) _Pragma("unroll") for (int k = 0; k < 2; ++k) dst[n][k] = *(const LAS bf16x8*)(lds + PG8_SB(b, h) + boff + n * 2048 + k * 1024); } while (0)
#define PG8_MMA(ai, bj, At, Bt) do { __builtin_amdgcn_s_setprio(1); _Pragma("unroll") for (int m = 0; m < 4; ++m) _Pragma("unroll") for (int n = 0; n < 2; ++n) _Pragma("unroll") for (int k = 0; k < 2; ++k) \
        acc[ai][bj][m][n] = __builtin_amdgcn_mfma_f32_16x16x32_bf16(Bt[n][k], At[m][k], acc[ai][bj][m][n], 0, 0, 0); __builtin_amdgcn_s_setprio(0); } while (0)
#define PG8_WAIT_V(n) asm volatile("s_waitcnt vmcnt(" #n ")" ::: "memory")
#define PG8_WAIT_L(n) asm volatile("s_waitcnt lgkmcnt(" #n ")" ::: "memory")
#define PG8_BAR __builtin_amdgcn_s_barrier()
#define PG8_SCHED __builtin_amdgcn_sched_barrier(0)
    Unit cur, nxt; int ui = 0;
    if (!S.next(0, cur)) return;
    AOff<Sched::GATHER> oc, on;
    aoff_set(oc, S, cur, RA, rowb, CA);
    f32x4 acc[2][2][4][2];
#pragma unroll
    for (int a = 0; a < 2; ++a)
#pragma unroll
        for (int b = 0; b < 2; ++b)
#pragma unroll
            for (int m = 0; m < 4; ++m)
#pragma unroll
                for (int n = 0; n < 2; ++n) acc[a][b][m][n] = (f32x4){0.f, 0.f, 0.f, 0.f};
    bf16x8 At[4][2], B0[2][2], B1[2][2];
    const char* cB = cur.b;
    if constexpr (SP2) {
        PG8_STAGE_B(PG8_SB(0, 0), cB); PG8_STAGE_B(PG8_SB(0, 1), cB + hstep); PG8_STAGE_A(PG8_SA(0, 0), oc, 0, 0); PG8_STAGE_A(PG8_SA(0, 1), oc, 1, 0);
        if (wr == 1) PG8_BAR;
        PG8_WAIT_V(2); PG8_BAR;
        PG8_STAGE_B(PG8_SB(1, 0), cB + kstep); PG8_STAGE_A(PG8_SA(1, 0), oc, 0, kstep); PG8_STAGE_B(PG8_SB(1, 1), cB + hstep + kstep);
        PG8_WAIT_V(6); PG8_BAR;
    } else {
    PG8_STAGE_B(PG8_SB(0, 0), cB); PG8_STAGE_A(PG8_SA(0, 0), oc, 0, 0); PG8_STAGE_B(PG8_SB(0, 1), cB + hstep); PG8_STAGE_A(PG8_SA(0, 1), oc, 1, 0);
    if (wr == 1) PG8_BAR;
    PG8_WAIT_V(4); PG8_BAR;
    PG8_STAGE_B(PG8_SB(1, 0), cB + kstep); PG8_STAGE_A(PG8_SA(1, 0), oc, 0, kstep); PG8_STAGE_B(PG8_SB(1, 1), cB + hstep + kstep);
    PG8_WAIT_V(6); PG8_BAR;
    }
    for (;;) {
        const bool has_next = S.next(ui + 1, nxt);
        const char* nB = has_next ? nxt.b : cB;
        if (has_next) aoff_set(on, S, nxt, RA, rowb, CA); else on = oc;
        LAS unsigned char* etab = lds + 131072 + 1024 + (ui & 1) * 2048;
        E.stage(cur, etab, wid, lane);
        for (int t = 0; t < nt; t += 2) {
            const bool last = (t == nt - 2);
            const size_t k1 = (size_t)(t + 1) * kstep;
            const size_t k2 = last ? (size_t)0 : (size_t)(t + 2) * kstep, k3 = k2 + kstep;
            const char* b2 = last ? nB : cB + (size_t)(t + 2) * kstep; const char* b3 = b2 + kstep;
            const AOff<Sched::GATHER> o2 = aoff_sel(last, on, oc);
            if constexpr (SP2) {
            PG8_LDB(B0, 0, 0); PG8_LDB(B1, 0, 1); PG8_SCHED; PG8_LDA(At, 0, 0); PG8_STAGE_A(PG8_SA(1, 1), oc, 1, k1);
            PG8_WAIT_V(8); PG8_WAIT_L(0); PG8_BAR; PG8_MMA(0, 0, At, B0); PG8_MMA(0, 1, At, B1); PG8_BAR; PG8_SCHED;
            PG8_LDA(At, 0, 1); PG8_STAGE_B(PG8_SB(0, 0), b2); PG8_STAGE_B(PG8_SB(0, 1), b2 + hstep); PG8_STAGE_A(PG8_SA(0, 0), o2, 0, k2);
            PG8_WAIT_V(8); PG8_WAIT_L(0); PG8_BAR; PG8_MMA(1, 0, At, B0); PG8_MMA(1, 1, At, B1); PG8_BAR; PG8_SCHED;
            PG8_LDB(B0, 1, 0); PG8_LDB(B1, 1, 1); PG8_SCHED; PG8_LDA(At, 1, 0); PG8_STAGE_A(PG8_SA(0, 1), o2, 1, k2);
            PG8_WAIT_V(8); PG8_WAIT_L(0); PG8_BAR; PG8_MMA(0, 0, At, B0); PG8_MMA(0, 1, At, B1); PG8_BAR; PG8_SCHED;
            PG8_LDA(At, 1, 1); PG8_STAGE_B(PG8_SB(1, 0), b3); PG8_STAGE_B(PG8_SB(1, 1), b3 + hstep); PG8_STAGE_A(PG8_SA(1, 0), o2, 0, k3);
            PG8_WAIT_V(8); PG8_WAIT_L(0); PG8_BAR; PG8_MMA(1, 0, At, B0); PG8_MMA(1, 1, At, B1); PG8_BAR; PG8_SCHED;
            } else {
            PG8_LDB(B0, 0, 0); PG8_SCHED; PG8_LDA(At, 0, 0); PG8_STAGE_A(PG8_SA(1, 1), oc, 1, k1);
            PG8_WAIT_L(8); PG8_BAR; PG8_WAIT_L(0); PG8_MMA(0, 0, At, B0); PG8_BAR; PG8_SCHED;
            PG8_LDB(B1, 0, 1); PG8_STAGE_B(PG8_SB(0, 0), b2);
            PG8_BAR; PG8_WAIT_L(0); PG8_MMA(0, 1, At, B1); PG8_BAR;
            PG8_LDA(At, 0, 1); PG8_STAGE_A(PG8_SA(0, 0), o2, 0, k2);
            PG8_BAR; PG8_WAIT_L(0); PG8_MMA(1, 0, At, B0); PG8_BAR; PG8_SCHED;
            PG8_STAGE_B(PG8_SB(0, 1), b2 + hstep);
            PG8_WAIT_V(6); PG8_BAR; PG8_MMA(1, 1, At, B1); PG8_BAR;
            PG8_LDB(B0, 1, 0); PG8_SCHED; PG8_LDA(At, 1, 0); PG8_STAGE_A(PG8_SA(0, 1), o2, 1, k2);
            PG8_WAIT_L(8); PG8_BAR; PG8_WAIT_L(0); PG8_MMA(0, 0, At, B0); PG8_BAR; PG8_SCHED;
            PG8_LDB(B1, 1, 1); PG8_STAGE_B(PG8_SB(1, 0), b3);
            PG8_BAR; PG8_WAIT_L(0); PG8_MMA(0, 1, At, B1); PG8_BAR;
            PG8_LDA(At, 1, 1); PG8_STAGE_A(PG8_SA(1, 0), o2, 0, k3);
            PG8_BAR; PG8_WAIT_L(0); PG8_MMA(1, 0, At, B0); PG8_BAR; PG8_SCHED;
            PG8_STAGE_B(PG8_SB(1, 1), b3 + hstep);
            PG8_WAIT_V(6); PG8_BAR; PG8_MMA(1, 1, At, B1); PG8_BAR;
            }
        }
        if constexpr (ALIGN_EPI) { if (wr == 0) PG8_BAR; }
        E(acc, cur, wr, wc, fr, fq, etab);
        if (!has_next) break;
#pragma unroll
        for (int a = 0; a < 2; ++a)
#pragma unroll
            for (int b = 0; b < 2; ++b)
#pragma unroll
                for (int m = 0; m < 4; ++m)
#pragma unroll
                    for (int n = 0; n < 2; ++n) acc[a][b][m][n] = (f32x4){0.f, 0.f, 0.f, 0.f};
        cur = nxt; cB = nB; ++ui;
        oc = on;
        if constexpr (ALIGN_EPI) { if (wr == 1) PG8_BAR; }
    }
    PG8_WAIT_V(0);
    if constexpr (!ALIGN_EPI) { if (wr == 0) PG8_BAR; }
    PG8_BAR;
#undef PG8_SA
#undef PG8_SB
#undef PG8_STAGE_A
#undef PG8_STAGE_B
#undef PG8_LDA
#undef PG8_LDB
#undef PG8_MMA
#undef PG8_WAIT_V
#undef PG8_WAIT_L
#undef PG8_BAR
#undef PG8_SCHED
}
}

struct Ctx {
    const Params* p; LAS unsigned char* lds; int tid, lane, wave, G, bid, dry;
    unsigned char* ws; unsigned char* dsc;
#define WSP(T, name, off) __device__ __forceinline__ T* name() const { return (T*)(ws + (off)); }
#define DSP(T, name, off) __device__ __forceinline__ T* name() const { return (T*)(dsc + (off)); }
    WSP(bf16_t, H, WS_H) WSP(bf16_t, P, WS_P) WSP(bf16_t, Y, WS_Y) WSP(bf16_t, HN, WS_HN)
    WSP(bf16_t, WinE, WS_WINE) WSP(bf16_t, WoutE, WS_WOUTE) WSP(bf16_t, WinO, WS_WINO) WSP(bf16_t, WoutO, WS_WOUTO) WSP(bf16_t, W1, WS_W1) WSP(bf16_t, W2, WS_W2)
    WSP(int, mcnt, WS_CTL + 16384)
    WSP(bf16_t, YM, WS_P + PO_YM) WSP(bf16_t, HID, WS_P + PO_HID) WSP(int, mlist, WS_P + PO_LIST) WSP(float, mlw, WS_P + PO_LW) WSP(float, mls, WS_P + PO_LS) WSP(float, srow, WS_SROW) WSP(bf16_t, XB, WS_H + (size_t)NP * 1024 * 2)
    DSP(float, lruA, DO_LRUA) DSP(float, lruH, DO_LRUH) DSP(float, lruC, DO_LRUC) DSP(float, glaG, DO_GLAG)
    WSP(bf16_t, DUt, WS_DUT) WSP(bf16_t, IUt, WS_IUT) WSP(bf16_t, GUt, WS_GUT) WSP(bf16_t, WAt, WS_WAT) WSP(bf16_t, WXt, WS_WXT) WSP(bf16_t, WrH, WS_WRH) WSP(bf16_t, WrL, WS_WRL) WSP(float, LAMC, WS_LAMC)
    WSP(bf16_t, GLUt, WS_GLU)
    WSP(bf16_t, rwGP, WS_HN) WSP(bf16_t, rwQE, WS_HN + (size_t)NRU * 4096 * 2)
    DSP(bf16_t, rwHC, DO_RWHC) DSP(bf16_t, rwOO, DO_RWOO) DSP(bf16_t, rwE2, DO_RWE2) DSP(float, rwGL, DO_RWGL)
    __device__ __forceinline__ bf16_t* lruLA(const int b) const { return b < 4 ? (bf16_t*)(ws + WS_P + (size_t)NP * EVEN_IN * 2) + (size_t)b * TP * 512 : (bf16_t*)(dsc + DO_END) + (size_t)(b - 4) * TP * 512; }
    DSP(bf16_t, gKH, DO_RWHC) DSP(bf16_t, gVC, DO_RWHC + (size_t)BATCH * 4 * NCH * 8192 * 2)
#undef WSP
#undef DSP
};

constexpr int NJ_WINE = 16 * 44, NJ_WOUT = 256, NJ_WINO = 16 * 49, NJ_W1 = 64 * 128, NJ_W2 = 64 * 64;
constexpr int J1 = NJ_WINE, J2 = J1 + NJ_WOUT, J3 = J2 + NJ_WINO, J4 = J3 + NJ_WOUT, J5 = J4 + NJ_W1, J6 = J5 + NJ_W2, J7 = J6 + 48;
struct ConvJob { const float* src; bf16_t* dst; const float* ksc; int lds_src, ldd, nvalid; };
__device__ __forceinline__ ConvJob conv_decode(const Ctx& c, const int job) {
    const Params& p = *c.p; ConvJob J; J.nvalid = 64; J.ksc = nullptr;
    int j = job;
    if (j < J1) { const int kt = j / 44, nt = j % 44; J.src = p.in[I_EWIN] + (size_t)kt * 64 * EVEN_IN + nt * 64; J.lds_src = EVEN_IN; J.ksc = p.in[I_ENORM] + kt * 64; J.dst = c.WinE() + (size_t)nt * 64 * 1024 + kt * 64; J.ldd = 1024; }
    else if (j < J2) { j -= J1; const int kt = j / 16, nt = j % 16; J.src = p.in[I_EWOUT] + (size_t)kt * 64 * 1024 + nt * 64; J.lds_src = 1024; J.dst = c.WoutE() + (size_t)nt * 64 * 1024 + kt * 64; J.ldd = 1024; }
    else if (j < J3) { j -= J2; const int kt = j / 49, nt = j % 49; J.src = p.in[I_OWIN] + (size_t)kt * 64 * ODD_IN + nt * 64; J.lds_src = ODD_IN; J.ksc = p.in[I_ONORM] + kt * 64; J.nvalid = (ODD_IN - nt * 64) < 64 ? (ODD_IN - nt * 64) : 64;
        J.dst = c.WinO() + (size_t)nt * 64 * 1024 + kt * 64; J.ldd = 1024; }
    else if (j < J4) { j -= J3; const int kt = j / 16, nt = j % 16; J.src = p.in[I_OWOUT] + (size_t)kt * 64 * 1024 + nt * 64; J.lds_src = 1024; J.dst = c.WoutO() + (size_t)nt * 64 * 1024 + kt * 64; J.ldd = 1024; }
    else if (j < J5) { j -= J4; const int le = j / 128, r = j % 128, which = r / 64, r2 = r % 64, kt = r2 / 4, nt = r2 % 4;
        J.src = p.in[which ? I_MWUP : I_MWGATE] + (size_t)le * 1024 * 256 + (size_t)kt * 64 * 256 + nt * 64; J.lds_src = 256; J.ksc = p.in[I_MNORM] + (le >> 5) * 1024 + kt * 64;
        const int row0 = (nt >> 1) * 256 + (nt & 1) * 64 + which * 128;
        J.dst = c.W1() + (size_t)le * 512 * 1024 + (size_t)row0 * 1024 + kt * 64; J.ldd = 1024; }
    else if (j >= J6) { j -= J6;
        if (j < 8) { J.src = p.in[I_EDECAYUP] + j * 64; J.lds_src = 512; J.dst = c.DUt() + (size_t)j * 64 * 64; J.ldd = 64; }
        else if (j < 16) { j -= 8; J.src = p.in[I_EICLRUP] + j * 64; J.lds_src = 512; J.dst = c.IUt() + (size_t)j * 64 * 64; J.ldd = 64; }
        else if (j < 32) { j -= 16; const int kt = j / 8, nt = j % 8; J.src = p.in[I_EGATEUP] + (size_t)kt * 64 * 512 + nt * 64; J.lds_src = 512; J.dst = c.GUt() + (size_t)nt * 64 * 128 + kt * 64; J.ldd = 128; }
        else if (j < 40) { j -= 32; J.src = p.in[I_ELRUWA] + (size_t)j * 4096; J.lds_src = 64; J.dst = c.WAt() + (size_t)j * 4096; J.ldd = 64; }
        else { j -= 40; J.src = p.in[I_ELRUWX] + (size_t)j * 4096; J.lds_src = 64; J.dst = c.WXt() + (size_t)j * 4096; J.ldd = 64; } }
    else { j -= J5; const int le = j / 64, r = j % 64, kt = r / 16, nt = r % 16;
        J.src = p.in[I_MWDOWN] + (size_t)le * 256 * 1024 + (size_t)kt * 64 * 1024 + nt * 64; J.lds_src = 1024;
        J.dst = c.W2() + (size_t)le * 1024 * 256 + (size_t)nt * 64 * 256 + kt * 64; J.ldd = 256; }
    return J;
}
constexpr int CONV_T = 2;
template <bool FAST> __device__ __forceinline__ void conv_range(const Ctx& c, const int lo, const int hi, const int vb, const int nvb) {
    const int tid = c.tid;
    lfloat* tile = (lfloat*)(c.lds + LDS_PH);
    for (int j0 = lo + CONV_T * vb; j0 < hi; j0 += CONV_T * nvb) {
        f32x4 v[CONV_T][2]; float gk[CONV_T][2];
#pragma unroll
        for (int q = 0; q < CONV_T; ++q) { const int job = (j0 + q) < hi ? (j0 + q) : (hi - 1); const ConvJob J = conv_decode(c, job); const float* kp = J.ksc ? J.ksc : c.p->in[I_ENORM];
#pragma unroll
            for (int i = 0; i < 2; ++i) { const int k = (tid >> 4) + 32 * i, n4 = (tid & 15) * 4; { const float g = kp[k]; gk[q][i] = J.ksc ? g : 1.0f; }
                if (FAST) v[q][i] = *(const f32x4*)(J.src + (size_t)k * J.lds_src + (n4 < J.nvalid ? n4 : 0));
                else { v[q][i] = (f32x4){0.f, 0.f, 0.f, 0.f}; if (n4 < J.nvalid) v[q][i] = *(const f32x4*)(J.src + (size_t)k * J.lds_src + n4); } } }
#pragma unroll
        for (int q = 0; q < CONV_T; ++q)
#pragma unroll
            for (int i = 0; i < 2; ++i) { const int k = (tid >> 4) + 32 * i, n4 = (tid & 15) * 4; lfloat* tp = tile + q * 4160 + k * 65 + n4; const float g = gk[q][i];
                tp[0] = v[q][i][0] * g; tp[1] = v[q][i][1] * g; tp[2] = v[q][i][2] * g; tp[3] = v[q][i][3] * g; }
        __syncthreads();
#pragma unroll
        for (int q = 0; q < CONV_T; ++q) { const int job = j0 + q;
            if (job < hi) { const ConvJob J = conv_decode(c, job); const int n = tid >> 3, k8 = (tid & 7) * 8;
                if (n < J.nvalid) { float o[8];
#pragma unroll
                    for (int e = 0; e < 8; ++e) o[e] = tile[q * 4160 + (k8 + e) * 65 + n];
                    if (!c.dry) *(u32x4*)(J.dst + (size_t)n * J.ldd + k8) = pack8(o); } } }
        __syncthreads();
    }
}

__device__ __forceinline__ void ph_prologue(const Ctx& c) {
    const Params& p = *c.p; const int tid = c.tid;
    conv_range<true>(c, 0, J1, c.bid, c.G); conv_range<true>(c, J6, J7, c.bid, c.G);
    if (c.bid == 0 && !c.dry) c.LAMC()[tid] = -8.0f * softplusf_(-p.in[I_ELAMBDA][tid]);
    { const int stride = c.G * 8; int row = c.bid * 8 + c.wave;
      if (row < NP) {
#define PR_LOAD(row_, dst) do { const int b_ = (row_) / TP, t_ = (row_) % TP, tc_ = t_ < TT ? t_ : 0; \
            const float* src_ = tc_ < NMETA ? p.in[I_META] + (size_t)tc_ * 1024 : p.in[I_X] + ((size_t)b_ * SEQ + (tc_ - NMETA)) * 1024; \
            _Pragma("unroll") for (int i = 0; i < 4; ++i) dst[i] = *(const f32x4*)(src_ + 4 * c.lane + 256 * i); } while (0)
        f32x4 v[4], vn[4];
        PR_LOAD(row, v);
        for (; row < NP; row += stride) {
            { const int rn = row + stride < NP ? row + stride : row; PR_LOAD(rn, vn); }
            const int t = row % TP;
            bf16_t* nrow = c.XB() + (size_t)row * 1024;
            if (t >= TT) {
#pragma unroll
                for (int i = 0; i < 4; ++i) { if (!c.dry) *(u32x2*)(nrow + 4 * c.lane + 256 * i) = (u32x2){0u, 0u}; }
                if (c.lane == 0 && !c.dry) c.srow()[row] = 0.f;
            } else {
                float ss = 0.f;
#pragma unroll
                for (int i = 0; i < 4; ++i) ss += v[i][0] * v[i][0] + v[i][1] * v[i][1] + v[i][2] * v[i][2] + v[i][3] * v[i][3];
                ss = wave_sum(ss);
                if (c.lane == 0 && !c.dry) c.srow()[row] = rsqrtf(ss * (1.0f / 1024.0f) + 1e-6f);
#pragma unroll
                for (int i = 0; i < 4; ++i) { u32x2 w; w.x = pack2(v[i][0], v[i][1]); w.y = pack2(v[i][2], v[i][3]); if (!c.dry) *(u32x2*)(nrow + 4 * c.lane + 256 * i) = w; }
            }
#pragma unroll
            for (int i = 0; i < 4; ++i) v[i] = vn[i];
        }
#undef PR_LOAD
      } }
}
__device__ __forceinline__ void filler_A(const Ctx& c, const int vb, const int nvb) {
    const Params& p = *c.p; const int tid = c.tid;
    conv_range<true>(c, J1, J4 + 4096, vb, nvb); conv_range<true>(c, J5, J5 + 2048, vb, nvb);
    for (int idx = vb * NTHREADS + tid; idx < 2 * 48 * 1024; idx += nvb * NTHREADS) {
        const int l = idx / (48 * 1024), r = idx % (48 * 1024), e = r / 1024, k = r % 1024;
        const float val = (e < 4 ? p.in[I_MWGROUP][((size_t)l * 1024 + k) * 4 + e] : e < 36 ? p.in[I_MWROUTER][((size_t)l * 1024 + k) * 32 + (e - 4)] : 0.f) * p.in[I_MNORM][(size_t)l * 1024 + k];
        const bf16_t hi = f2bf(val); const bf16_t lo = f2bf(val - bf2f(hi));
        if (!c.dry) { c.WrH()[idx] = hi; c.WrL()[idx] = lo; } }
    for (int idx = vb * NTHREADS + tid; idx < 512 * 32; idx += nvb * NTHREADS) { const int n = idx >> 5, k = idx & 31; if (!c.dry) c.GLUt()[idx] = k < 16 ? f2bf(p.in[I_OGUP][k * 512 + n]) : (bf16_t)0; }
    for (int idx = vb * NTHREADS + tid; idx < (ODD_IN_PAD - ODD_IN) * 1024 / 8; idx += nvb * NTHREADS)
        if (!c.dry) *(u32x4*)(c.WinO() + (size_t)ODD_IN * 1024 + (size_t)idx * 8) = (u32x4){0u, 0u, 0u, 0u};
}
__device__ __forceinline__ void filler_B(const Ctx& c, const int vb, const int nvb) { conv_range<true>(c, J4 + 4096, J5, vb, nvb); conv_range<true>(c, J5 + 2048, J6, vb, nvb); }

typedef LAS bf16_t lbf;
#define MFMA16(a, b, c) __builtin_amdgcn_mfma_f32_16x16x32_bf16(a, b, c, 0, 0, 0)
typedef short s16x4 __attribute__((ext_vector_type(4)));
#define MFMA4(a, b, c) __builtin_amdgcn_mfma_f32_16x16x16bf16_1k(__builtin_bit_cast(s16x4, a), __builtin_bit_cast(s16x4, b), c, 0, 0, 0)
__device__ __forceinline__ bf16x8 ldfrag(const lbf* base, int ld, int row0, int k0, int lane) { return *(const LAS bf16x8*)(base + (row0 + (lane & 15)) * ld + k0 + (lane >> 4) * 8); }
__device__ __forceinline__ bf16x8 gfrag(const bf16_t* base, int ld, int row0, int k0, int lane) { return *(const bf16x8*)(base + (size_t)(row0 + (lane & 15)) * ld + k0 + (lane >> 4) * 8); }
__device__ __forceinline__ int swz64(const int row, const int col) { return row * 64 + ((((col) >> 3) ^ (row & 7)) << 3) + (col & 7); }
__device__ __forceinline__ bf16x8 ldfrag_sw(const lbf* base, int row0, int k0, int lane) { return *(const LAS bf16x8*)(base + swz64(row0 + (lane & 15), k0 + (lane >> 4) * 8)); }
typedef short s16x4v __attribute__((ext_vector_type(4)));
__device__ __forceinline__ bf16x8 ldfrag_tr(const lbf* base, int ld, int k0, int c0, int lane) {
    const int fr = lane & 15, fq = lane >> 4; const lbf* a = base + (k0 + 8 * fq + (fr >> 2)) * ld + c0 + 4 * (fr & 3);
    const s16x4v lo = __builtin_amdgcn_ds_read_tr16_b64_v4i16((LAS s16x4v*)a), hi = __builtin_amdgcn_ds_read_tr16_b64_v4i16((LAS s16x4v*)(a + 4 * ld));
    return (bf16x8){lo[0], lo[1], lo[2], lo[3], hi[0], hi[1], hi[2], hi[3]}; }
__device__ __forceinline__ u32x2 pk4(const f32x4 a) { u32x2 w; w.x = pg8::cvt_pk_bf16(a[0], a[1]); w.y = pg8::cvt_pk_bf16(a[2], a[3]); return w; }
__device__ __forceinline__ f32x4 up4(const u32x2 w) { return (f32x4){bf2f(w.x & 0xffffu), bf2f(w.x >> 16), bf2f(w.y & 0xffffu), bf2f(w.y >> 16)}; }
__device__ __forceinline__ void st4(lbf* base, int ld, int i0, int j0, const f32x4 a, int lane) { *(LAS u32x2*)(base + (j0 + (lane & 15)) * ld + i0 + 4 * (lane >> 4)) = pk4(a); }


__device__ __forceinline__ float fast_sigmoid(float x) { return __builtin_amdgcn_rcpf(1.0f + __expf(-x)); }
struct LruRows { u32x4 xv[4]; u32x4 gb; };
__device__ __forceinline__ LruRows lru_load_rows(const Ctx& c, const int u, const bool final) {
    const int b = u / (NCH * 8), rem = u % (NCH * 8), ch = rem / 8, n = rem % 8;
    const int i = c.tid >> 3, cg0 = 64 * n + (c.tid & 7) * 8, t = ch * 64 + i;
    LruRows R; R.gb = (u32x4){0u, 0u, 0u, 0u};
#pragma unroll
    for (int j = 0; j < 4; ++j) { const int tj = t - 3 + j; const bool ok = tj >= 0 && tj < TT;
        const u32x4 x = *(const u32x4*)(c.P() + ((size_t)b * TP + (ok ? tj : 0)) * EVEN_IN + 1792 + cg0);
        R.xv[j] = ok ? x : (u32x4){0u, 0u, 0u, 0u}; }
    if (final) R.gb = *(const u32x4*)(c.P() + ((size_t)b * TP + t) * EVEN_IN + 2304 + cg0);
    return R;
}
__device__ __forceinline__ void lru_run(const Ctx& c, const bool final, const int vb, const int nvb) {
    const Params& p = *c.p; const int tid = c.tid, lane = c.lane, w = c.wave, fr = lane & 15, fq = lane >> 4;
    const int NU = BATCH * NCH * 8;
    if (vb >= NU) return;
    lbf* XA = (lbf*)(c.lds + LDS_PH);
    lfloat* XC = (lfloat*)(XA + 64 * 72);
    lfloat* AA = XC + 4096;
    lfloat* UU = AA + 4096;
    lfloat* SEGA = UU + 4096;
    lfloat* SEGH = SEGA + 512;
    lfloat* CARA = SEGH + 512;
    lfloat* CARH = CARA + 512;
    const int i = tid >> 3, j8 = (tid & 7) * 8, mi = w >> 1;
    const bool fixed_n = (nvb % 8) == 0;
    bf16x8 fwa[2][2], fwx[2][2];
    if (fixed_n) { const int n = vb % 8;
#pragma unroll
        for (int n2 = 0; n2 < 2; ++n2)
#pragma unroll
            for (int k = 0; k < 2; ++k) { fwa[n2][k] = gfrag(c.WAt() + n * 4096, 64, 16 * (2 * (w & 1) + n2), 32 * k, lane); fwx[n2][k] = gfrag(c.WXt() + n * 4096, 64, 16 * (2 * (w & 1) + n2), 32 * k, lane); } }
    f32x4 cb0, cb1, cw0[4], cw1[4], bav[2], bxv[2], lcv[2];
#define LRU_CONSTS(n_) do { const int cgc = 64 * (n_) + j8; cb0 = *(const f32x4*)(p.in[I_ECONVB] + cgc); cb1 = *(const f32x4*)(p.in[I_ECONVB] + cgc + 4); \
        _Pragma("unroll") for (int j = 0; j < 4; ++j) { cw0[j] = *(const f32x4*)(p.in[I_ECONVW] + j * 512 + cgc); cw1[j] = *(const f32x4*)(p.in[I_ECONVW] + j * 512 + cgc + 4); } \
        _Pragma("unroll") for (int n2 = 0; n2 < 2; ++n2) { const int cg = 64 * (n_) + 16 * (2 * (w & 1) + n2) + 4 * fq; bav[n2] = *(const f32x4*)(p.in[I_ELRUBA] + cg); bxv[n2] = *(const f32x4*)(p.in[I_ELRUBX] + cg); lcv[n2] = *(const f32x4*)(c.LAMC() + cg); } } while (0)
    if (fixed_n) LRU_CONSTS(vb % 8);
    LruRows R = lru_load_rows(c, vb, final);
    for (int u = vb; u < NU; u += nvb) {
        const int b = u / (NCH * 8), rem = u % (NCH * 8), ch = rem / 8, n = rem % 8, t0 = ch * 64, cg0 = 64 * n + j8, t = t0 + i;
        if (!fixed_n) LRU_CONSTS(n);
        if (!fixed_n) {
#pragma unroll
            for (int n2 = 0; n2 < 2; ++n2)
#pragma unroll
                for (int k = 0; k < 2; ++k) { fwa[n2][k] = gfrag(c.WAt() + n * 4096, 64, 16 * (2 * (w & 1) + n2), 32 * k, lane); fwx[n2][k] = gfrag(c.WXt() + n * 4096, 64, 16 * (2 * (w & 1) + n2), 32 * k, lane); } }
        float ca = 1.f, chh = 0.f;
        float cra[17], crh[17];
        if (final) { const int chn = tid & 63, sg = tid >> 6;
#pragma unroll
            for (int j = 0; j < 17; ++j) { const int c2 = 17 * sg + j, c3 = c2 < NCH ? c2 : NCH - 1; const size_t s2i = ((size_t)b * NCH + c3) * 512 + 64 * n + chn; cra[j] = c.lruA()[s2i]; crh[j] = c.lruH()[s2i]; } }
        const u32x4 gbv = R.gb;
        { float xc[8];
            xc[0] = cb0[0]; xc[1] = cb0[1]; xc[2] = cb0[2]; xc[3] = cb0[3]; xc[4] = cb1[0]; xc[5] = cb1[1]; xc[6] = cb1[2]; xc[7] = cb1[3];
#pragma unroll
            for (int j = 0; j < 4; ++j) { float x[8]; unpack8(R.xv[j], x);
                const f32x4 w0 = cw0[j], w1 = cw1[j];
                xc[0] += w0[0] * x[0]; xc[1] += w0[1] * x[1]; xc[2] += w0[2] * x[2]; xc[3] += w0[3] * x[3];
                xc[4] += w1[0] * x[4]; xc[5] += w1[1] * x[5]; xc[6] += w1[2] * x[6]; xc[7] += w1[3] * x[7]; }
            *(LAS u32x4*)(XA + i * 72 + j8) = pack8(xc);
            *(LAS f32x4*)(XC + i * 64 + j8) = (f32x4){xc[0], xc[1], xc[2], xc[3]}; *(LAS f32x4*)(XC + i * 64 + j8 + 4) = (f32x4){xc[4], xc[5], xc[6], xc[7]}; }
        __builtin_amdgcn_sched_barrier(0);
        R = lru_load_rows(c, u + nvb < NU ? u + nvb : u, final);
        __builtin_amdgcn_sched_barrier(0);
        lds_barrier();
#pragma unroll
        for (int n2 = 0; n2 < 2; ++n2) { const int ni = 2 * (w & 1) + n2; f32x4 gr = (f32x4){0.f, 0.f, 0.f, 0.f}, gi = gr;
#pragma unroll
            for (int k = 0; k < 2; ++k) { const bf16x8 xa = ldfrag(XA, 72, 16 * mi, 32 * k, lane); gr = MFMA16(fwa[n2][k], xa, gr); gi = MFMA16(fwx[n2][k], xa, gi); }
            const int tt = 16 * mi + fr, j = 16 * ni + 4 * fq, cg = 64 * n + j;
            const f32x4 xc4 = *(const LAS f32x4*)(XC + tt * 64 + j), ba = bav[n2], bx = bxv[n2], lc = lcv[n2];
            f32x4 a4, u4;
            f32x4 gi4;
#pragma unroll
            for (int r = 0; r < 4; ++r) { const float g_r = fast_sigmoid(gr[r] + ba[r]); gi4[r] = fast_sigmoid(gi[r] + bx[r]); a4[r] = lc[r] * g_r; }
            const u32x2 lap = pk4(a4); const f32x4 laf = up4(lap);
#pragma unroll
            for (int r = 0; r < 4; ++r) { const float a = __expf(laf[r]); a4[r] = a; u4[r] = sqrtf(fmaxf(1.0f - a * a, 0.f)) * gi4[r] * xc4[r]; }
            const u32x2 up_ = pk4(u4); u4 = up4(up_);
            if (final) { *(LAS f32x4*)(AA + tt * 64 + j) = a4; *(LAS f32x4*)(UU + tt * 64 + j) = u4; }
            else {
#pragma unroll
                for (int r = 0; r < 4; ++r) { float A = a4[r], U = u4[r];
#define LRU_DPP_STEP(ctrl_) { const float Ap = __builtin_bit_cast(float, __builtin_amdgcn_update_dpp(0x3f800000, __builtin_bit_cast(int, A), ctrl_, 0xF, 0xF, false)); \
                              const float Up = __builtin_bit_cast(float, __builtin_amdgcn_update_dpp(0, __builtin_bit_cast(int, U), ctrl_, 0xF, 0xF, false)); U = A * Up + U; A = A * Ap; }
                    LRU_DPP_STEP(0x111) LRU_DPP_STEP(0x112) LRU_DPP_STEP(0x114) LRU_DPP_STEP(0x118)
#undef LRU_DPP_STEP
                    a4[r] = A; u4[r] = U; }
                if (fr == 15) { *(LAS f32x4*)(SEGA + mi * 64 + j) = a4; *(LAS f32x4*)(SEGH + mi * 64 + j) = u4; } }
            if (!c.dry) { *(u32x2*)(c.lruLA(b) + ((size_t)t0 + tt) * 512 + cg) = lap; *(u32x2*)(c.Y() + ((size_t)b * TP + t0 + tt) * 1024 + 512 + cg) = up_; } }
        lds_barrier();
        if (!final) {
            if (tid < 64) { const size_t si = ((size_t)b * NCH + ch) * 512 + 64 * n + tid; float cin = 0.f, at = 1.f;
#pragma unroll
                for (int s2 = 0; s2 < 4; ++s2) { const float a2 = SEGA[s2 * 64 + tid]; cin = a2 * cin + SEGH[s2 * 64 + tid]; at *= a2; }
                if (!c.dry) { c.lruA()[si] = at; c.lruH()[si] = cin; } } }
        else { const int chn = tid & 63, sg = tid >> 6; float ar[8], ur[8], h = 0.f, ap = 1.f;
#pragma unroll
            for (int q = 0; q < 8; ++q) { ar[q] = AA[(8 * sg + q) * 64 + chn]; ur[q] = UU[(8 * sg + q) * 64 + chn]; h = ar[q] * h + ur[q]; ap *= ar[q]; }
            SEGA[sg * 64 + chn] = ap; SEGH[sg * 64 + chn] = h;
            if (final) {
#pragma unroll
                for (int j = 0; j < 17; ++j) { const bool ok = (17 * sg + j) < ch; const float a2 = ok ? cra[j] : 1.f, h2 = ok ? crh[j] : 0.f; chh = a2 * chh + h2; ca *= a2; }
                CARA[sg * 64 + chn] = ca; CARH[sg * 64 + chn] = chh; }
            lds_barrier();
            const size_t si = ((size_t)b * NCH + ch) * 512 + 64 * n + chn;
            float cin = 0.f;
            if (!final) { if (sg == 7) { float at = 1.f;
#pragma unroll
                    for (int s2 = 0; s2 < 8; ++s2) { cin = SEGA[s2 * 64 + chn] * cin + SEGH[s2 * 64 + chn]; at *= SEGA[s2 * 64 + chn]; }
                    if (!c.dry) { c.lruA()[si] = at; c.lruH()[si] = cin; } } }
            else {
#pragma unroll
                for (int s2 = 0; s2 < 8; ++s2) cin = CARA[s2 * 64 + chn] * cin + CARH[s2 * 64 + chn];
                for (int s2 = 0; s2 < sg; ++s2) cin = SEGA[s2 * 64 + chn] * cin + SEGH[s2 * 64 + chn];
#pragma unroll
                for (int q = 0; q < 8; ++q) { cin = ar[q] * cin + ur[q]; UU[(8 * sg + q) * 64 + chn] = cin; } } }
        if (final) lds_barrier();
        if (final) { float g[8], o[8]; unpack8(gbv, g);
#pragma unroll
            for (int q = 0; q < 8; ++q) { const float x = g[q], uu2 = 1.5957691216057308f * (x + 0.044715f * x * x * x); o[q] = UU[i * 64 + j8 + q] * x * fast_sigmoid(uu2); }
            if (!c.dry) *(u32x4*)(c.Y() + ((size_t)b * TP + t) * 1024 + 512 + cg0) = pack8(o);
            lds_barrier(); }
    }
}
struct LruFin { u32x4 la, uu, gb; };
__device__ __forceinline__ LruFin lru_fin_load(const Ctx& c, const int u) {
    const int b = u / (NCH * 8), rem = u % (NCH * 8), ch = rem / 8, n = rem % 8;
    const int i = c.tid >> 3, cg0 = 64 * n + (c.tid & 7) * 8; const size_t t = (size_t)ch * 64 + i;
    LruFin R; R.la = *(const u32x4*)(c.lruLA(b) + t * 512 + cg0); R.uu = *(const u32x4*)(c.Y() + ((size_t)b * TP + t) * 1024 + 512 + cg0); R.gb = *(const u32x4*)(c.P() + ((size_t)b * TP + t) * EVEN_IN + 2304 + cg0);
    return R;
}
__device__ __forceinline__ void lru_final_run(const Ctx& c, const int vb, const int nvb) {
    const int tid = c.tid; const int NU = BATCH * NCH * 8;
    if (vb >= NU) return;
    lfloat* AA = (lfloat*)(c.lds + LDS_PH);
    lfloat* UU = AA + 4096;
    lfloat* SEGA = UU + 4096;
    lfloat* SEGH = SEGA + 512;
    lfloat* CARA = SEGH + 512;
    lfloat* CARH = CARA + 512;
    const int i = tid >> 3, j8 = (tid & 7) * 8, chn = tid & 63, sg = tid >> 6;
    LruFin R = lru_fin_load(c, vb);
    for (int u = vb; u < NU; u += nvb) {
        const int b = u / (NCH * 8), rem = u % (NCH * 8), ch = rem / 8, n = rem % 8, t0 = ch * 64;
        float cra[17], crh[17];
#pragma unroll
        for (int j = 0; j < 17; ++j) { const int c2 = 17 * sg + j, c3 = c2 < NCH ? c2 : NCH - 1; const size_t s2i = ((size_t)b * NCH + c3) * 512 + 64 * n + chn; cra[j] = c.lruA()[s2i]; crh[j] = c.lruH()[s2i]; }
        { float la[8], uu[8]; unpack8(R.la, la); unpack8(R.uu, uu);
            *(LAS f32x4*)(AA + i * 64 + j8) = (f32x4){__expf(la[0]), __expf(la[1]), __expf(la[2]), __expf(la[3])}; *(LAS f32x4*)(AA + i * 64 + j8 + 4) = (f32x4){__expf(la[4]), __expf(la[5]), __expf(la[6]), __expf(la[7])};
            *(LAS f32x4*)(UU + i * 64 + j8) = (f32x4){uu[0], uu[1], uu[2], uu[3]}; *(LAS f32x4*)(UU + i * 64 + j8 + 4) = (f32x4){uu[4], uu[5], uu[6], uu[7]}; }
        const u32x4 gbv = R.gb;
        __builtin_amdgcn_sched_barrier(0);
        R = lru_fin_load(c, u + nvb < NU ? u + nvb : u);
        __builtin_amdgcn_sched_barrier(0);
        lds_barrier();
        { float ar[8], ur[8], h = 0.f, ap = 1.f;
#pragma unroll
            for (int q = 0; q < 8; ++q) { ar[q] = AA[(8 * sg + q) * 64 + chn]; ur[q] = UU[(8 * sg + q) * 64 + chn]; h = ar[q] * h + ur[q]; ap *= ar[q]; }
            SEGA[sg * 64 + chn] = ap; SEGH[sg * 64 + chn] = h;
            float ca = 1.f, chh = 0.f;
#pragma unroll
            for (int j = 0; j < 17; ++j) { const bool ok = (17 * sg + j) < ch; const float a2 = ok ? cra[j] : 1.f, h2 = ok ? crh[j] : 0.f; chh = a2 * chh + h2; ca *= a2; }
            CARA[sg * 64 + chn] = ca; CARH[sg * 64 + chn] = chh;
            lds_barrier();
            float cin = 0.f;
#pragma unroll
            for (int s2 = 0; s2 < 8; ++s2) cin = CARA[s2 * 64 + chn] * cin + CARH[s2 * 64 + chn];
            for (int s2 = 0; s2 < sg; ++s2) cin = SEGA[s2 * 64 + chn] * cin + SEGH[s2 * 64 + chn];
#pragma unroll
            for (int q = 0; q < 8; ++q) { cin = ar[q] * cin + ur[q]; UU[(8 * sg + q) * 64 + chn] = cin; } }
        lds_barrier();
        { float g[8], o[8]; unpack8(gbv, g);
#pragma unroll
            for (int q = 0; q < 8; ++q) { const float x = g[q], uu2 = 1.5957691216057308f * (x + 0.044715f * x * x * x); o[q] = UU[i * 64 + j8 + q] * x * fast_sigmoid(uu2); }
            if (!c.dry) *(u32x4*)(c.Y() + ((size_t)b * TP + t0 + i) * 1024 + 512 + 64 * n + j8) = pack8(o); }
        lds_barrier();
    }
}
__device__ __forceinline__ void ph_lru2(const Ctx& c, const bool final) { lru_run(c, final, (c.G % 8 == 0) ? (c.G - 8 - (c.bid & ~7)) + (c.bid & 7) : c.bid, c.G); }

constexpr int RS = 64 * 72;
__device__ __forceinline__ bool rwkv_s1_task(const int tid, int& q, int& rb) {
    if (tid < 192) { const int g = tid % 24; rb = tid / 24; q = g < 8 ? 24 + g : 32 + g; return true; }
    if (tid < 448) { const int t2 = tid - 192, g = t2 & 31; rb = t2 >> 5; q = g < 24 ? g : 8 + g; return true; }
    q = 0; rb = 0; return false;
}
__device__ __forceinline__ int rwkv_col_of(const int q, const int h) { return q < 8 ? h * 64 + 8 * q : q < 16 ? 512 + h * 64 + 8 * (q - 8) : q < 24 ? 1024 + h * 64 + 8 * (q - 16) : 1536 + 8 * (q - 24); }
__device__ __forceinline__ void rwkv_load_rows(const Ctx& c, const int u, u32x4 (&xv)[9], f32x4 (&mv)[2]) {
    const int b = u / (8 * NCH), h = (u / NCH) % 8, ch = u % NCH, t0 = ch * 64;
    int q, rb;
    if (rwkv_s1_task(c.tid, q, rb)) { const int col = rwkv_col_of(q, h);
        mv[0] = *(const f32x4*)(c.p->in[I_EMU] + col); mv[1] = *(const f32x4*)(c.p->in[I_EMU] + col + 4);
#pragma unroll
        for (int j = 0; j < 9; ++j) { const int t = t0 + 8 * rb - 1 + j; const bool ok = t >= 0 && t < TT;
            const u32x4 x = *(const u32x4*)(c.P() + ((size_t)b * TP + (ok ? t : 0)) * EVEN_IN + col);
            xv[j] = ok ? x : (u32x4){0u, 0u, 0u, 0u}; } }
}
__device__ __forceinline__ void rwkv_prep_unit(const Ctx& c, const int u, u32x4 (&xv)[9], f32x4 (&mv)[2], const int unext) {
    const Params& p = *c.p; const int tid = c.tid, lane = c.lane, w = c.wave;
    const int b = u / (8 * NCH), h = (u / NCH) % 8, ch = u % NCH, t0 = ch * 64;
    lbf* S = (lbf*)(c.lds + LDS_PH);
    lbf *sKK = S, *sBB = S + RS, *sKM = S + 2 * RS, *sV = S + 3 * RS, *sR = S + 4 * RS, *sBh = S + 5 * RS, *sKh = S + 6 * RS, *sVc = S + 7 * RS, *sYA = S + 8 * RS,
        *sP1r = S + 10 * RS, *sP1c = S + 11 * RS, *sMak = S + 12 * RS, *sMrb = S + 13 * RS, *sMrk = S + 14 * RS;
    lfloat* CUM = (lfloat*)(S + 15 * RS);
    lfloat* BON = CUM + 4096;
    lfloat* SEG = BON + 64;
    lfloat* CST = SEG + 512;
    lfloat* A32 = (lfloat*)sP1r;
    lbf* sGD = sYA;
    const int mi = w >> 1, nb2 = 2 * (w & 1);
    const int fr = lane & 15, fq = lane >> 4;
    bf16x8 fDU[2][2], fIU[2][2], fGU[2][4];
#define RW_LORA_LOADS() do { _Pragma("unroll") for (int n2 = 0; n2 < 2; ++n2) { _Pragma("unroll") for (int k = 0; k < 2; ++k) { \
        fDU[n2][k] = gfrag(c.DUt(), 64, h * 64 + 16 * (nb2 + n2), 32 * k, lane); fIU[n2][k] = gfrag(c.IUt(), 64, h * 64 + 16 * (nb2 + n2), 32 * k, lane); } } } while (0)
    { int q, rb;
      if (rwkv_s1_task(tid, q, rb)) {
        int col, ld = 72; lbf* dst;
        if (q < 8) { col = h * 64 + 8 * q; dst = sR + 8 * q; }
        else if (q < 16) { col = 512 + h * 64 + 8 * (q - 8); dst = sKM + 8 * (q - 8); }
        else if (q < 24) { col = 1024 + h * 64 + 8 * (q - 16); dst = sV + 8 * (q - 16); }
        else if (q < 32) { col = 1536 + 8 * (q - 24); dst = sBh + 8 * (q - 24); }
        else if (q < 40) { col = 1600 + 8 * (q - 32); dst = sKh + 8 * (q - 32); }
        else { col = 1664 + 8 * (q - 40); dst = sGD + 8 * (q - 40); ld = 136; }
        const bool is_tanh = q < 32;
        float m8[8];
        { const f32x4 m0 = mv[0], m1 = mv[1]; m8[0] = m0[0]; m8[1] = m0[1]; m8[2] = m0[2]; m8[3] = m0[3]; m8[4] = m1[0]; m8[5] = m1[1]; m8[6] = m1[2]; m8[7] = m1[3]; }
        const float sc = is_tanh ? -2.0f : -1.0f;
        float pv[8]; unpack8(xv[0], pv);
        asm volatile("" :: "v"(xv[8]), "v"(mv[1]));
        __builtin_amdgcn_sched_barrier(0); RW_LORA_LOADS(); __builtin_amdgcn_sched_barrier(0);
        lbf* dp = dst + 8 * rb * ld;
#pragma unroll
        for (int j = 0; j < 8; ++j) { float x[8]; unpack8(xv[j + 1], x); float o[8];
            const bool valid = (t0 + 8 * rb + j) < TT;
#pragma unroll
            for (int k = 0; k < 8; ++k) { o[k] = x[k] + m8[k] * (pv[k] - x[k]); pv[k] = x[k]; }
            if (w < 3) {
#pragma unroll
                for (int k = 0; k < 8; ++k) { const float sg = __builtin_amdgcn_rcpf(1.0f + __expf(sc * o[k])); o[k] = is_tanh ? 2.0f * sg - 1.0f : sg; }
                asm volatile("" ::: "memory"); }
#pragma unroll
            for (int k = 0; k < 8; ++k) o[k] = valid ? o[k] : 0.f;
            *(LAS u32x4*)dp = pack8(o); dp += ld; } }
      else { const int hl = h * 64 + lane;
        RW_LORA_LOADS();
        CST[lane] = p.in[I_EKK][hl]; CST[64 + lane] = p.in[I_EKA][hl]; CST[128 + lane] = p.in[I_ERK][hl]; CST[192 + lane] = p.in[I_EDECAY0][hl]; CST[256 + lane] = p.in[I_EICLR0][hl];
        CST[320 + lane] = p.in[I_ELNG][hl]; CST[384 + lane] = p.in[I_ELNB][hl]; } }
#undef RW_LORA_LOADS
    rwkv_load_rows(c, unext < NRU ? unext : NRU - 1, xv, mv);
    lds_barrier();
#pragma unroll
    for (int n2 = 0; n2 < 2; ++n2) { const int ni = nb2 + n2;
        f32x4 aw = (f32x4){0.f, 0.f, 0.f, 0.f}, aa = aw;
#pragma unroll
        for (int k0 = 0; k0 < 64; k0 += 32) { const bf16x8 fw = ldfrag(sBh, 72, 16 * mi, k0, lane), fa = ldfrag(sKh, 72, 16 * mi, k0, lane);
            aw = MFMA16(fDU[n2][k0 >> 5], fw, aw); aa = MFMA16(fIU[n2][k0 >> 5], fa, aa); }
        const int i = 16 * mi + fr, j = 16 * ni + 4 * fq, hj = h * 64 + j;
        const f32x4 d0 = *(const LAS f32x4*)(CST + 192 + j), i0 = *(const LAS f32x4*)(CST + 256 + j);
        f32x4 lw, av;
#pragma unroll
        for (int r = 0; r < 4; ++r) { lw[r] = -0.6065306597126334f * fast_sigmoid(d0[r] + aw[r]);
            av[r] = fast_sigmoid(i0[r] + aa[r]); }
#pragma unroll
        for (int r = 0; r < 4; ++r) { float x = lw[r];
            x += __builtin_bit_cast(float, __builtin_amdgcn_update_dpp(0, __builtin_bit_cast(int, x), 0x111, 0xF, 0xF, true));
            x += __builtin_bit_cast(float, __builtin_amdgcn_update_dpp(0, __builtin_bit_cast(int, x), 0x112, 0xF, 0xF, true));
            x += __builtin_bit_cast(float, __builtin_amdgcn_update_dpp(0, __builtin_bit_cast(int, x), 0x114, 0xF, 0xF, true));
            x += __builtin_bit_cast(float, __builtin_amdgcn_update_dpp(0, __builtin_bit_cast(int, x), 0x118, 0xF, 0xF, true));
            lw[r] = x; }
        *(LAS f32x4*)(CUM + i * 64 + j) = lw; *(LAS f32x4*)(A32 + i * 64 + j) = av;
        if (fr == 15) *(LAS f32x4*)(SEG + mi * 64 + j) = lw; }
#pragma unroll
    for (int n2 = 0; n2 < 2; ++n2) {
#pragma unroll
        for (int k = 0; k < 4; ++k) fGU[n2][k] = gfrag(c.GUt(), 128, h * 64 + 16 * (nb2 + n2), 32 * k, lane); }
    lds_barrier();
    { const int i = tid >> 3, j8 = (tid & 7) * 8, hj = h * 64 + j8;
        float k[8], r[8], kx[8], ss = 0.f, bon = 0.f;
        unpack8(*(const LAS u32x4*)(sKM + i * 72 + j8), k); unpack8(*(const LAS u32x4*)(sR + i * 72 + j8), r);
#pragma unroll
        for (int q = 0; q < 8; ++q) { kx[q] = k[q] * CST[j8 + q]; ss += kx[q] * kx[q]; }
        ss = sum8(ss);
        const float inv = 1.0f / fmaxf(sqrtf(ss), 1e-12f);
        float kk[8], km[8], bb[8];
#pragma unroll
        for (int q = 0; q < 8; ++q) { const float a = A32[i * 64 + j8 + q]; kk[q] = kx[q] * inv; km[q] = k[q] * (1.0f + (a - 1.0f) * CST[64 + j8 + q]); bb[q] = kk[q] * a;
            bon += r[q] * km[q] * CST[128 + j8 + q]; }
        bon = sum8(bon);
        *(LAS u32x4*)(sKK + i * 72 + j8) = pack8(kk); *(LAS u32x4*)(sKM + i * 72 + j8) = pack8(km); *(LAS u32x4*)(sBB + i * 72 + j8) = pack8(bb);
        if ((tid & 7) == 0) BON[i] = bon; }
    lds_barrier();
#pragma unroll
    for (int n2 = 0; n2 < 2; ++n2) { const int ni = nb2 + n2;
        f32x4 ag = (f32x4){0.f, 0.f, 0.f, 0.f};
#pragma unroll
        for (int k0 = 0; k0 < 128; k0 += 32) ag = MFMA16(fGU[n2][k0 >> 5], ldfrag(sGD, 136, 16 * mi, k0, lane), ag);
        const int i = 16 * mi + fr, j = 16 * ni + 4 * fq, hj = h * 64 + j;
        const f32x4 lg = *(const LAS f32x4*)(CST + 320 + j), lb = *(const LAS f32x4*)(CST + 384 + j), v = up4(*(const LAS u32x2*)(sV + i * 72 + j));
        const float bon = BON[i]; f32x4 e1, e2;
#pragma unroll
        for (int r = 0; r < 4; ++r) { e1[r] = ag[r] * lg[r]; e2[r] = (lb[r] + bon * v[r]) * ag[r]; }
        if (!c.dry) *(u32x2*)(c.Y() + ((size_t)b * TP + t0 + i) * 1024 + hj) = pk4(e1);
        if (!c.dry) *(u32x2*)(c.rwE2() + (size_t)u * 4096 + i * 64 + j) = pk4(e2); }
    { const int i = tid >> 3, j8 = (tid & 7) * 8, sgi = i >> 4;
        float pre[8] = {0.f, 0.f, 0.f, 0.f, 0.f, 0.f, 0.f, 0.f};
        for (int s2 = 0; s2 < sgi; ++s2) { const f32x4 p0 = *(const LAS f32x4*)(SEG + s2 * 64 + j8), p1 = *(const LAS f32x4*)(SEG + s2 * 64 + j8 + 4);
            pre[0] += p0[0]; pre[1] += p0[1]; pre[2] += p0[2]; pre[3] += p0[3]; pre[4] += p1[0]; pre[5] += p1[1]; pre[6] += p1[2]; pre[7] += p1[3]; }
        float kk[8], bb[8], km[8], r[8];
        unpack8(*(const LAS u32x4*)(sKK + i * 72 + j8), kk); unpack8(*(const LAS u32x4*)(sBB + i * 72 + j8), bb);
        unpack8(*(const LAS u32x4*)(sKM + i * 72 + j8), km); unpack8(*(const LAS u32x4*)(sR + i * 72 + j8), r);
#pragma unroll
        for (int q = 0; q < 8; ++q) { const float cu = CUM[i * 64 + j8 + q] + pre[q], cp = ((i & 15) ? CUM[(i - 1) * 64 + j8 + q] : 0.f) + pre[q];
            const float en = __expf(-cu); kk[q] = -kk[q] * __expf(cp); bb[q] *= en; km[q] *= en; r[q] *= __expf(cu); }
        *(LAS u32x4*)(sKK + i * 72 + j8) = pack8(kk); *(LAS u32x4*)(sBB + i * 72 + j8) = pack8(bb);
        *(LAS u32x4*)(sKM + i * 72 + j8) = pack8(km); *(LAS u32x4*)(sR + i * 72 + j8) = pack8(r); }
    lfloat* GLL = (lfloat*)sVc;
    if (tid < 64) { float cl = CUM[63 * 64 + tid];
#pragma unroll
        for (int s2 = 0; s2 < 3; ++s2) cl += SEG[s2 * 64 + tid];
        const float gl = __expf(cl); GLL[tid] = gl;
        if (!c.dry) c.rwGL()[(size_t)u * 64 + tid] = gl; }
    lds_barrier();
    const f32x4 zero4 = (f32x4){0.f, 0.f, 0.f, 0.f};
    LAS u32x2* DBUF = (LAS u32x2*)sBh;
    for (int tl = w; tl < 16; tl += 8) { const int tm = tl >> 2, tn = tl & 3;
        f32x4 mab = zero4, mabc = zero4, mak = zero4, mrb = zero4, mrk = zero4;
        if (tn <= tm) {
#pragma unroll
            for (int k0 = 0; k0 < 64; k0 += 32) { const bf16x8 fa = ldfrag(sKK, 72, 16 * tm, k0, lane), frr = ldfrag(sR, 72, 16 * tm, k0, lane), fb = ldfrag(sBB, 72, 16 * tn, k0, lane), fk = ldfrag(sKM, 72, 16 * tn, k0, lane);
                mab = MFMA16(fb, fa, mab); mak = MFMA16(fk, fa, mak); mrb = MFMA16(fb, frr, mrb); mrk = MFMA16(fk, frr, mrk);
                mabc = MFMA16(fa, fb, mabc); }
            if (tn == tm) {
#pragma unroll
                for (int r = 0; r < 4; ++r) { const int t = fr, s2 = 4 * fq + r; const bool st = s2 < t, le = s2 <= t;
                    mab[r] = st ? mab[r] : 0.f; mak[r] = st ? mak[r] : 0.f; mrb[r] = le ? mrb[r] : 0.f; mrk[r] = le ? mrk[r] : 0.f;
                    mabc[r] = (fr < 4 * fq + r) ? mabc[r] : 0.f; }
                u32x2 MA = pk4(mab);
                u32x2 MB = pk4(mabc);
                f32x4 DA = up4(MA);
#pragma unroll
                for (int r = 0; r < 4; ++r) DA[r] += (fr == 4 * fq + r) ? 1.0f : 0.f;
#pragma unroll
                for (int k = 0; k < 3; ++k) {
                    const f32x4 mb2 = MFMA4(MA, MB, zero4);
                    const u32x2 pmb2 = pk4(mb2);
                    DA = MFMA4(pmb2, pk4(DA), DA);
                    if (k < 2) { const f32x4 ma2 = MFMA4(MB, MA, zero4);
                        MA = pk4(ma2); }
                    MB = pmb2; }
                DBUF[tm * 64 + lane] = pk4(DA); } }
        st4(sP1r, 72, 16 * tn, 16 * tm, mab, lane); st4(sMak, 72, 16 * tn, 16 * tm, mak, lane); st4(sMrb, 72, 16 * tn, 16 * tm, mrb, lane); st4(sMrk, 72, 16 * tn, 16 * tm, mrk, lane);
        st4(sP1c, 72, 16 * tm, 16 * tn, mabc, lane); }
    lds_barrier();
    const bool two = mi >= 2;
    { lbf* yrow = sYA + (16 * w + fr) * 72 + 4 * fq;
        f32x4 T0, T1, T2, T3;
        if (w < 4) {
            const lbf* ap = sKK + (4 * fq + (fr >> 2)) * 72 + 16 * w + 4 * (fr & 3);
#define TRJ(j_) up4(__builtin_bit_cast(u32x2, __builtin_amdgcn_ds_read_tr16_b64_v4i16((LAS s16x4v*)(ap + 16 * (j_) * 72))))
            T0 = TRJ(0); T1 = TRJ(1); T2 = TRJ(2); T3 = TRJ(3);
#undef TRJ
        } else {
            const bf16x8 vf0 = ldfrag_tr(sV, 72, 0, 16 * (w - 4), lane), vf1 = ldfrag_tr(sV, 72, 32, 16 * (w - 4), lane);
            T0 = MFMA16(ldfrag(sMak, 72, 0, 0, lane), vf0, zero4); T1 = MFMA16(ldfrag(sMak, 72, 16, 0, lane), vf0, zero4);
            T2 = MFMA16(ldfrag(sMak, 72, 32, 0, lane), vf0, zero4); T2 = MFMA16(ldfrag(sMak, 72, 32, 32, lane), vf1, T2);
            T3 = MFMA16(ldfrag(sMak, 72, 48, 0, lane), vf0, zero4); T3 = MFMA16(ldfrag(sMak, 72, 48, 32, lane), vf1, T3); }
        const u32x2 D0 = DBUF[lane], D1 = DBUF[64 + lane], D2 = DBUF[128 + lane], D3 = DBUF[192 + lane];
#define LFR(i_, j_) (*(const LAS u32x2*)(sP1r + (16 * (i_) + fr) * 72 + 16 * (j_) + 4 * fq))
        const u32x2 L10 = LFR(1, 0), L20 = LFR(2, 0), L21 = LFR(2, 1), L30 = LFR(3, 0), L31 = LFR(3, 1), L32 = LFR(3, 2);
#undef LFR
        const f32x4 X0 = MFMA4(D0, pk4(T0), zero4); const u32x2 p0 = pk4(X0);
        T1 = MFMA4(L10, p0, T1); T2 = MFMA4(L20, p0, T2); T3 = MFMA4(L30, p0, T3);
        const f32x4 X1 = MFMA4(D1, pk4(T1), zero4); const u32x2 p1 = pk4(X1);
        T2 = MFMA4(L21, p1, T2); T3 = MFMA4(L31, p1, T3);
        const f32x4 X2 = MFMA4(D2, pk4(T2), zero4); const u32x2 p2 = pk4(X2);
        T3 = MFMA4(L32, p2, T3);
        const f32x4 X3 = MFMA4(D3, pk4(T3), zero4);
        *(LAS u32x2*)(yrow) = p0; *(LAS u32x2*)(yrow + 16) = p1; *(LAS u32x2*)(yrow + 32) = p2; *(LAS u32x2*)(yrow + 48) = pk4(X3); }
    lds_barrier();
    const lbf* Wc = sYA; const lbf* Uc = sYA + 64 * 72;
    { const bf16x8 fmrb0 = ldfrag(sMrb, 72, 16 * mi, 0, lane), fmrb1 = ldfrag(sMrb, 72, 16 * mi, 32, lane), fmrk0 = ldfrag(sMrk, 72, 16 * mi, 0, lane), fmrk1 = ldfrag(sMrk, 72, 16 * mi, 32, lane);
        const bf16x8 fbh0 = ldfrag_tr(sBB, 72, 0, 16 * mi, lane), fbh1 = ldfrag_tr(sBB, 72, 32, 16 * mi, lane), fkh0 = ldfrag_tr(sKM, 72, 0, 16 * mi, lane), fkh1 = ldfrag_tr(sKM, 72, 32, 16 * mi, lane);
        const float glq = GLL[16 * mi + fr]; const f32x4 glp = *(const LAS f32x4*)(GLL + 16 * mi + 4 * fq);
#pragma unroll
        for (int n2 = 0; n2 < 2; ++n2) { const int ni = nb2 + n2;
            const bf16x8 fw0 = ldfrag(Wc, 72, 16 * ni, 0, lane), fw1 = ldfrag(Wc, 72, 16 * ni, 32, lane), fu0 = ldfrag(Uc, 72, 16 * ni, 0, lane), fu1 = ldfrag(Uc, 72, 16 * ni, 32, lane);
            const bf16x8 fv0 = ldfrag_tr(sV, 72, 0, 16 * ni, lane), fv1 = ldfrag_tr(sV, 72, 32, 16 * ni, lane);
            f32x4 aq = up4(*(const LAS u32x2*)(sR + (16 * mi + fr) * 72 + 16 * ni + 4 * fq));
            aq = MFMA16(fw0, fmrb0, aq);
            f32x4 ao = MFMA16(fu0, fmrb0, zero4); ao = MFMA16(fv0, fmrk0, ao);
            if (two) { aq = MFMA16(fw1, fmrb1, aq); ao = MFMA16(fu1, fmrb1, ao); ao = MFMA16(fv1, fmrk1, ao); }
            f32x4 ag = MFMA16(fw0, fbh0, zero4); ag = MFMA16(fw1, fbh1, ag); ag = ag * glq;
            f32x4 ah = MFMA16(fbh0, fu0, zero4); ah = MFMA16(fbh1, fu1, ah); ah = MFMA16(fkh0, fv0, ah); ah = MFMA16(fkh1, fv1, ah); ah = ah * glp;
            const size_t ub = (size_t)u * 4096;
            const int so = swz64(16 * mi + fr, 16 * ni + 4 * fq), sh = swz64(16 * ni + fr, 16 * mi + 4 * fq);
            if (!c.dry) { *(u32x2*)(c.rwQE() + ub + so) = pk4(aq);
                *(u32x2*)(c.rwOO() + ub + so) = pk4(ao);
                *(u32x2*)(c.rwGP() + ub + so) = pk4(ag);
                *(u32x2*)(c.rwHC() + ub + sh) = pk4(ah); } } }
    lds_barrier();
}

constexpr int RWR_SLOTB = 4 * 8192 + 2048;
__device__ __forceinline__ void rw_ring_issue(const Ctx& c, LAS unsigned char* slot, const size_t ug) {
    const int w = c.wave; const size_t ub = ug * 8192 + (size_t)w * 1024 + (size_t)c.lane * 16;
    __builtin_amdgcn_global_load_lds((const unsigned*)((const char*)c.rwGP() + ub), (LAS unsigned*)(slot + w * 1024), 16, 0, 0);
    __builtin_amdgcn_global_load_lds((const unsigned*)((const char*)c.rwQE() + ub), (LAS unsigned*)(slot + 8192 + w * 1024), 16, 0, 0);
    __builtin_amdgcn_global_load_lds((const unsigned*)((const char*)c.rwHC() + ub), (LAS unsigned*)(slot + 16384 + w * 1024), 16, 0, 0);
    __builtin_amdgcn_global_load_lds((const unsigned*)((const char*)c.rwOO() + ub), (LAS unsigned*)(slot + 24576 + w * 1024), 16, 0, 0);
    __builtin_amdgcn_global_load_lds((const unsigned*)((const char*)c.rwGL() + ug * 256 + (size_t)c.lane * 4), (LAS unsigned*)(slot + 32768 + w * 256), 4, 0, 0);
}
__device__ __forceinline__ void rwkv_seq_unit5(const Ctx& c, const int bh) {
    const int lane = c.lane, w = c.wave, fr = lane & 15, fq = lane >> 4, mi = w >> 1, nb2 = 2 * (w & 1);
    LAS unsigned char* ring = c.lds + LDS_PH;
    lbf* Zb = (lbf*)(ring + 4 * RWR_SLOTB);
    f32x4 z[2] = {(f32x4){0.f, 0.f, 0.f, 0.f}, (f32x4){0.f, 0.f, 0.f, 0.f}};
    const size_t u0 = (size_t)bh * NCH;
    rw_ring_issue(c, ring, u0); rw_ring_issue(c, ring + RWR_SLOTB, u0 + 1);
    st4(Zb, 72, 16 * mi, 16 * nb2, z[0], lane); st4(Zb, 72, 16 * mi, 16 * nb2 + 16, z[1], lane);
#define RW5_STEP(ch_, s4_, WAITN) do { const int ch = (ch_); \
        LAS unsigned char* SLB = ring + (s4_) * RWR_SLOTB; lbf* Zc = Zb + ((s4_) & 1) * RS; lbf* Zn = Zb + (((s4_) + 1) & 1) * RS; \
        asm volatile("s_waitcnt vmcnt(" #WAITN ")" ::: "memory"); \
        lds_barrier(); \
        { const int nx = ch + 2 < NCH ? ch + 2 : NCH - 1; rw_ring_issue(c, ring + (((s4_) + 2) & 3) * RWR_SLOTB, u0 + nx); }     \
        const lbf* GPm = (const lbf*)SLB; const lbf* QEm = GPm + 4096; const lbf* HCm = GPm + 8192; const lbf* OOm = GPm + 12288; \
        const size_t ub = (u0 + ch) * 4096; \
          \
        const f32x4 gl = *(const LAS f32x4*)((const LAS float*)(SLB + 32768 + w * 256) + 16 * mi + 4 * fq); \
        const bf16x8 g0 = ldfrag_sw(GPm, 16 * mi, 0, lane), g1 = ldfrag_sw(GPm, 16 * mi, 32, lane), q0 = ldfrag_sw(QEm, 16 * mi, 0, lane), q1 = ldfrag_sw(QEm, 16 * mi, 32, lane); \
        const u32x2 hc0 = *(const LAS u32x2*)(HCm + swz64(16 * nb2 + fr, 16 * mi + 4 * fq)), hc1 = *(const LAS u32x2*)(HCm + swz64(16 * nb2 + 16 + fr, 16 * mi + 4 * fq)); \
        const u32x2 oo0 = *(const LAS u32x2*)(OOm + swz64(16 * mi + fr, 16 * nb2 + 4 * fq)), oo1 = *(const LAS u32x2*)(OOm + swz64(16 * mi + fr, 16 * nb2 + 16 + 4 * fq)); \
        const bf16x8 fz00 = ldfrag(Zc, 72, 16 * nb2, 0, lane), fz01 = ldfrag(Zc, 72, 16 * nb2, 32, lane), fz10 = ldfrag(Zc, 72, 16 * nb2 + 16, 0, lane), fz11 = ldfrag(Zc, 72, 16 * nb2 + 16, 32, lane); \
        __builtin_amdgcn_sched_barrier(0); \
        f32x4 a0 = z[0] * gl + up4(hc0), a1 = z[1] * gl + up4(hc1), o0 = up4(oo0), o1 = up4(oo1); \
        a0 = MFMA16(g0, fz00, a0); a1 = MFMA16(g0, fz10, a1); a0 = MFMA16(g1, fz01, a0); a1 = MFMA16(g1, fz11, a1); \
        o0 = MFMA16(fz00, q0, o0); o1 = MFMA16(fz10, q0, o1); o0 = MFMA16(fz01, q1, o0); o1 = MFMA16(fz11, q1, o1); \
        z[0] = a0; z[1] = a1; \
        st4(Zn, 72, 16 * mi, 16 * nb2, a0, lane); st4(Zn, 72, 16 * mi, 16 * nb2 + 16, a1, lane);     \
        __builtin_amdgcn_sched_barrier(0); \
        { int l2 = lane; asm volatile("" : "+v"(l2)); \
          if (!c.dry) { *(u32x2*)(c.rwOO() + ub + (16 * mi + (l2 & 15)) * 64 + 16 * nb2 + 4 * (l2 >> 4)) = pk4(o0); *(u32x2*)(c.rwOO() + ub + (16 * mi + (l2 & 15)) * 64 + 16 * nb2 + 16 + 4 * (l2 >> 4)) = pk4(o1); } } \
    } while (0)
    RW5_STEP(0, 0, 5); RW5_STEP(1, 1, 7); RW5_STEP(2, 2, 9); RW5_STEP(3, 3, 9);
#pragma unroll 1
    for (int ch0 = 4; ch0 + 3 < NCH; ch0 += 4) { RW5_STEP(ch0, 0, 9); RW5_STEP(ch0 + 1, 1, 9); RW5_STEP(ch0 + 2, 2, 9); RW5_STEP(ch0 + 3, 3, 9); }
    RW5_STEP(NCH - 1, 0, 9);
#undef RW5_STEP
    asm volatile("s_waitcnt vmcnt(0)" ::: "memory");
    lds_barrier();
}
static_assert(NCH % 4 == 1, "scan loop shape");
static_assert(LDS_PH + 4 * RWR_SLOTB + 2 * RS * 2 <= LDS_BYTES, "scan ring");
__device__ __forceinline__ void ph_rwkv_prep(const Ctx& c) {
    if (c.bid >= NRU) return;
    u32x4 xv[9]; f32x4 mv[2];
    rwkv_load_rows(c, c.bid, xv, mv);
    for (int u = c.bid; u < NRU; u += c.G) rwkv_prep_unit(c, u, xv, mv, u + c.G);
}
__device__ __forceinline__ void ph_rwkv_seq(const Ctx& c) {
    if (c.G >= 128) {
        if (c.bid < 64) rwkv_seq_unit5(c, c.bid);
        else { const int vb = c.bid - 64, nvb = c.G - 64;
            lru_final_run(c, vb, nvb);
            filler_A(c, vb, nvb); }
    } else {
        for (int u = c.bid; u < 64; u += c.G) rwkv_seq_unit5(c, u);
        lru_final_run(c, c.bid, c.G);
        filler_A(c, c.bid, c.G);
    }
}
__device__ __forceinline__ void ph_rwkv_post(const Ctx& c) {
    if (c.bid >= NRU) return;
    const int i = c.tid >> 3, j8 = (c.tid & 7) * 8;
#define RP_LOAD(u_, xo, x1, x2) do { const int b_ = (u_) / (8 * NCH), h_ = ((u_) / NCH) % 8, ch_ = (u_) % NCH; \
        xo = *(const u32x4*)(c.rwOO() + (size_t)(u_) * 4096 + i * 64 + j8); x1 = *(const u32x4*)(c.Y() + ((size_t)b_ * TP + ch_ * 64 + i) * 1024 + h_ * 64 + j8); x2 = *(const u32x4*)(c.rwE2() + (size_t)(u_) * 4096 + i * 64 + j8); } while (0)
    u32x4 co, c1, c2;
    RP_LOAD(c.bid, co, c1, c2);
    for (int u = c.bid; u < NRU; u += c.G) {
        u32x4 no, n1, n2; { const int un = u + c.G < NRU ? u + c.G : u; RP_LOAD(un, no, n1, n2); }
        const int b = u / (8 * NCH), h = (u / NCH) % 8, ch = u % NCH;
        float o[8], e1[8], e2[8];
        bf16_t* yp = c.Y() + ((size_t)b * TP + ch * 64 + i) * 1024 + h * 64 + j8;
        unpack8(co, o); unpack8(c1, e1); unpack8(c2, e2);
        float s1 = 0.f;
#pragma unroll
        for (int q = 0; q < 8; ++q) s1 += o[q];
        s1 = sum8(s1); const float mean = s1 * (1.0f / 64.0f);
        float s2 = 0.f;
#pragma unroll
        for (int q = 0; q < 8; ++q) { const float d = o[q] - mean; s2 += d * d; }
        s2 = sum8(s2); const float rstd = rsqrtf(s2 * (1.0f / 64.0f) + 64e-5f);
        float y[8];
#pragma unroll
        for (int q = 0; q < 8; ++q) y[q] = (o[q] - mean) * rstd * e1[q] + e2[q];
        if (!c.dry) *(u32x4*)yp = pack8(y);
        co = no; c1 = n1; c2 = n2;
    }
#undef RP_LOAD
}

constexpr int SELCAP = 1088;
__device__ __forceinline__ void ph_router4(const Ctx& c, const int l) {
    const Params& p = *c.p; const int tid = c.tid, lane = c.lane, w = c.wave, fr = lane & 15, fq = lane >> 4;
    lfloat* PART = (lfloat*)(c.lds + LDS_PH);
    lfloat* SSQ = PART + 8 * 32 * 48;
    lfloat* SROW = SSQ + 256;
    lfloat* LG = SROW + 32;
    lint* sel_e = (lint*)(LG + 32 * 48);
    lfloat* sel_w = (lfloat*)(sel_e + 2 * SELCAP);
    lint* sel_row = (lint*)(sel_w + 2 * SELCAP);
    lint* sel_pos = sel_row + SELCAP;
    lfloat* sel_s = (lfloat*)(sel_pos + 2 * SELCAP);
    lint* lcnt = (lint*)(sel_s + SELCAP);
    lint* gbase = lcnt + 32;
    if (tid < 32) lcnt[tid] = 0;
    const bf16_t* WH = c.WrH() + (size_t)l * 48 * 1024; const bf16_t* WL = c.WrL() + (size_t)l * 48 * 1024;
    const float* bg = p.in[I_MBGROUP] + l * 4; const float* br = p.in[I_MBROUTER] + l * 32;
    bf16x8 bh[3][4], bl[3][4];
#pragma unroll
    for (int ni = 0; ni < 3; ++ni)
#pragma unroll
        for (int ks = 0; ks < 4; ++ks) { bh[ni][ks] = gfrag(WH, 1024, 16 * ni, 128 * w + 32 * ks, lane); bl[ni][ks] = gfrag(WL, 1024, 16 * ni, 128 * w + 32 * ks, lane); }
    const int cb = 128 * w + 8 * fq;
    int nloc = 0;
    u32x4 hN[2][4];
    for (int it = 0;; ++it) {
        const int idx0 = (it * c.G + c.bid) * 32; if (idx0 >= NTOK) break;
        nloc = it * 32 + 32;
#define RT_LOAD(dst_, idx0_) do { _Pragma("unroll") for (int mi_ = 0; mi_ < 2; ++mi_) { const int idx = (idx0_) + 16 * mi_ + fr, idc = idx < NTOK ? idx : NTOK - 1; const int b = idc / TT, t = idc % TT; \
            const bf16_t* hrow = c.H() + (size_t)(b * TP + t) * 1024 + cb; \
            _Pragma("unroll") for (int ks = 0; ks < 4; ++ks) dst_[mi_][ks] = *(const u32x4*)(hrow + 32 * ks); } } while (0)
        u32x4 hC[2][4];
        if (it == 0) RT_LOAD(hN, idx0);
#pragma unroll
        for (int mi = 0; mi < 2; ++mi)
#pragma unroll
            for (int ks = 0; ks < 4; ++ks) hC[mi][ks] = hN[mi][ks];
        RT_LOAD(hN, idx0 + c.G * 32);
#pragma unroll
        for (int mi = 0; mi < 2; ++mi) { float ss = 0.f;
#pragma unroll
            for (int ks = 0; ks < 4; ++ks) { float hb[8]; unpack8(hC[mi][ks], hb);
                ss += hb[0] * hb[0] + hb[1] * hb[1] + hb[2] * hb[2] + hb[3] * hb[3] + hb[4] * hb[4] + hb[5] * hb[5] + hb[6] * hb[6] + hb[7] * hb[7]; }
            ss += __shfl_xor(ss, 16); ss += __shfl_xor(ss, 32);
            if (fq == 0) SSQ[w * 32 + 16 * mi + fr] = ss;
#pragma unroll
            for (int ni = 0; ni < 3; ++ni) { f32x4 acc = (f32x4){0.f, 0.f, 0.f, 0.f};
#pragma unroll
                for (int ks = 0; ks < 4; ++ks) { const bf16x8 ah = __builtin_bit_cast(bf16x8, hC[mi][ks]); acc = MFMA16(ah, bh[ni][ks], acc); acc = MFMA16(ah, bl[ni][ks], acc); }
#pragma unroll
                for (int r = 0; r < 4; ++r) PART[(w * 32 + 16 * mi + 4 * fq + r) * 48 + 16 * ni + fr] = acc[r]; } }
        __syncthreads();
        { const int t = tid >> 4, e3 = tid & 15;
            float ssum = 0.f;
#pragma unroll
            for (int k = 0; k < 8; ++k) ssum += SSQ[k * 32 + t];
            const float s = rsqrtf(ssum * (1.0f / 1024.0f) + 1e-6f);
            if (e3 == 0) SROW[t] = s;
#pragma unroll
            for (int j = 0; j < 3; ++j) { const int e = e3 + 16 * j; float a = 0.f;
#pragma unroll
                for (int k = 0; k < 8; ++k) a += PART[(k * 32 + t) * 48 + e];
                LG[t * 48 + e] = a * s; } }
        __syncthreads();
        if (tid < 32) { const int idx = idx0 + tid, slot = it * 32 + tid;
            if (idx < NTOK) { const lfloat* lg = LG + tid * 48;
                const float g0 = lg[0] + bg[0], g1 = lg[1] + bg[1], g2 = lg[2] + bg[2], g3 = lg[3] + bg[3];
                int gi = 0; float gm = g0; if (g1 > gm) { gm = g1; gi = 1; } if (g2 > gm) { gm = g2; gi = 2; } if (g3 > gm) { gm = g3; gi = 3; }
                const float gprob = 1.0f / (__expf(g0 - gm) + __expf(g1 - gm) + __expf(g2 - gm) + __expf(g3 - gm));
                float el[8];
#pragma unroll
                for (int j = 0; j < 8; ++j) el[j] = lg[4 + gi * 8 + j] + br[gi * 8 + j];
                int i1 = 0; float v1 = el[0];
#pragma unroll
                for (int j = 1; j < 8; ++j) if (el[j] > v1) { v1 = el[j]; i1 = j; }
                int i2 = -1; float v2 = -3.0e38f;
#pragma unroll
                for (int j = 0; j < 8; ++j) if (j != i1 && el[j] > v2) { v2 = el[j]; i2 = j; }
                if (i2 < 0) { i2 = (i1 + 1) & 7; v2 = v1; }
                const float e2 = __expf(v2 - v1), w1 = gprob / (1.0f + e2), w2 = gprob * e2 / (1.0f + e2);
                const int b = idx / TT, t = idx % TT;
                sel_e[slot] = gi * 8 + i1; sel_e[SELCAP + slot] = gi * 8 + i2; sel_w[slot] = w1; sel_w[SELCAP + slot] = w2; sel_row[slot] = b * TP + t; sel_s[slot] = SROW[tid];
            } else sel_row[slot] = -1; }
        __syncthreads();
    }
    __syncthreads();
    for (int sx = tid; sx < nloc; sx += NTHREADS) if (sel_row[sx] >= 0) { sel_pos[sx] = __hip_atomic_fetch_add(&lcnt[sel_e[sx]], 1, __ATOMIC_RELAXED, __HIP_MEMORY_SCOPE_WORKGROUP); sel_pos[SELCAP + sx] = __hip_atomic_fetch_add(&lcnt[sel_e[SELCAP + sx]], 1, __ATOMIC_RELAXED, __HIP_MEMORY_SCOPE_WORKGROUP); }
    __syncthreads();
    if (tid < 32) gbase[tid] = (lcnt[tid] > 0 && !c.dry) ? atomicAdd(&c.mcnt()[l * 32 + tid], lcnt[tid]) : 0;
    __syncthreads();
    for (int sx = tid; sx < nloc; sx += NTHREADS) if (sel_row[sx] >= 0 && !c.dry) {
#pragma unroll
        for (int sl = 0; sl < 2; ++sl) { const int e = sel_e[sl * SELCAP + sx]; const size_t pos = (size_t)e * MCAP + gbase[e] + sel_pos[sl * SELCAP + sx];
            c.mlist()[pos] = sel_row[sx] * 2 + sl; c.mlw()[pos] = sel_w[sl * SELCAP + sx]; c.mls()[pos] = sel_s[sx]; } }
    __syncthreads();
}

__device__ __forceinline__ void ph_combine_norm(const Ctx& c, const float* gain, const int mode) {
    f32x4 gv[4];
#pragma unroll
    for (int i = 0; i < 4; ++i) gv[i] = *(const f32x4*)(gain + 4 * c.lane + 256 * i);
    for (int row = c.bid * 8 + c.wave; row < NP; row += c.G * 8) {
        const int b = row / TP, t = row % TP;
        if (t >= TT) { if (mode == 0) { bf16_t* zrow = c.H() + (size_t)row * 1024;
#pragma unroll
                for (int i = 0; i < 4; ++i) if (!c.dry) *(u32x2*)(zrow + 4 * c.lane + 256 * i) = (u32x2){0u, 0u};
                if (c.lane == 0 && !c.dry) c.srow()[row] = 0.f; }
            continue; }
        if (mode == 1 && t < NMETA) continue;
        bf16_t* hrow = c.H() + (size_t)row * 1024; const bf16_t* y0 = c.YM() + (size_t)row * 2048; const bf16_t* y1 = y0 + 1024;
        f32x4 v[4]; float ss = 0.f;
#pragma unroll
        for (int i = 0; i < 4; ++i) { v[i] = up4(*(const u32x2*)(hrow + 4 * c.lane + 256 * i));
            const u32x2 a = *(const u32x2*)(y0 + 4 * c.lane + 256 * i), d = *(const u32x2*)(y1 + 4 * c.lane + 256 * i);
            v[i][0] += bf2f(a.x & 0xffffu) + bf2f(d.x & 0xffffu); v[i][1] += bf2f(a.x >> 16) + bf2f(d.x >> 16);
            v[i][2] += bf2f(a.y & 0xffffu) + bf2f(d.y & 0xffffu); v[i][3] += bf2f(a.y >> 16) + bf2f(d.y >> 16);
            ss += v[i][0] * v[i][0] + v[i][1] * v[i][1] + v[i][2] * v[i][2] + v[i][3] * v[i][3]; }
        ss = wave_sum(ss);
        const float s = rsqrtf(ss * (1.0f / 1024.0f) + 1e-6f);
        float* orow = c.p->out + ((size_t)b * SEQ + (t - NMETA)) * 1024;
        if (mode == 0 && c.lane == 0 && !c.dry) c.srow()[row] = s;
#pragma unroll
        for (int i = 0; i < 4; ++i) {
            if (mode == 0) { if (!c.dry) *(u32x2*)(hrow + 4 * c.lane + 256 * i) = pk4(v[i]); }
            else { const f32x4 g = gv[i]; f32x4 o; o[0] = v[i][0] * s * g[0]; o[1] = v[i][1] * s * g[1]; o[2] = v[i][2] * s * g[2]; o[3] = v[i][3] * s * g[3]; if (!c.dry) *(f32x4*)(orow + 4 * c.lane + 256 * i) = o; } }
    }
}

__device__ __forceinline__ void moe_table(const Ctx& c, const int l) {
    lint* ts = (lint*)(c.lds + LDS_MISC);
    if (c.tid < 64) { const int v = c.tid < 32 ? (c.mcnt()[l * 32 + c.tid] + 255) >> 8 : 0; int inc = v;
#pragma unroll
        for (int d = 1; d < 32; d <<= 1) { const int o = __shfl_up(inc, d); if (c.tid >= d) inc += o; }
        if (c.tid < 32) { ts[c.tid] = inc - v; ts[33 + c.tid] = c.mcnt()[l * 32 + c.tid]; }
        if (c.tid == 31) ts[32] = inc; }
    __syncthreads();
}

__device__ __forceinline__ float logsigmoidf_(float x) { return fminf(x, 0.f) - log1pf(__expf(-fabsf(x))); }
__device__ __forceinline__ float fast_logsigmoid(float x) { return fminf(x, 0.f) - __logf(1.0f + __expf(-fabsf(x))); }
struct GlaPrepLoads { u32x4 q0, q1, k0, k1, vv[4], gd; };
__device__ __forceinline__ void gla_prep_load(const Ctx& c, const int u, GlaPrepLoads& L) {
    const int b = u / (4 * NCH), hd = (u / NCH) % 4, ch = u % NCH, tid = c.tid;
    const int i = tid >> 3, j16 = (tid & 7) * 16, d32 = (tid & 7) * 32;
    const bf16_t* rp = c.P() + ((size_t)b * TP + ch * 64 + i) * ODD_IN;
    L.q0 = *(const u32x4*)(rp + hd * 128 + j16); L.q1 = *(const u32x4*)(rp + hd * 128 + j16 + 8);
    L.k0 = *(const u32x4*)(rp + 512 + hd * 128 + j16); L.k1 = *(const u32x4*)(rp + 512 + hd * 128 + j16 + 8);
#pragma unroll
    for (int q = 0; q < 4; ++q) L.vv[q] = *(const u32x4*)(rp + 1024 + hd * 256 + d32 + 8 * q);
    L.gd = *(const u32x4*)(c.P() + ((size_t)b * TP + ch * 64 + 16 * (c.wave >> 1) + (c.lane & 15)) * ODD_IN + 2048 + 8 * ((c.lane >> 4) & 1));
}
__device__ __forceinline__ void gla_prep_unit(const Ctx& c, const int u, GlaPrepLoads& L, const int unext) {
    const Params& p = *c.p; const int tid = c.tid, lane = c.lane, w = c.wave, fr = lane & 15, fq = lane >> 4;
    const int b = u / (4 * NCH), hd = (u / NCH) % 4, ch = u % NCH;
    const size_t row0 = (size_t)b * TP + ch * 64;
    lbf* Qr = (lbf*)(c.lds + LDS_PH);
    lbf* Kr = Qr + 64 * 136;
    lbf* KHc = Kr + 64 * 136;
    lbf* Vc = KHc + 128 * 72;
    lfloat* GLB = (lfloat*)Vc;
    lbf* Sr = Vc + 256 * 72;
    lfloat* CUM = (lfloat*)(Sr + 64 * 72);
    lbf* Vr = (lbf*)CUM; constexpr int VRS = 272;
    lfloat* GD = CUM + 64 * 128;
    lbf* GDb = (lbf*)GD;
    lfloat* SEG = GD + 1024;
    const float* g_up = p.in[I_OGUP]; const float* g_b = p.in[I_OGB];
    const int i = tid >> 3, j16 = (tid & 7) * 16, d32 = (tid & 7) * 32;
    bf16x8 fgu[4]; f32x4 gbv[4];
#pragma unroll
    for (int n4 = 0; n4 < 4; ++n4) { const int ni = 4 * (w & 1) + n4; fgu[n4] = gfrag(c.GLUt(), 32, hd * 128 + 16 * ni, 0, lane); gbv[n4] = *(const f32x4*)(g_b + hd * 128 + 16 * ni + 4 * (lane >> 4)); }
    const u32x4 q0 = L.q0, q1 = L.q1, k0 = L.k0, k1 = L.k1;
    const bf16x8 gdf = __builtin_bit_cast(bf16x8, fq < 2 ? L.gd : (u32x4){0u, 0u, 0u, 0u});
    { const int ti = w >> 1;
#pragma unroll
        for (int n4 = 0; n4 < 4; ++n4) { const int ni = 4 * (w & 1) + n4;
            const f32x4 z4 = (f32x4){0.f, 0.f, 0.f, 0.f};
            const f32x4 acc = MFMA16(fgu[n4], gdf, z4);
            const f32x4 gb4 = gbv[n4]; f32x4 la;
#pragma unroll
            for (int r = 0; r < 4; ++r) la[r] = fast_logsigmoid(acc[r] + gb4[r]) * (1.0f / 16.0f);
#pragma unroll
            for (int r = 0; r < 4; ++r) { float x = la[r];
                x += __builtin_bit_cast(float, __builtin_amdgcn_update_dpp(0, __builtin_bit_cast(int, x), 0x111, 0xF, 0xF, true));
                x += __builtin_bit_cast(float, __builtin_amdgcn_update_dpp(0, __builtin_bit_cast(int, x), 0x112, 0xF, 0xF, true));
                x += __builtin_bit_cast(float, __builtin_amdgcn_update_dpp(0, __builtin_bit_cast(int, x), 0x114, 0xF, 0xF, true));
                x += __builtin_bit_cast(float, __builtin_amdgcn_update_dpp(0, __builtin_bit_cast(int, x), 0x118, 0xF, 0xF, true));
                la[r] = x; }
            *(LAS f32x4*)(CUM + (16 * ti + fr) * 128 + 16 * ni + 4 * fq) = la;
            if (fr == 15) *(LAS f32x4*)(SEG + ti * 128 + 16 * ni + 4 * fq) = la; } }
    lds_barrier();
    { float q[16], k[16]; unpack8(q0, q); unpack8(q1, q + 8); unpack8(k0, k); unpack8(k1, k + 8);
        float pre[16];
#pragma unroll
        for (int e = 0; e < 16; ++e) pre[e] = 0.f;
        for (int s2 = 0; s2 < (w >> 1); ++s2) {
#pragma unroll
            for (int e4 = 0; e4 < 4; ++e4) { const f32x4 pv = *(const LAS f32x4*)(SEG + s2 * 128 + j16 + 4 * e4); pre[4 * e4] += pv[0]; pre[4 * e4 + 1] += pv[1]; pre[4 * e4 + 2] += pv[2]; pre[4 * e4 + 3] += pv[3]; } }
#pragma unroll
        for (int e = 0; e < 16; ++e) { const float cu = CUM[i * 128 + j16 + e] + pre[e]; q[e] = q[e] * 0.08838834764831845f * __expf(cu); k[e] = k[e] * __expf(-cu); }
        const u32x4 qa = pack8(q), qb = pack8(q + 8);
        *(LAS u32x4*)(Qr + i * 136 + j16) = qa; *(LAS u32x4*)(Qr + i * 136 + j16 + 8) = qb;
        *(LAS u32x4*)(Kr + i * 136 + j16) = pack8(k); *(LAS u32x4*)(Kr + i * 136 + j16 + 8) = pack8(k + 8);
        bf16_t* wp = c.P() + (row0 + i) * ODD_IN + hd * 128 + j16;
        if (!c.dry) { *(u32x4*)wp = qa; *(u32x4*)(wp + 8) = qb; } }
    float gl = 0.f;
    if (tid < 128) { gl = __expf(CUM[63 * 128 + tid] + SEG[tid] + SEG[128 + tid] + SEG[256 + tid]); GLB[tid] = gl; if (!c.dry) c.glaG()[(size_t)u * 128 + tid] = gl; }
    lds_barrier();
#pragma unroll
    for (int q = 0; q < 4; ++q) *(LAS u32x4*)(Vr + i * VRS + d32 + 8 * q) = L.vv[q];
    __builtin_amdgcn_sched_barrier(0);
    gla_prep_load(c, unext < BATCH * 4 * NCH ? unext : u, L);
    __builtin_amdgcn_sched_barrier(0);
    { const int k = tid & 127, i16 = (tid >> 7) * 16; const float g = GLB[k]; float o[16];
#pragma unroll
        for (int q = 0; q < 16; ++q) o[q] = bf2f(Kr[(i16 + q) * 136 + k]) * g;
        const u32x4 oa = pack8(o), ob = pack8(o + 8);
        bf16_t* gp = c.gKH() + (size_t)u * 8192 + k * 64 + i16;
        if (!c.dry) { *(u32x4*)gp = oa; *(u32x4*)(gp + 8) = ob; } }
    { const int ti = w >> 1;
#pragma unroll
        for (int n2 = 0; n2 < 2; ++n2) { const int si = 2 * (w & 1) + n2; f32x4 acc = (f32x4){0.f, 0.f, 0.f, 0.f};
            if (si <= ti) {
#pragma unroll
                for (int kk = 0; kk < 128; kk += 32) acc = MFMA16(ldfrag(Kr, 136, 16 * si, kk, lane), ldfrag(Qr, 136, 16 * ti, kk, lane), acc);
#pragma unroll
                for (int r = 0; r < 4; ++r) { const int t = 16 * ti + fr, s2 = 16 * si + 4 * fq + r; acc[r] = (s2 <= t) ? acc[r] : 0.f; } }
            st4(Sr, 72, 16 * si, 16 * ti, acc, lane); } }
    lds_barrier();
    { const int ti = w >> 1; const bf16x8 s0 = ldfrag(Sr, 72, 16 * ti, 0, lane), s1 = ldfrag(Sr, 72, 16 * ti, 32, lane);
#pragma unroll
        for (int d8 = 0; d8 < 8; ++d8) { const int di = 8 * (w & 1) + d8; f32x4 acc = (f32x4){0.f, 0.f, 0.f, 0.f};
            acc = MFMA16(ldfrag_tr(Vr, VRS, 0, 16 * di, lane), s0, acc); acc = MFMA16(ldfrag_tr(Vr, VRS, 32, 16 * di, lane), s1, acc);
            if (!c.dry) *(u32x2*)(c.HN() + (row0 + 16 * ti + fr) * 1024 + hd * 256 + 16 * di + 4 * fq) = pk4(acc); } }
    lds_barrier();
}
__device__ __forceinline__ void ph_gla_prep2(const Ctx& c) {
    if (c.bid >= BATCH * 4 * NCH) return;
    GlaPrepLoads L; gla_prep_load(c, c.bid, L);
    for (int u = c.bid; u < BATCH * 4 * NCH; u += c.G) gla_prep_unit(c, u, L, u + c.G);
}

struct GlaStage4 { u32x4 kh[2], vo, qt[2], gl; };
__device__ __forceinline__ void gla4_stage_load(const Ctx& c, GlaStage4& S, const int bh, const int dq, const int ch) {
    const int tid = c.tid, b = bh >> 2, hd = bh & 3; const size_t ug = (size_t)bh * NCH + ch, r0 = (size_t)b * TP + ch * 64;
    const bf16_t* kb = c.gKH() + ug * 8192;
    S.kh[0] = *(const u32x4*)(kb + tid * 8); S.kh[1] = *(const u32x4*)(kb + 4096 + tid * 8);
    const int t2 = tid & 255;
    const bf16_t* vp = c.P() + (r0 + (t2 >> 2)) * ODD_IN + 1024 + hd * 256 + dq * 32 + (t2 & 3) * 8;
    const bf16_t* op = c.HN() + (r0 + (t2 >> 2)) * 1024 + hd * 256 + dq * 32 + (t2 & 3) * 8;
    S.vo = *(const u32x4*)(tid < 256 ? vp : op);
    S.qt[0] = *(const u32x4*)(c.P() + (r0 + (tid >> 4)) * ODD_IN + hd * 128 + (tid & 15) * 8); S.qt[1] = *(const u32x4*)(c.P() + (r0 + 32 + (tid >> 4)) * ODD_IN + hd * 128 + (tid & 15) * 8);
    S.gl = *(const u32x4*)(c.glaG() + ug * 128 + (tid & 31) * 4);
}
constexpr int G4_VS = 48;
constexpr int G4_K = 0, G4_V = 128 * 72, G4_Q = G4_V + 64 * G4_VS, G4_O = G4_Q + 64 * 136, G4_G = G4_O + 64 * 40, G4_SIZE = G4_G + 256;
__device__ __forceinline__ void gla4_stage_put(lbf* B, const GlaStage4& S, const int tid) {
    *(LAS u32x4*)(B + G4_K + (tid >> 3) * 72 + (tid & 7) * 8) = S.kh[0]; *(LAS u32x4*)(B + G4_K + (64 + (tid >> 3)) * 72 + (tid & 7) * 8) = S.kh[1];
    const int t2 = tid & 255;
    if (tid < 256) *(LAS u32x4*)(B + G4_V + (t2 >> 2) * G4_VS + (t2 & 3) * 8) = S.vo; else *(LAS u32x4*)(B + G4_O + (t2 >> 2) * 40 + (t2 & 3) * 8) = S.vo;
    *(LAS u32x4*)(B + G4_Q + (tid >> 4) * 136 + (tid & 15) * 8) = S.qt[0]; *(LAS u32x4*)(B + G4_Q + (32 + (tid >> 4)) * 136 + (tid & 15) * 8) = S.qt[1];
    if (tid < 32) *(LAS u32x4*)(B + G4_G + tid * 8) = S.gl;
}
__device__ __forceinline__ void gla_seq_unit4(const Ctx& c, const int u) {
    const int tid = c.tid, lane = c.lane, w = c.wave, fr = lane & 15, fq = lane >> 4;
    const int bh = u >> 3, dq = u & 7, b = bh >> 2, hd = bh & 3;
    lbf* SB = (lbf*)(c.lds + LDS_PH);
    lbf* Zb = SB + 2 * G4_SIZE;
    f32x4 z[2] = {(f32x4){0.f, 0.f, 0.f, 0.f}, (f32x4){0.f, 0.f, 0.f, 0.f}};
    const int ti = w >> 1, dt = w & 1;
    GlaStage4 R0, R1, R2;
    gla4_stage_load(c, R0, bh, dq, 0); gla4_stage_load(c, R1, bh, dq, 1); gla4_stage_load(c, R2, bh, dq, 2);
    gla4_stage_put(SB, R0, tid); gla4_stage_load(c, R0, bh, dq, 3);
#define GLA4_STEP(RS_, ch_) do { const int ch = (ch_); \
        lbf* B = SB + (ch & 1) * G4_SIZE; lbf* Zc = Zb + (ch & 1) * (32 * 136); \
        _Pragma("unroll") for (int d = 0; d < 2; ++d) st4(Zc, 136, 16 * w, 16 * d, z[d], lane); \
        lds_barrier(); \
        gla4_stage_put(SB + ((ch + 1) & 1) * G4_SIZE, RS_, tid); \
        gla4_stage_load(c, RS_, bh, dq, ch + 4 < NCH ? ch + 4 : NCH - 1); \
        { const f32x4 gl = *(const LAS f32x4*)((const LAS float*)(B + G4_G) + 16 * w + 4 * fq); \
            const bf16x8 k0 = ldfrag(B + G4_K, 72, 16 * w, 0, lane), k1 = ldfrag(B + G4_K, 72, 16 * w, 32, lane); \
            _Pragma("unroll") for (int d = 0; d < 2; ++d) { f32x4 a = z[d] * gl; a = MFMA16(k0, ldfrag_tr(B + G4_V, G4_VS, 0, 16 * d, lane), a); a = MFMA16(k1, ldfrag_tr(B + G4_V, G4_VS, 32, 16 * d, lane), a); z[d] = a; } }     \
        const size_t r0 = (size_t)b * TP + ch * 64; \
        { f32x4 o = up4(*(const LAS u32x2*)(B + G4_O + (16 * ti + fr) * 40 + 16 * dt + 4 * fq)), o2 = (f32x4){0.f, 0.f, 0.f, 0.f};     \
            o = MFMA16(ldfrag(Zc, 136, 16 * dt, 0, lane), ldfrag(B + G4_Q, 136, 16 * ti, 0, lane), o); o2 = MFMA16(ldfrag(Zc, 136, 16 * dt, 64, lane), ldfrag(B + G4_Q, 136, 16 * ti, 64, lane), o2); \
            o = MFMA16(ldfrag(Zc, 136, 16 * dt, 32, lane), ldfrag(B + G4_Q, 136, 16 * ti, 32, lane), o); o2 = MFMA16(ldfrag(Zc, 136, 16 * dt, 96, lane), ldfrag(B + G4_Q, 136, 16 * ti, 96, lane), o2); \
            o = o + o2; \
            int l2 = lane; asm volatile("" : "+v"(l2)); \
            if (!c.dry) *(u32x2*)(c.HN() + (r0 + 16 * ti + (l2 & 15)) * 1024 + hd * 256 + dq * 32 + 16 * dt + 4 * (l2 >> 4)) = pk4(o); } \
    } while (0)
#pragma unroll 1
    for (int ch0 = 0; ch0 < NCH; ch0 += 3) { GLA4_STEP(R1, ch0); GLA4_STEP(R2, ch0 + 1); GLA4_STEP(R0, ch0 + 2); }
#undef GLA4_STEP
    lds_barrier();
}
__device__ __forceinline__ void ph_gla_seq2(const Ctx& c) {
    for (int v = c.bid; v < BATCH * 4 * 8; v += c.G) { const int xcd = v & 7, slot = v >> 3; const int u = ((xcd * 4 + (slot >> 3)) << 3) | (slot & 7); gla_seq_unit4(c, u); }
}
__device__ __forceinline__ void ph_gla_finish(const Ctx& c) {
    const Params& p = *c.p; const float* hg = p.in[I_OHEADGAIN];
    float hgv[16];
#pragma unroll
    for (int q = 0; q < 16; ++q) hgv[q] = hg[16 * c.lane + q];
    const int stride = c.G * 8;
    int row = c.bid * 8 + c.wave;
    if (row >= NP) return;
    u32x4 co0, co1, cr0, cr1;
#define GF_LOAD(row_, a0, a1, b0, b1) do { const bf16_t* op = c.HN() + (size_t)(row_) * 1024 + 16 * c.lane; const bf16_t* rp = c.P() + (size_t)(row_) * ODD_IN + 2064 + 16 * c.lane; \
        a0 = *(const u32x4*)op; a1 = *(const u32x4*)(op + 8); b0 = *(const u32x4*)rp; b1 = *(const u32x4*)(rp + 8); } while (0)
    GF_LOAD(row, co0, co1, cr0, cr1);
    for (; row < NP; row += stride) {
        u32x4 no0, no1, nr0, nr1; { const int rn = row + stride < NP ? row + stride : row; GF_LOAD(rn, no0, no1, nr0, nr1); }
        float o[16], r[16];
        unpack8(co0, o); unpack8(co1, o + 8); unpack8(cr0, r); unpack8(cr1, r + 8);
        float ss = 0.f;
#pragma unroll
        for (int q = 0; q < 16; ++q) ss += o[q] * o[q];
        ss += __shfl_xor(ss, 1); ss += __shfl_xor(ss, 2); ss += __shfl_xor(ss, 4); ss += __shfl_xor(ss, 8);
        const float inv = rsqrtf(ss * (1.0f / 256.0f) + 1e-6f); float y[16];
#pragma unroll
        for (int q = 0; q < 16; ++q) y[q] = o[q] * inv * hgv[q] * (r[q] / (1.0f + __expf(-r[q])));
        bf16_t* yp = c.Y() + (size_t)row * 1024 + 16 * c.lane;
        if (!c.dry) *(u32x4*)yp = pack8(y); if (!c.dry) *(u32x4*)(yp + 8) = pack8(y + 8);
        co0 = no0; co1 = no1; cr0 = nr0; cr1 = nr1;
    }
#undef GF_LOAD
}

constexpr int N_PHASES = 19;
__global__ void __launch_bounds__(NTHREADS, 2) fwd(const Params p, const int lo, const int hi, const int probe) {
    extern __shared__ __attribute__((aligned(16))) unsigned char smem[];
    Ctx c; c.p = &p; c.lds = (LAS unsigned char*)smem; c.tid = threadIdx.x; c.lane = c.tid & 63; c.wave = __builtin_amdgcn_readfirstlane(c.tid >> 6); c.G = gridDim.x; c.bid = blockIdx.x; c.dry = 0;
    unsigned char* ws = p.ws;
    c.ws = ws; c.dsc = (unsigned char*)p.out;
    LAS unsigned char* glds = c.lds + LDS_PH;

    if (c.tid < 4) ((volatile LAS unsigned*)smem)[c.tid] = 0u;
    __syncthreads();
    XcdBarrier bar; bar.bar = (unsigned*)(ws + WS_CTL); bar.x = 0; bar.st = (volatile LAS unsigned*)smem; bar.wave = c.wave;
    if (hi - lo > 1) bar = xcd_barrier_post((unsigned*)(ws + WS_CTL), (volatile LAS unsigned*)smem);
#ifndef PHMASK
#define PHMASK 0x7FFFF
#endif
#define IN(k) (((PHMASK >> (k)) & 1) && lo <= (k) && (k) < hi)
#define RELANE() do { c.lane = lane_now(); c.tid = c.wave * 64 + c.lane; } while (0)
#define SEAM(k) do { if (IN(k) && IN((k) + 1)) xcd_barrier(bar); } while (0)
#if PROBE_MASK
#define RUN(k, ...) do { if (IN(k)) { RELANE(); if ((PROBE_MASK >> (k)) & 1) { for (int rep = ((probe >> (k)) & 1) ? 0 : 1; rep < 2; ++rep) { c.dry = (rep == 0); __VA_ARGS__; } } else { c.dry = 0; __VA_ARGS__; } } } while (0)
#else
#define RUN(k, ...) do { if (IN(k)) { RELANE(); __VA_ARGS__; } } while (0)
#endif

    RUN(0, ph_prologue(c));
    SEAM(0);
    if ((probe >> 30) & 1) { for (int k = 0; k < 16; ++k) xcd_barrier(bar); }
    if (IN(1)) { RELANE(); pg8::DenseOrder S; S.init(NP, EVEN_IN, 1024, c.WinE(), c.G, c.bid); pg8::EpiStoreBf16T<true, false> E{c.P(), EVEN_IN, EVEN_IN, c.dry, c.srow(), nullptr};
        pg8::gemm_phase(glds, (const char*)c.XB(), 1024, S, E, c.wave); }
    SEAM(1);
    RUN(2, { ph_rwkv_prep(c); ph_lru2(c, false); });
    SEAM(2);
    RUN(3, ph_rwkv_seq(c));
    SEAM(3);
    RUN(4, ph_rwkv_post(c));
    SEAM(4);
    if (IN(5)) { RELANE(); pg8::DenseOrder S; S.init(NP, 1024, 1024, c.WoutE(), c.G, c.bid); pg8::EpiStoreBf16T<false, true> E{c.H(), 1024, 1024, c.dry, nullptr, c.XB()};
        pg8::gemm_phase(glds, (const char*)c.Y(), 1024, S, E, c.wave); }
    SEAM(5);
    RUN(6, ph_router4(c, 0));
    SEAM(6);
    if (IN(7)) { RELANE(); moe_table(c, 0);
        pg8::MoeOrderT<true> S{(const LAS int*)(glds + 131072), c.mcnt(), c.mlist(), (const char*)c.W1(), (size_t)512 * 1024 * 2, 2, c.G, c.bid, 1024, 1}; pg8::EpiSwiglu E{c.HID(), c.dry, c.mls()};
        pg8::gemm_phase(glds, (const char*)c.H(), 1024, S, E, c.wave); }
    SEAM(7);
    if (IN(8)) { RELANE(); moe_table(c, 0);
        pg8::MoeOrderT<false> S{(const LAS int*)(glds + 131072), c.mcnt(), c.mlist(), (const char*)c.W2(), (size_t)1024 * 256 * 2, 4, c.G, c.bid, 256, 0}; pg8::EpiScatter E{c.YM(), c.mlist(), c.mlw(), c.dry};
        pg8::gemm_phase<pg8::EpiScatter, pg8::MoeOrderT<false>, false, true>(glds, (const char*)c.HID(), 256, S, E, c.wave);   }
    SEAM(8);
    RUN(9, ph_combine_norm(c, p.in[I_ONORM], 0));
    SEAM(9);
    if (IN(10)) { RELANE(); pg8::DenseOrder S; S.init(NP, ODD_IN_PAD, 1024, c.WinO(), c.G, c.bid); pg8::EpiStoreBf16T<true, false> E{c.P(), ODD_IN, ODD_IN, c.dry, c.srow(), nullptr};
        pg8::gemm_phase(glds, (const char*)c.H(), 1024, S, E, c.wave); }
    SEAM(10);
    RUN(11, ph_gla_prep2(c));
    SEAM(11);
    RUN(12, ph_gla_seq2(c));
    SEAM(12);
    RUN(13, { ph_gla_finish(c); filler_B(c, c.bid, c.G); });
    SEAM(13);
    if (IN(14)) { RELANE(); pg8::DenseOrder S; S.init(NP, 1024, 1024, c.WoutO(), c.G, c.bid); pg8::EpiStoreBf16T<false, true> E{c.H(), 1024, 1024, c.dry, nullptr, c.H()};
        pg8::gemm_phase(glds, (const char*)c.Y(), 1024, S, E, c.wave); }
    SEAM(14);
    RUN(15, ph_router4(c, 1));
    SEAM(15);
    if (IN(16)) { RELANE(); moe_table(c, 1);
        pg8::MoeOrderT<true> S{(const LAS int*)(glds + 131072), c.mcnt() + 32, c.mlist(), (const char*)(c.W1() + (size_t)32 * 512 * 1024), (size_t)512 * 1024 * 2, 2, c.G, c.bid, 1024, 1}; pg8::EpiSwiglu E{c.HID(), c.dry, c.mls()};
        pg8::gemm_phase(glds, (const char*)c.H(), 1024, S, E, c.wave); }
    SEAM(16);
    if (IN(17)) { RELANE(); moe_table(c, 1);
        pg8::MoeOrderT<false> S{(const LAS int*)(glds + 131072), c.mcnt() + 32, c.mlist(), (const char*)(c.W2() + (size_t)32 * 1024 * 256), (size_t)1024 * 256 * 2, 4, c.G, c.bid, 256, 0}; pg8::EpiScatter E{c.YM(), c.mlist(), c.mlw(), c.dry};
        pg8::gemm_phase<pg8::EpiScatter, pg8::MoeOrderT<false>, false, true>(glds, (const char*)c.HID(), 256, S, E, c.wave);   }
    SEAM(17);
    RUN(18, ph_combine_norm(c, p.in[I_FINALNORM], 1));
#undef IN
#undef SEAM
#undef RUN
}

extern "C" void kernel_launch(void* const* d_in, const int* in_sizes, int n_in, void* d_out, int out_size, void* d_ws, size_t ws_size, hipStream_t stream) {
    static int grid = 0;
    if (grid == 0) {
        if (n_in != 38 || ws_size < WS_END) { fprintf(stderr, "kernel_launch: unexpected n_in %d or ws_size %zu (< %zu)\n", n_in, ws_size, (size_t)WS_END); grid = -1; return; }
        int dev = 0, cus = 0, per_cu = 0;
        if (hipGetDevice(&dev) != hipSuccess || hipDeviceGetAttribute(&cus, hipDeviceAttributeMultiprocessorCount, dev) != hipSuccess) { grid = -1; return; }
        if (hipFuncSetAttribute((const void*)fwd, hipFuncAttributeMaxDynamicSharedMemorySize, LDS_BYTES) != hipSuccess) { fprintf(stderr, "kernel_launch: hipFuncSetAttribute failed\n"); grid = -1; return; }
        if (hipOccupancyMaxActiveBlocksPerMultiprocessor(&per_cu, (const void*)fwd, NTHREADS, LDS_BYTES) != hipSuccess || per_cu < 1) fprintf(stderr, "kernel_launch: occupancy query says %d\n", per_cu);
        (void)hipGetLastError();
        grid = cus;
    }
    if (grid < 0) return;
    (void)hipMemsetAsync((char*)d_ws + WS_CTL, 0, 32768, stream);
    Params p{};
    for (int i = 0; i < 38; ++i) p.in[i] = (const float*)d_in[i];
    p.out = (float*)d_out; p.ws = (unsigned char*)d_ws;
#if ONE_LAUNCH
    hipLaunchKernelGGL(fwd, dim3(grid), dim3(NTHREADS), LDS_BYTES, stream, p, 0, N_PHASES, (int)PROBE_MASK);
#else
    for (int k = 0; k < N_PHASES; ++k) hipLaunchKernelGGL(fwd, dim3(grid), dim3(NTHREADS), LDS_BYTES, stream, p, k, k + 1, (int)PROBE_MASK);
#endif
}
```
